# Optimizing an MI355X kernel written in HIP

```python
import jax, jax.numpy as jnp
from jax import lax
import numpy as np

D_MODEL = 1024
BATCH = 32
SEQ = 2048
DEPTH = 2

D_MIX = D_MODEL
HEAD_DIM = 64
A_HEADS = 6
A_DIM = A_HEADS * HEAD_DIM
IDX_HEADS = 4
IDX_DIM = 64
TOPK_MAX = 256
Q_BLOCK = 128
B_HEADS = 6
B_DK = 64
B_DV = 64
B_DIM = B_HEADS * B_DV
HGRN_CHUNK = 64
C_GROUPS = 4
C_DIM = D_MIX - A_DIM - B_DIM
C_GROUP_DIM = C_DIM // C_GROUPS
C_CHUNK = 128
ROPE_THETA = 10000.0
F_DENSE = 2816
N_EXPERTS = 8
TOP_K = 2
F_EXPERT = 3584
N_DENSE = (DEPTH + 1) // 2
N_MOE = DEPTH // 2
EPS = 1e-6
IN_WIDTHS = (A_DIM, HEAD_DIM, HEAD_DIM, IDX_HEADS * IDX_DIM, IDX_DIM, IDX_HEADS, B_HEADS * B_DK, B_HEADS * B_DK, B_HEADS * B_DV, B_HEADS * B_DV, 2 * C_DIM)
IN_DIM = sum(IN_WIDTHS)

kernel_name = "hybrid_dsa_hgrn2_gmlp_moe_block"


def rms_norm(x, g):
    xf = x.astype(jnp.float32)
    y = xf * lax.rsqrt(jnp.mean(xf * xf, axis=-1, keepdims=True) + EPS)
    return (y * g.astype(jnp.float32)).astype(x.dtype)


def layer_norm(x, g, b):
    xf = x.astype(jnp.float32)
    mu = jnp.mean(xf, axis=-1, keepdims=True)
    var = jnp.mean(jnp.square(xf - mu), axis=-1, keepdims=True)
    y = (xf - mu) * lax.rsqrt(var + EPS)
    return (y * g.astype(jnp.float32) + b.astype(jnp.float32)).astype(x.dtype)


def rope(x, pos):
    d = x.shape[-1]
    inv = ROPE_THETA ** (-jnp.arange(0, d, 2, dtype=jnp.float32) / d)
    ang = pos.astype(jnp.float32)[..., None] * inv
    cos = jnp.cos(ang)[:, :, None, :]
    sin = jnp.sin(ang)[:, :, None, :]
    xf = x.astype(jnp.float32)
    x1, x2 = xf[..., : d // 2], xf[..., d // 2:]
    return jnp.concatenate([x1 * cos - x2 * sin, x2 * cos + x1 * sin], axis=-1).astype(x.dtype)


def dsa_mixer(q, k, v, iq, ik, iw, positions):
    Bn, S = q.shape[0], q.shape[1]
    q = rope(q, positions)
    k = rope(k[:, :, None, :], positions)[:, :, 0, :]
    iq = rope(iq, positions)
    ik = rope(ik[:, :, None, :], positions)[:, :, 0, :]
    n_top = min(TOPK_MAX, S // 4)
    nb = S // Q_BLOCK
    to_blocks = lambda a: jnp.swapaxes(a.reshape((Bn, nb, Q_BLOCK) + a.shape[2:]), 0, 1)
    s_idx = jnp.arange(S)

    def one_block(args):
        qj, iqj, iwj, j = args
        t = j * Q_BLOCK + jnp.arange(Q_BLOCK)
        rel = jax.nn.relu(jnp.einsum('bqhd,bsd->bqhs', iqj, ik).astype(jnp.float32) * IDX_DIM ** -0.5)
        score = jnp.einsum('bqh,bqhs->bqs', iwj.astype(jnp.float32) * IDX_HEADS ** -0.5, rel)
        causal = s_idx[None, :] <= t[:, None]
        score = jnp.where(causal[None], score, -jnp.inf)
        _, idx = lax.top_k(score, n_top)
        flat = idx.reshape(Bn, Q_BLOCK * n_top, 1)
        kg = jnp.take_along_axis(k, flat, axis=1).reshape(Bn, Q_BLOCK, n_top, HEAD_DIM)
        vg = jnp.take_along_axis(v, flat, axis=1).reshape(Bn, Q_BLOCK, n_top, HEAD_DIM)
        logits = jnp.einsum('bqhd,bqkd->bqhk', qj, kg).astype(jnp.float32) * HEAD_DIM ** -0.5
        valid = idx <= t[None, :, None]
        logits = jnp.where(valid[:, :, None, :], logits, -jnp.inf)
        p = jax.nn.softmax(logits, axis=-1).astype(v.dtype)
        return jnp.einsum('bqhk,bqkd->bqhd', p, vg)

    out = lax.map(one_block, (to_blocks(q), to_blocks(iq), to_blocks(iw), jnp.arange(nb)))
    return jnp.swapaxes(out, 0, 1).reshape(Bn, S, A_HEADS * HEAD_DIM)


def hgrn2_mixer(q, f_logit, i, g, lb, onorm_g):
    Bn, S, H, dk = q.shape
    dv = i.shape[-1]
    lb = lb.reshape(H, dk).astype(jnp.float32)
    log_f = jnp.logaddexp(jnp.log(lb), jnp.log1p(-lb) + jax.nn.log_sigmoid(f_logit.astype(jnp.float32)))
    kk = -jnp.expm1(log_f)
    nc = S // HGRN_CHUNK
    chunk = lambda a: a.astype(jnp.float32).reshape(Bn, nc, HGRN_CHUNK, H, a.shape[-1]).transpose(1, 0, 3, 2, 4)
    qc, kc, vc, lfc = chunk(q), chunk(kk), chunk(i), chunk(log_f)
    bc = jnp.cumsum(lfc, axis=3)
    tril = jnp.arange(HGRN_CHUNK)[:, None] >= jnp.arange(HGRN_CHUNK)[None, :]

    def step(state, xs):
        qj, kj, vj, bj = xs
        diff = bj[:, :, :, None, :] - bj[:, :, None, :, :]
        decay = jnp.exp(jnp.where(tril[:, :, None], diff, -jnp.inf))
        attn = jnp.einsum('bhtd,bhsd,bhtsd->bhts', qj, kj, decay)
        o = jnp.einsum('bhts,bhsv->bhtv', attn, vj) + jnp.einsum('bhtd,bhdv->bhtv', qj * jnp.exp(bj), state)
        b_last = bj[:, :, -1:, :]
        new_state = jnp.exp(b_last[:, :, 0, :])[..., None] * state + jnp.einsum('bhsd,bhsv->bhdv', kj * jnp.exp(b_last - bj), vj)
        return new_state, o

    s0 = jnp.zeros((Bn, H, dk, dv), jnp.float32)
    _, o = lax.scan(step, s0, (qc, kc, vc, bc))
    o = o.transpose(1, 0, 3, 2, 4).reshape(Bn, S, H, dv)
    o = rms_norm(o, onorm_g) * jax.nn.silu(g.astype(jnp.float32))
    return o.reshape(Bn, S, H * dv).astype(q.dtype)


def gmlp_mixer(uv, vn_g, vn_b, ws, bs):
    Bn, S = uv.shape[0], uv.shape[1]
    uv = jax.nn.gelu(uv, approximate=False)
    u, v = uv[..., :C_DIM], uv[..., C_DIM:]
    v = layer_norm(v, vn_g, vn_b)
    nc = S // C_CHUNK
    v = v.reshape(Bn, nc, C_CHUNK, C_GROUPS, C_GROUP_DIM)
    mask = jnp.tril(jnp.ones((C_CHUNK, C_CHUNK), ws.dtype))
    w = ws * mask[None]
    mixed = jnp.einsum('gts,bnsgd->bntgd', w, v) + bs.T[None, None, :, :, None]
    return u * mixed.reshape(Bn, S, C_DIM)


def swiglu(h, w_gate, w_up, w_down):
    return (jax.nn.silu(h @ w_gate) * (h @ w_up)) @ w_down


def moe_swiglu(h, w_router, w_gate, w_up, w_down):
    logits = jnp.einsum('bsd,de->bse', h, w_router).astype(jnp.float32)
    top_v, top_i = lax.top_k(logits, TOP_K)
    wts = jax.nn.softmax(top_v, axis=-1)
    gates = jnp.sum(jax.nn.one_hot(top_i, N_EXPERTS, dtype=jnp.float32) * wts[..., None], axis=-2)

    def per_seq(args):
        hb, gb = args
        a = jnp.einsum('sd,edf->sef', hb, w_gate)
        u = jnp.einsum('sd,edf->sef', hb, w_up)
        act = jax.nn.silu(a) * u * gb[:, :, None]
        return jnp.einsum('sef,efd->sd', act, w_down)

    return lax.map(per_seq, (h, gates.astype(h.dtype)))


def setup_inputs(seed: int = 0) -> dict:
    key = jax.random.key(seed)
    ks = jax.random.split(key, 24)
    nrm = lambda k, shape, s: jax.random.normal(k, shape, jnp.float32) * s
    x = nrm(ks[0], (BATCH, SEQ, D_MODEL), 1.0)
    c = nrm(ks[1], (BATCH, D_MODEL), 1.0)
    offsets = jax.random.randint(ks[2], (BATCH, 1), 0, 4096, dtype=jnp.int32)
    positions = offsets + jnp.arange(SEQ, dtype=jnp.int32)[None, :]
    return {
        "x": x,
        "c": c,
        "positions": positions,
        "w_ada": nrm(ks[3], (DEPTH, D_MODEL, 6 * D_MODEL), 0.5 * D_MODEL ** -0.5),
        "b_ada": nrm(ks[4], (DEPTH, 6 * D_MODEL), 0.02),
        "g_norm_mix": 1.0 + nrm(ks[5], (DEPTH, D_MODEL), 0.02),
        "g_norm_ffn": 1.0 + nrm(ks[6], (DEPTH, D_MODEL), 0.02),
        "w_in": nrm(ks[7], (DEPTH, D_MODEL, IN_DIM), D_MODEL ** -0.5),
        "w_out": nrm(ks[8], (DEPTH, D_MIX, D_MODEL), D_MIX ** -0.5),
        "hgrn_lb_logits": nrm(ks[9], (DEPTH, B_HEADS * B_DK), 0.5),
        "hgrn_out_norm": 1.0 + nrm(ks[10], (DEPTH, B_DV), 0.02),
        "gmlp_vnorm_g": 1.0 + nrm(ks[11], (DEPTH, C_DIM), 0.02),
        "gmlp_vnorm_b": nrm(ks[12], (DEPTH, C_DIM), 0.02),
        "gmlp_w_s": nrm(ks[13], (DEPTH, C_GROUPS, C_CHUNK, C_CHUNK), C_CHUNK ** -0.5),
        "gmlp_b_s": 1.0 + nrm(ks[14], (DEPTH, C_GROUPS, C_CHUNK), 0.02),
        "ffn_w_gate": nrm(ks[15], (N_DENSE, D_MODEL, F_DENSE), D_MODEL ** -0.5),
        "ffn_w_up": nrm(ks[16], (N_DENSE, D_MODEL, F_DENSE), D_MODEL ** -0.5),
        "ffn_w_down": nrm(ks[17], (N_DENSE, F_DENSE, D_MODEL), F_DENSE ** -0.5),
        "moe_w_router": nrm(ks[18], (N_MOE, D_MODEL, N_EXPERTS), D_MODEL ** -0.5),
        "moe_w_gate": nrm(ks[19], (N_MOE, N_EXPERTS, D_MODEL, F_EXPERT), D_MODEL ** -0.5),
        "moe_w_up": nrm(ks[20], (N_MOE, N_EXPERTS, D_MODEL, F_EXPERT), D_MODEL ** -0.5),
        "moe_w_down": nrm(ks[21], (N_MOE, N_EXPERTS, F_EXPERT, D_MODEL), F_EXPERT ** -0.5),
        "g_final": 1.0 + nrm(ks[22], (D_MODEL,), 0.02),
    }


def reference(x, c, positions, w_ada, b_ada, g_norm_mix, g_norm_ffn, w_in, w_out, hgrn_lb_logits, hgrn_out_norm, gmlp_vnorm_g, gmlp_vnorm_b, gmlp_w_s, gmlp_b_s, ffn_w_gate, ffn_w_up, ffn_w_down, moe_w_router, moe_w_gate, moe_w_up, moe_w_down, g_final):
    Bn, S = x.shape[0], x.shape[1]
    p_lb = jax.nn.softmax(hgrn_lb_logits.astype(jnp.float32), axis=0)
    cum = jnp.cumsum(p_lb, axis=0)
    lower_bounds = cum - cum[0:1]
    splits = [int(s) for s in np.cumsum(IN_WIDTHS)[:-1]]
    cond = jax.nn.silu(c)
    for l in range(DEPTH):
        mod = cond @ w_ada[l] + b_ada[l]
        sh1, sc1, g1, sh2, sc2, g2 = [m[:, None, :] for m in jnp.split(mod, 6, axis=-1)]
        h = rms_norm(x, g_norm_mix[l]) * (1 + sc1) + sh1
        z = h @ w_in[l]
        aq, ak, av, iq, ik, iw, bq, bf, bi, bg, cuv = jnp.split(z, splits, axis=-1)
        a_out = dsa_mixer(aq.reshape(Bn, S, A_HEADS, HEAD_DIM), ak, av, iq.reshape(Bn, S, IDX_HEADS, IDX_DIM), ik, iw, positions)
        b_out = hgrn2_mixer(bq.reshape(Bn, S, B_HEADS, B_DK), bf.reshape(Bn, S, B_HEADS, B_DK), bi.reshape(Bn, S, B_HEADS, B_DV), bg.reshape(Bn, S, B_HEADS, B_DV), lower_bounds[l], hgrn_out_norm[l])
        c_out = gmlp_mixer(cuv, gmlp_vnorm_g[l], gmlp_vnorm_b[l], gmlp_w_s[l], gmlp_b_s[l])
        mix = jnp.concatenate([a_out, b_out, c_out], axis=-1) @ w_out[l]
        x = x + g1 * mix
        h = rms_norm(x, g_norm_ffn[l]) * (1 + sc2) + sh2
        if l % 2 == 0:
            y = swiglu(h, ffn_w_gate[l // 2], ffn_w_up[l // 2], ffn_w_down[l // 2])
        else:
            y = moe_swiglu(h, moe_w_router[l // 2], moe_w_gate[l // 2], moe_w_up[l // 2], moe_w_down[l // 2])
        x = x + g2 * y
    return rms_norm(x, g_final)
```

```cpp
#include <hip/hip_runtime.h>
#include <cstdio>
#include <cstdint>

#ifndef MK_PER_PHASE
#define MK_PER_PHASE 1
#endif
#ifndef EN_GMLP
#define EN_GMLP 1
#endif
#ifndef EN_HGRN
#define EN_HGRN 1
#endif
#ifndef EN_DSA
#define EN_DSA 1
#endif

#define GAS __attribute__((address_space(1)))
#define LAS __attribute__((address_space(3)))
typedef unsigned short bf16_t;
typedef short bf16x8 __attribute__((ext_vector_type(8)));
typedef float f32x4 __attribute__((ext_vector_type(4)));
typedef float f32x2 __attribute__((ext_vector_type(2)));
typedef float f32x16 __attribute__((ext_vector_type(16)));
typedef unsigned u32x4 __attribute__((ext_vector_type(4)));
typedef unsigned u32x2 __attribute__((ext_vector_type(2)));
typedef GAS unsigned gu32;
#define RLX_AGENT __ATOMIC_RELAXED, __HIP_MEMORY_SCOPE_AGENT

constexpr int T = 65536, DM = 1024, NB = 32, SEQ = 2048;
constexpr int NIN = 3072;
constexpr int INSRC = 2884;
constexpr int FD = 2816, FE = 3584, NE = 8;
constexpr int NWAVES = 8, NTHR = 512;
constexpr int HSROWS = T + 2048;
constexpr float EPS = 1e-6f;

constexpr size_t MiB = 1u << 20;
constexpr size_t WS_CTL = 0, CTL_ZERO_BYTES = 1 * MiB;
constexpr size_t WS_MOD = 1 * MiB;
constexpr size_t WS_CS = 3 * MiB;
constexpr size_t WS_LB = 5 * MiB;
constexpr size_t WS_GW = 5 * MiB + 512 * 1024;
constexpr size_t WS_TOK = 6 * MiB;
constexpr size_t WS_ROWINFO = 8 * MiB;
constexpr size_t WS_WIN = 16 * MiB;
constexpr size_t WS_WOUT = 28 * MiB;
constexpr size_t WS_WF1 = 32 * MiB;
constexpr size_t WS_WF2 = 43 * MiB;
constexpr size_t WS_WM1 = 49 * MiB;
constexpr size_t WS_WM2 = 161 * MiB;
constexpr size_t WS_ACT1 = 224 * MiB;
constexpr size_t WS_BIG = 352 * MiB;
constexpr size_t WS_QA = WS_BIG;
constexpr size_t WS_KA = WS_QA + 48 * MiB;
constexpr size_t WS_VAT = WS_KA + 8 * MiB;
constexpr size_t WS_IQ = WS_VAT + 8 * MiB;
constexpr size_t WS_IK = WS_IQ + 32 * MiB;
constexpr size_t WS_IW = WS_IK + 8 * MiB;
constexpr size_t WS_HQ = WS_IW + 1 * MiB;
constexpr size_t WS_HLF = WS_HQ + 48 * MiB;
constexpr size_t WS_HKK = WS_HLF + 96 * MiB;
constexpr size_t WS_HI = WS_HKK + 48 * MiB;
constexpr size_t WS_HG = WS_HI + 48 * MiB;
constexpr size_t WS_GU = WS_HG + 48 * MiB;
constexpr size_t WS_GV = WS_GU + 32 * MiB;
constexpr size_t WS_BM = WS_GV + 32 * MiB;
constexpr size_t WS_MIXEND = WS_BM + 16 * MiB;
constexpr size_t WS_ACTF = WS_BIG;
constexpr size_t WS_HS = 224 * MiB;
constexpr size_t WS_ACTM = 488 * MiB;
constexpr size_t WS_HBM = 800 * MiB;
constexpr size_t WS_END = 1024 * MiB;
static_assert(WS_MIXEND <= WS_END && WS_ACTF + (size_t)T * FD * 2 <= WS_END, "ws map");
static_assert(WS_HS + (size_t)2 * HSROWS * DM * 2 <= WS_ACTM && WS_ACTM + (size_t)HSROWS * FE * 2 <= WS_END && WS_HBM + (size_t)T * DM * 2 <= WS_ACTM + (size_t)HSROWS * FE * 2, "ws map moe");
static_assert(WS_WM2 + (size_t)NE * DM * FE * 2 <= WS_ACT1, "ws map weights");

constexpr int CW_BAR = 4096;
constexpr int CW_Q = 8192;
constexpr int CW_CNT = 12288;
constexpr int CW_KMAX = 16384;

constexpr int LDS_BYTES = 163840;
constexpr int LDS_MISC = 163840 - 256;
constexpr int PH_SCRATCH = LDS_MISC;

__device__ __forceinline__ float bf2f(unsigned short b) { return __builtin_bit_cast(float, ((unsigned)b) << 16); }
__device__ __forceinline__ unsigned f2bf(float f) { unsigned u = __builtin_bit_cast(unsigned, f); return (u + 0x7fffu + ((u >> 16) & 1u)) >> 16; }
__device__ __forceinline__ unsigned pk2(float lo, float hi) { unsigned r; asm volatile("v_cvt_pk_bf16_f32 %0, %1, %2" : "=v"(r) : "v"(lo), "v"(hi)); return r; }
__device__ __forceinline__ float wave_sum(float v) {
#pragma unroll
    for (int o = 1; o < 64; o <<= 1) v += __shfl_xor(v, o);
    return v;
}
__device__ __forceinline__ float fast_exp(float x) { return __builtin_amdgcn_exp2f(x * 1.44269504089f); }
__device__ __forceinline__ float fast_log(float x) { return __builtin_amdgcn_logf(x) * 0.69314718056f; }
__device__ __forceinline__ float sigmoidf(float x) { return __builtin_amdgcn_rcpf(1.f + fast_exp(-x)); }

__device__ __forceinline__ int opaque_tid0() { int t = threadIdx.x; asm volatile("" : "+v"(t)); return t; }
namespace pg8 {
constexpr int BM = 256, BK = 64, HALF = 128, HTB = HALF * BK * 2, STAGE_BYTES = 8 * HTB, NXCD = 8, WGM = 8;
__host__ __device__ __forceinline__ int lds_byte(int r, int c) { const int st = (r >> 4) * 2 + (c >> 5), rr = r & 15, cc = c & 31, ob = rr * 64 + cc * 2; return st * 1024 + (ob ^ (((ob >> 9) & 1) << 5)); }
__host__ __device__ __forceinline__ void stage_rc(int b, int& R, int& C) { const int st = b / 1024, sb = b % 1024, swz = sb ^ (((sb >> 9) & 1) << 5); R = (st >> 1) * 16 + swz / 64; C = (st & 1) * 32 + (swz % 64) / 2; }
__host__ __device__ __forceinline__ int perm32(int rho) { const int n = rho >> 4, i = rho & 15; return 8 * (i >> 2) + 4 * n + (i & 3); }
struct Unit { int pm, pn; };
struct Gemm { const bf16_t* A; const bf16_t* Bt; int M, N, K; };
struct StaticOrder {
    int nM, nN, nwg, G, c;
    __device__ void init(int M, int N, int G_, int c_) { nM = M / BM; nN = N / BM; nwg = nM * nN; G = G_; c = c_; }
    __device__ bool next(int i, Unit& u) const {
        const long L = (long)i * G + c; if (L >= nwg) return false;
        int wgid = (int)L; { const int q = nwg / NXCD, r = nwg % NXCD, xcd = wgid % NXCD, off = wgid / NXCD; wgid = (xcd < r ? xcd * (q + 1) : r * (q + 1) + (xcd - r) * q) + off; }
        const int nig = WGM * nN, gid = wgid / nig, fm = gid * WGM, gsz = (nM - fm) < WGM ? (nM - fm) : WGM;
        u.pm = fm + ((wgid % nig) % gsz); u.pn = (wgid % nig) / gsz; return true;
    }
};
struct MoeOrder : StaticOrder {
    const LAS int* tp; int nNl;
    __device__ bool next(int i, Unit& u) const {
        if (!StaticOrder::next(i, u)) return false;
        int e = 0;
#pragma unroll
        for (int k = 1; k < 8; ++k) e += (u.pm >= tp[k]) ? 1 : 0;
        u.pn += e * nNl; return true;
    }
};

template <class Epi, class Sched>
__device__ __forceinline__ void gemm_phase(LAS unsigned char* lds, const Gemm g, const Sched& S, const Epi& E) {
    const int tid = opaque_tid0(), wid = __builtin_amdgcn_readfirstlane(tid >> 6), lane = tid & 63, wr = wid >> 2, wc = wid & 3, fr = lane & 15, fq = lane >> 4;
    const int K = g.K, nt = K / BK;
    unsigned voffA[2], voffB[2];
#pragma unroll
    for (int i = 0; i < 2; ++i) { int R, C; stage_rc(tid * 16 + i * 8192, R, C); const int Rb = Epi::PERM ? ((R & ~31) + perm32(R & 31)) : R;
        voffA[i] = (unsigned)(R * K + C) * 2u; voffB[i] = (unsigned)(Rb * K + C) * 2u; }
    const size_t kstep = (size_t)(BK * 2);
    const size_t hstep = (size_t)HALF * K * 2;
    const size_t tstep = 2 * hstep;
    const unsigned ldsw = (unsigned)wid * 1024u;
    const int aoff = lds_byte(wr * 64 + fr, fq * 8), boff = lds_byte(wc * 32 + fr, fq * 8);
#define PG8_SA(b, h) (((b) * 2 + (h)) * HTB)
#define PG8_SB(b, h) ((4 + (b) * 2 + (h)) * HTB)
#define PG8_STAGE(bufoff, gbase, voff) do { _Pragma("unroll") for (int _i = 0; _i < 2; ++_i) \
        __builtin_amdgcn_global_load_lds((const unsigned*)((const char*)(gbase) + (voff)[_i]), (LAS unsigned*)(lds + (bufoff) + ldsw + _i * 8192), 16, 0, 0); } while (0)
#define PG8_LDA(dst, b, h) do { _Pragma("unroll") for (int m = 0; m < 4; ++m) _Pragma("unroll") for (int k = 0; k < 2; ++k) dst[m][k] = *(const LAS bf16x8*)(lds + PG8_SA(b, h) + aoff + m * 2048 + k * 1024); } while (0)
#define PG8_LDB(dst, b, h) do { _Pragma("unroll") for (int n = 0; n < 2; ++n) _Pragma("unroll") for (int k = 0; k < 2; ++k) dst[n][k] = *(const LAS bf16x8*)(lds + PG8_SB(b, h) + boff + n * 2048 + k * 1024); } while (0)
#define PG8_MMA(ai, bj, At, Bt) do { __builtin_amdgcn_s_setprio(1); _Pragma("unroll") for (int m = 0; m < 4; ++m) _Pragma("unroll") for (int n = 0; n < 2; ++n) _Pragma("unroll") for (int k = 0; k < 2; ++k) \
        acc[ai][bj][m][n] = __builtin_amdgcn_mfma_f32_16x16x32_bf16(Bt[n][k], At[m][k], acc[ai][bj][m][n], 0, 0, 0); __builtin_amdgcn_s_setprio(0); } while (0)
#define PG8_WAIT_V(n) asm volatile("s_waitcnt vmcnt(" #n ")" ::: "memory")
#define PG8_WAIT_L(n) asm volatile("s_waitcnt lgkmcnt(" #n ")" ::: "memory")
#define PG8_BAR __builtin_amdgcn_s_barrier()
#define PG8_SCHED __builtin_amdgcn_sched_barrier(0)
    Unit cur, nxt; int ui = 0;
    if (!S.next(0, cur)) return;
    f32x4 acc[2][2][4][2];
#pragma unroll
    for (int a = 0; a < 2; ++a)
#pragma unroll
        for (int b = 0; b < 2; ++b)
#pragma unroll
            for (int m = 0; m < 4; ++m)
#pragma unroll
                for (int n = 0; n < 2; ++n) acc[a][b][m][n] = (f32x4){0.f, 0.f, 0.f, 0.f};
    bf16x8 At[4][2], B0[2][2], B1[2][2];
    const char* cA = (const char*)g.A + (size_t)cur.pm * tstep; const char* cB = (const char*)g.Bt + (size_t)cur.pn * tstep;
    PG8_STAGE(PG8_SB(0, 0), cB, voffB); PG8_STAGE(PG8_SB(0, 1), cB + hstep, voffB); PG8_STAGE(PG8_SA(0, 0), cA, voffA); PG8_STAGE(PG8_SA(0, 1), cA + hstep, voffA);
    if (wr == 1) PG8_BAR;
    PG8_WAIT_V(2); PG8_BAR;
    PG8_STAGE(PG8_SB(1, 0), cB + kstep, voffB); PG8_STAGE(PG8_SA(1, 0), cA + kstep, voffA); PG8_STAGE(PG8_SB(1, 1), cB + hstep + kstep, voffB);
    PG8_WAIT_V(6); PG8_BAR;
    for (;;) {
        const bool has_next = S.next(ui + 1, nxt);
        const char* nA = has_next ? (const char*)g.A + (size_t)nxt.pm * tstep : cA; const char* nB = has_next ? (const char*)g.Bt + (size_t)nxt.pn * tstep : cB;
        for (int t = 0; t < nt; t += 2) {
            const bool last = (t == nt - 2);
            const char* a1 = cA + (size_t)(t + 1) * kstep;
            const char* a2 = last ? nA : cA + (size_t)(t + 2) * kstep; const char* b2 = last ? nB : cB + (size_t)(t + 2) * kstep;
            const char* a3 = a2 + kstep; const char* b3 = b2 + kstep;
            PG8_LDB(B0, 0, 0); PG8_LDB(B1, 0, 1); PG8_SCHED; PG8_LDA(At, 0, 0); PG8_STAGE(PG8_SA(1, 1), a1 + hstep, voffA);
            PG8_WAIT_V(8); PG8_WAIT_L(0); PG8_BAR; PG8_MMA(0, 0, At, B0); PG8_MMA(0, 1, At, B1); PG8_BAR; PG8_SCHED;
            PG8_LDA(At, 0, 1); PG8_STAGE(PG8_SB(0, 0), b2, voffB); PG8_STAGE(PG8_SB(0, 1), b2 + hstep, voffB); PG8_STAGE(PG8_SA(0, 0), a2, voffA);
            PG8_WAIT_V(8); PG8_WAIT_L(0); PG8_BAR; PG8_MMA(1, 0, At, B0); PG8_MMA(1, 1, At, B1); PG8_BAR; PG8_SCHED;
            PG8_LDB(B0, 1, 0); PG8_LDB(B1, 1, 1); PG8_SCHED; PG8_LDA(At, 1, 0); PG8_STAGE(PG8_SA(0, 1), a2 + hstep, voffA);
            PG8_WAIT_V(8); PG8_WAIT_L(0); PG8_BAR; PG8_MMA(0, 0, At, B0); PG8_MMA(0, 1, At, B1); PG8_BAR; PG8_SCHED;
            PG8_LDA(At, 1, 1); PG8_STAGE(PG8_SB(1, 0), b3, voffB); PG8_STAGE(PG8_SB(1, 1), b3 + hstep, voffB); PG8_STAGE(PG8_SA(1, 0), a3, voffA);
            PG8_WAIT_V(8); PG8_WAIT_L(0); PG8_BAR; PG8_MMA(1, 0, At, B0); PG8_MMA(1, 1, At, B1); PG8_BAR; PG8_SCHED;
        }
        if (wr == 0) PG8_BAR;
        E(acc, cur, wr, wc, fr, fq);
        if (!has_next) break;
#pragma unroll
        for (int a = 0; a < 2; ++a)
#pragma unroll
            for (int b = 0; b < 2; ++b)
#pragma unroll
                for (int m = 0; m < 4; ++m)
#pragma unroll
                    for (int n = 0; n < 2; ++n) acc[a][b][m][n] = (f32x4){0.f, 0.f, 0.f, 0.f};
        cur = nxt; cA = nA; cB = nB; ++ui;
        if (wr == 1) PG8_BAR;
    }
    PG8_WAIT_V(0);
    PG8_BAR;
#undef PG8_SA
#undef PG8_SB
#undef PG8_STAGE
#undef PG8_LDA
#undef PG8_LDB
#undef PG8_MMA
#undef PG8_WAIT_V
#undef PG8_WAIT_L
#undef PG8_BAR
#undef PG8_SCHED
}
}

typedef f32x4 AccT[2][2][4][2];

__device__ __forceinline__ f32x2 gelu_pk(f32x2 v) {
    const f32x2 av = __builtin_elementwise_abs(v), d = av * 0.2316418882f + 1.0f;
    f32x2 t; t.x = __builtin_amdgcn_rcpf(d.x); t.y = __builtin_amdgcn_rcpf(d.y);
    f32x2 q = t * 0.5307027145f + (-0.7265760135f); q = q * t + 0.7107068705f; q = q * t + (-0.142248368f); q = q * t + 0.127414796f; q = q * t;
    const f32x2 s = (v * v) * (-0.72134752044f);
    f32x2 e; e.x = __builtin_amdgcn_exp2f(s.x); e.y = __builtin_amdgcn_exp2f(s.y);
    const f32x2 m = v * (q * e), r = v - m;
    f32x2 o; o.x = v.x < 0.f ? m.x : r.x; o.y = v.y < 0.f ? m.y : r.y; return o;
}
__device__ __forceinline__ float gelu1(float x) { f32x2 r = gelu_pk((f32x2){x, x}); return r.x; }
__device__ __forceinline__ u32x4 pack8(const f32x4 a, const f32x4 b) { u32x4 w; w.x = pk2(a[0], a[1]); w.y = pk2(a[2], a[3]); w.z = pk2(b[0], b[1]); w.w = pk2(b[2], b[3]); return w; }

constexpr float QSCALE = 0.125f * 1.44269504089f;

struct EpiInproj {
    static constexpr bool PERM = true;
    bf16_t *QA, *KA, *VAT, *IQ, *IK; float* IW; bf16_t *HQ, *HKK, *HI, *HG; float* HLF; bf16_t *GU, *GV;
    const float* CS; const int* pos; const float* lb; unsigned* kmax;
    __device__ __forceinline__ void operator()(const AccT& acc, const pg8::Unit& u, int wr, int wc, int fr, int fq) const {
        const int row0 = u.pm * 256 + wr * 64 + fr, pn = u.pn;
        if (pn < 4) {
            float kmx = 0.f;
#pragma unroll
            for (int ai = 0; ai < 2; ++ai)
#pragma unroll
                for (int m = 0; m < 4; ++m) {
                    asm volatile("" ::: "memory"); __builtin_amdgcn_sched_barrier(0);
                    const int row = row0 + ai * 128 + m * 16;
                    const f32x4 x1a = acc[ai][0][m][0], x1b = acc[ai][0][m][1], x2a = acc[ai][1][m][0], x2b = acc[ai][1][m][1];
                    if (pn == 1 && wc == 3) {
                        const int b = row >> 11, s = row & 2047; bf16_t* vp = VAT + ((size_t)b * 64) * 2048 + s;
#pragma unroll
                        for (int j = 0; j < 4; ++j) { vp[(size_t)(8 * fq + j) * 2048] = (bf16_t)f2bf(x1a[j]); vp[(size_t)(8 * fq + 4 + j) * 2048] = (bf16_t)f2bf(x1b[j]);
                            vp[(size_t)(32 + 8 * fq + j) * 2048] = (bf16_t)f2bf(x2a[j]); vp[(size_t)(32 + 8 * fq + 4 + j) * 2048] = (bf16_t)f2bf(x2b[j]); }
                        continue;
                    }
                    if (pn == 3 && wc >= 1) {
                        if (wc == 1 && fq == 0) *(f32x4*)(IW + (size_t)row * 4) = x1a;
                        continue;
                    }
                    const int p = pos[row]; const float* cs = CS + (size_t)p * 64 + 8 * fq;
                    const f32x4 ca = *(const f32x4*)cs, cb = *(const f32x4*)(cs + 4), sa = *(const f32x4*)(cs + 32), sb = *(const f32x4*)(cs + 36);
                    f32x4 o1a = x1a * ca - x2a * sa, o1b = x1b * cb - x2b * sb, o2a = x2a * ca + x1a * sa, o2b = x2b * cb + x1b * sb;
                    bf16_t* dst;
                    if (pn == 0) { dst = QA + ((size_t)row * 6 + wc) * 64; o1a *= QSCALE; o1b *= QSCALE; o2a *= QSCALE; o2b *= QSCALE; }
                    else if (pn == 1) { if (wc < 2) { dst = QA + ((size_t)row * 6 + 4 + wc) * 64; o1a *= QSCALE; o1b *= QSCALE; o2a *= QSCALE; o2b *= QSCALE; }
                        else { dst = KA + (size_t)row * 64;
                            float ss = 0.f;
#pragma unroll
                            for (int j = 0; j < 4; ++j) ss += o1a[j] * o1a[j] + o1b[j] * o1b[j] + o2a[j] * o2a[j] + o2b[j] * o2b[j];
                            ss += __shfl_xor(ss, 16); ss += __shfl_xor(ss, 32); kmx = fmaxf(kmx, ss); } }
                    else if (pn == 2) dst = IQ + ((size_t)row * 4 + wc) * 64;
                    else dst = IK + (size_t)row * 64;
                    *(u32x4*)(dst + 8 * fq) = pack8(o1a, o1b);
                    *(u32x4*)(dst + 32 + 8 * fq) = pack8(o2a, o2b);
                }
            if (pn == 1 && wc == 2) {
#pragma unroll
                for (int o = 1; o < 16; o <<= 1) kmx = fmaxf(kmx, __shfl_xor(kmx, o));
                if ((threadIdx.x & 63) == 0) atomicMax(kmax + (row0 >> 11), __builtin_bit_cast(unsigned, kmx));
            }
        } else if (pn < 10) {
            const int h = pn - 4; const int dq = 32 * (wc & 1) + 8 * fq;
            f32x4 lba, lbb;
            if (wc >= 2) { lba = *(const f32x4*)(lb + h * 64 + dq); lbb = *(const f32x4*)(lb + h * 64 + dq + 4); }
#pragma unroll
            for (int ai = 0; ai < 2; ++ai)
#pragma unroll
                for (int m = 0; m < 4; ++m) {
                    asm volatile("" ::: "memory"); __builtin_amdgcn_sched_barrier(0);
                    const int row = row0 + ai * 128 + m * 16; const size_t o = ((size_t)row * 6 + h) * 64 + dq;
                    if (wc < 2) {
                        *(u32x4*)(HQ + o) = pack8(acc[ai][0][m][0], acc[ai][0][m][1]);
                        *(u32x4*)(HI + o) = pack8(acc[ai][1][m][0], acc[ai][1][m][1]);
                    } else {
                        f32x4 lf[2], kk[2], sg[2];
#pragma unroll
                        for (int n = 0; n < 2; ++n)
#pragma unroll
                            for (int j = 0; j < 4; ++j) {
                                const float z = acc[ai][0][m][n][j], lbv = n ? lbb[j] : lba[j];
                                const float ls = fminf(z, 0.f) - fast_log(1.f + fast_exp(-fabsf(z)));
                                lf[n][j] = (lbv > 0.f) ? fast_log(lbv + (1.f - lbv) * fast_exp(ls)) : ls;
                                kk[n][j] = (1.f - lbv) * fast_exp(ls - z);
                                const float gg = acc[ai][1][m][n][j]; sg[n][j] = gg * sigmoidf(gg);
                            }
                        *(f32x4*)(HLF + o) = lf[0]; *(f32x4*)(HLF + o + 4) = lf[1];
                        *(u32x4*)(HKK + o) = pack8(kk[0], kk[1]);
                        *(u32x4*)(HG + o) = pack8(sg[0], sg[1]);
                    }
                }
        } else {
            bf16_t* dstb = (pn == 10) ? GU : GV;
#pragma unroll
            for (int ai = 0; ai < 2; ++ai)
#pragma unroll
                for (int m = 0; m < 4; ++m) {
                    asm volatile("" ::: "memory"); __builtin_amdgcn_sched_barrier(0);
                    const int row = row0 + ai * 128 + m * 16;
#pragma unroll
                    for (int bj = 0; bj < 2; ++bj) {
                        const f32x4 v0 = acc[ai][bj][m][0], v1 = acc[ai][bj][m][1];
                        const f32x2 a = gelu_pk((f32x2){v0[0], v0[1]}), b = gelu_pk((f32x2){v0[2], v0[3]}), c = gelu_pk((f32x2){v1[0], v1[1]}), d = gelu_pk((f32x2){v1[2], v1[3]});
                        u32x4 w; w.x = pk2(a.x, a.y); w.y = pk2(b.x, b.y); w.z = pk2(c.x, c.y); w.w = pk2(d.x, d.y);
                        *(u32x4*)(dstb + (size_t)row * 256 + bj * 128 + wc * 32 + 8 * fq) = w;
                    }
                }
        }
    }
};

struct EpiResid {
    static constexpr bool PERM = true;
    const float* xin; float* out; const float* gate;
    __device__ __forceinline__ void operator()(const AccT& acc, const pg8::Unit& u, int wr, int wc, int fr, int fq) const {
        const int row0 = u.pm * 256 + wr * 64 + fr, col0 = u.pn * 256 + wc * 32 + 8 * fq;
        const float* gp = gate + (size_t)(row0 >> 11) * 6144 + col0;
        f32x4 gv[2][2];
#pragma unroll
        for (int bj = 0; bj < 2; ++bj)
#pragma unroll
            for (int n = 0; n < 2; ++n) gv[bj][n] = *(const f32x4*)(gp + bj * 128 + 4 * n);
#pragma unroll
        for (int ai = 0; ai < 2; ++ai)
#pragma unroll
            for (int m = 0; m < 4; ++m) { asm volatile("" ::: "memory"); __builtin_amdgcn_sched_barrier(0); const size_t o = (size_t)(row0 + ai * 128 + m * 16) * DM + col0;
#pragma unroll
                for (int bj = 0; bj < 2; ++bj)
#pragma unroll
                    for (int n = 0; n < 2; ++n) { const f32x4 xv = *(const f32x4*)(xin + o + bj * 128 + 4 * n); *(f32x4*)(out + o + bj * 128 + 4 * n) = xv + gv[bj][n] * acc[ai][bj][m][n]; } }
    }
};

struct EpiSwiglu {
    static constexpr bool PERM = true;
    bf16_t* O; int ldo; int nNl;
    __device__ __forceinline__ void operator()(const AccT& acc, const pg8::Unit& u, int wr, int wc, int fr, int fq) const {
        const int row0 = u.pm * 256 + wr * 64 + fr, pnl = u.pn % nNl, col0 = pnl * 128 + wc * 32 + 8 * fq;
#pragma unroll
        for (int ai = 0; ai < 2; ++ai)
#pragma unroll
            for (int m = 0; m < 4; ++m) {
                asm volatile("" ::: "memory"); __builtin_amdgcn_sched_barrier(0);
                f32x4 r[2];
#pragma unroll
                for (int n = 0; n < 2; ++n)
#pragma unroll
                    for (int j = 0; j < 4; ++j) { const float g = acc[ai][0][m][n][j]; r[n][j] = g * sigmoidf(g) * acc[ai][1][m][n][j]; }
                *(u32x4*)(O + (size_t)(row0 + ai * 128 + m * 16) * ldo + col0) = pack8(r[0], r[1]);
            }
    }
};

struct EpiMoeDown {
    static constexpr bool PERM = true;
    float* out; const float* g2; const int* rowinfo;
    __device__ __forceinline__ void operator()(const AccT& acc, const pg8::Unit& u, int wr, int wc, int fr, int fq) const {
        const int row0 = u.pm * 256 + wr * 64 + fr, col0 = (u.pn & 3) * 256 + wc * 32 + 8 * fq;
#pragma unroll
        for (int ai = 0; ai < 2; ++ai)
#pragma unroll
            for (int m = 0; m < 4; ++m) {
                asm volatile("" ::: "memory"); __builtin_amdgcn_sched_barrier(0);
                const int row = row0 + ai * 128 + m * 16; const int tok = rowinfo[2 * row]; const float gt = __builtin_bit_cast(float, rowinfo[2 * row + 1]);
                if (tok >= 0) { const float* gp = g2 + (size_t)(tok >> 11) * 6144 + col0; float* op = out + (size_t)tok * DM + col0;
#pragma unroll
                    for (int bj = 0; bj < 2; ++bj)
#pragma unroll
                        for (int n = 0; n < 2; ++n) { const f32x4 gv = *(const f32x4*)(gp + bj * 128 + 4 * n); const f32x4 xv = *(const f32x4*)(op + bj * 128 + 4 * n);
                            *(f32x4*)(op + bj * 128 + 4 * n) = xv + gv * gt * acc[ai][bj][m][n]; } }
            }
    }
};

#define XB_TMO      128
#define XB_XCNT(j)  (256  + 64 * (j))
#define XB_XSUB(j)  (1280 + 64 * (j))
#define XB_XGEN(j)  (2304 + 64 * (j))
#define XB_TOP      3328
#define XB_TOPGEN   3392
#define XCD_BAR_WORDS 3456
#define XB_SPIN_CAP (1u << 18)
__device__ __forceinline__ unsigned xb_ld(unsigned* p)              { return __hip_atomic_load(p, __ATOMIC_RELAXED, __HIP_MEMORY_SCOPE_AGENT); }
__device__ __forceinline__ unsigned xb_add(unsigned* p, unsigned v) { return __hip_atomic_fetch_add(p, v, __ATOMIC_RELAXED, __HIP_MEMORY_SCOPE_AGENT); }
__device__ __forceinline__ unsigned xb_xcc_id() { return (unsigned)__builtin_amdgcn_s_getreg((3 << 11) | 20) & 0xFu; }
#define XB_SPIN(cond, bar) do { unsigned _sp = 0; while (cond) { __builtin_amdgcn_s_sleep(1); \
    if ((++_sp & 255u) == 0u) { if (xb_ld(&(bar)[XB_TMO])) break; if (_sp > XB_SPIN_CAP) { atomicAdd(&(bar)[XB_TMO], 1u); break; } } } } while (0)
struct XcdBarrier { unsigned* bar; unsigned x; volatile LAS unsigned* st; };
__device__ __forceinline__ XcdBarrier xcd_barrier_post(unsigned* bar, volatile LAS unsigned* st) {
    XcdBarrier b; b.bar = bar; b.x = xb_xcc_id(); b.st = st;
    if (threadIdx.x == 0) (void)xb_add(&bar[XB_XCNT(b.x)], 1u);
    return b;
}
__device__ __forceinline__ void xcd_barrier_complete(unsigned* bar, unsigned x, unsigned& nloc, unsigned& nx) {
    const unsigned G = gridDim.x * gridDim.y * gridDim.z;
    unsigned sum, cnt, mine, sp = 0u;
    for (;;) {
        sum = 0u; cnt = 0u; mine = 0u;
#pragma unroll
        for (unsigned j = 0; j < 16; ++j) { const unsigned c = xb_ld(&bar[XB_XCNT(j)]); sum += c; cnt += (c > 0u) ? 1u : 0u; mine = (j == x) ? c : mine; }
        if (sum == G) break;
        __builtin_amdgcn_s_sleep(1);
        if ((++sp & 255u) == 0u) { if (xb_ld(&bar[XB_TMO])) break; if (sp > XB_SPIN_CAP) { atomicAdd(&bar[XB_TMO], 1u); break; } }
    }
    nloc = mine > 0u ? mine : 1u; nx = cnt > 0u ? cnt : 1u;
}
__device__ __forceinline__ void xcd_barrier(const XcdBarrier& b) {
    asm volatile("s_waitcnt vmcnt(0)" ::: "memory");
    __syncthreads();
    if (threadIdx.x == 0) {
        unsigned* bar = b.bar;
        __builtin_amdgcn_s_waitcnt(0);
        unsigned nloc = b.st[0], nx = b.st[1];
        if (nloc == 0u) { xcd_barrier_complete(bar, b.x, nloc, nx); b.st[0] = nloc; b.st[1] = nx; }
        const unsigned old = xb_add(&bar[XB_XSUB(b.x)], 1u);
        const unsigned gen = old / nloc;
        if (old + 1u == (gen + 1u) * nloc) {
            __builtin_amdgcn_fence(__ATOMIC_RELEASE, "agent");
            asm volatile("s_waitcnt vmcnt(0)" ::: "memory");
            const unsigned og = xb_add(&bar[XB_TOP], 1u);
            const unsigned tg = og / nx;
            if (og + 1u == (tg + 1u) * nx) xb_add(&bar[XB_TOPGEN], 1u);
            else XB_SPIN(xb_ld(&bar[XB_TOPGEN]) == tg, bar);
            __builtin_amdgcn_fence(__ATOMIC_ACQUIRE, "agent");
            xb_add(&bar[XB_XGEN(b.x)], 1u);
            asm volatile("s_waitcnt vmcnt(0)" ::: "memory");
        } else {
            XB_SPIN(xb_ld(&bar[XB_XGEN(b.x)]) == gen, bar);
            __builtin_amdgcn_fence(__ATOMIC_ACQUIRE, "agent");
            asm volatile("s_waitcnt vmcnt(0)" ::: "memory");
        }
    }
    __syncthreads();
}

struct Args { const float* in[23]; float* out; unsigned char* ws; int ph_lo, ph_hi; };
enum { I_X = 0, I_C, I_POS, I_WADA, I_BADA, I_GMIX, I_GFFN, I_WIN, I_WOUT, I_LBL, I_ONORM, I_VNG, I_VNB, I_GWS, I_GBS, I_FG, I_FU, I_FD, I_MR, I_MG, I_MU, I_MD, I_GFIN };

__device__ __forceinline__ int opaque_tid() { int t = threadIdx.x; asm volatile("" : "+v"(t)); return t; }
__device__ __forceinline__ int q_next(unsigned* ctr, volatile LAS int* slot) {
    __syncthreads();
    if (threadIdx.x == 0) *slot = (int)__hip_atomic_fetch_add(ctr, 1u, RLX_AGENT);
    __syncthreads();
    return *slot;
}

template <class F>
__device__ __forceinline__ void p0_transpose_item(const float* W, int K, int Nsrc, bf16_t* WT, LAS float* scr, int kb, int nb, int lane, F srccol) {
    const int k0 = 64 * kb, n0 = 32 * nb; const int sc = srccol(n0 + (lane & 31));
#pragma unroll 8
    for (int i = 0; i < 32; ++i) { const int kk = 2 * i + (lane >> 5); scr[kk * 33 + (lane & 31)] = (sc >= 0) ? W[(size_t)(k0 + kk) * Nsrc + sc] : 0.f; }
    asm volatile("s_waitcnt lgkmcnt(0)" ::: "memory");
    const int c = lane & 7;
#pragma unroll
    for (int j = 0; j < 4; ++j) { const int n = (lane >> 3) + 8 * j; const LAS float* s = scr + (8 * c) * 33 + n;
        u32x4 o; o.x = pk2(s[0 * 33], s[1 * 33]); o.y = pk2(s[2 * 33], s[3 * 33]); o.z = pk2(s[4 * 33], s[5 * 33]); o.w = pk2(s[6 * 33], s[7 * 33]);
        *(u32x4*)(WT + (size_t)(n0 + n) * K + k0 + 8 * c) = o; }
    asm volatile("s_waitcnt lgkmcnt(0)" ::: "memory");
}
__device__ __forceinline__ int inproj_srccol(int n) {
    const int t = n >> 8, c = n & 255;
    if (t < 4) { const int half = c >> 7, hh = (c >> 5) & 3, dd = c & 31; const int s = 256 * t + 64 * hh + 32 * half + dd; return (t == 3 && s >= 836) ? -1 : s; }
    if (t < 10) { const int seg = c >> 6, dd = c & 63; return 836 + 384 * seg + 64 * (t - 4) + dd; }
    return 2372 + 256 * (t - 10) + c;
}
__constant__ float ROPE_INV[32] = {1.000000000e+00f, 7.498942018e-01f, 5.623413324e-01f, 4.216965139e-01f, 3.162277639e-01f, 2.371373773e-01f, 1.778279394e-01f, 1.333521456e-01f, 1.000000015e-01f, 7.498942316e-02f, 5.623413250e-02f, 4.216964915e-02f, 3.162277490e-02f, 2.371373773e-02f, 1.778279431e-02f, 1.333521400e-02f, 9.999999776e-03f, 7.498942316e-03f, 5.623413250e-03f, 4.216964822e-03f, 3.162277630e-03f, 2.371373819e-03f, 1.778279431e-03f, 1.333521446e-03f, 1.000000047e-03f, 7.498941850e-04f, 5.623413017e-04f, 4.216965172e-04f, 3.162277571e-04f, 2.371373703e-04f, 1.778279402e-04f, 1.333521504e-04f};

__device__ __forceinline__ void p0_prologue(const Args& A, LAS unsigned char* lds, int vcu, int G) {
    const int tid = opaque_tid0(), lane = tid & 63, wave = __builtin_amdgcn_readfirstlane(tid >> 6);
    unsigned char* ws = A.ws;
    const int gt = vcu * NTHR + tid, NGT = G * NTHR;
    {
        float* CS = (float*)(ws + WS_CS);
        for (int e = gt; e < 6144 * 32; e += NGT) {
            const int p = e >> 5, i = e & 31; const float a = (float)p * ROPE_INV[i];
            const double ad = (double)a; const double kq = __builtin_rint(ad * 0.63661977236758134308); const float y = (float)(ad - kq * 1.57079632679489661923);
            const int q = ((int)kq) & 3; const float y2 = y * y;
            const float sn = y + y * y2 * (-1.6666654611e-1f + y2 * (8.3321608736e-3f + y2 * (-1.9515295891e-4f)));
            const float cn = 1.f - 0.5f * y2 + y2 * y2 * (4.166664568298827e-2f + y2 * (-1.388731625493765e-3f + y2 * 2.443315711809948e-5f));
            const float s = (q == 0) ? sn : (q == 1) ? cn : (q == 2) ? -sn : -cn;
            const float c = (q == 0) ? cn : (q == 1) ? -sn : (q == 2) ? -cn : sn;
            CS[(size_t)p * 64 + i] = c; CS[(size_t)p * 64 + 32 + i] = s;
        }
        float* LB = (float*)(ws + WS_LB);
        for (int e = gt; e < 2 * 384; e += NGT) { const int l = e / 384, j = e % 384; const float l0 = A.in[I_LBL][j], l1 = A.in[I_LBL][384 + j];
            LB[e] = (l == 0) ? 0.f : 1.f / (1.f + expf(l0 - l1)); }
        bf16_t* GW = (bf16_t*)(ws + WS_GW);
        for (int e = gt; e < 2 * 4 * 128 * 128; e += NGT) { const int s = e & 127, t = (e >> 7) & 127; GW[e] = (bf16_t)((s <= t) ? f2bf(A.in[I_GWS][e]) : 0u); }
    }
    if (vcu < 192) {
        LAS float* sc = (LAS float*)lds;
        for (int e = tid; e < NB * DM; e += NTHR) { const float v = A.in[I_C][e]; sc[e] = v * sigmoidf(v); }
        __syncthreads();
        const int l = vcu / 96, n0 = (vcu % 96) * 64, n = n0 + lane;
        const float* W = A.in[I_WADA] + (size_t)l * DM * 6144;
        float acc[32];
#pragma unroll
        for (int b = 0; b < 32; ++b) acc[b] = 0.f;
        for (int k4 = wave * 128; k4 < wave * 128 + 128; k4 += 4) {
            const float w0 = W[(size_t)(k4 + 0) * 6144 + n], w1 = W[(size_t)(k4 + 1) * 6144 + n], w2 = W[(size_t)(k4 + 2) * 6144 + n], w3 = W[(size_t)(k4 + 3) * 6144 + n];
#pragma unroll
            for (int b = 0; b < 32; ++b) { const f32x4 s4 = *(const LAS f32x4*)(sc + b * DM + k4); acc[b] += s4[0] * w0 + s4[1] * w1 + s4[2] * w2 + s4[3] * w3; }
        }
        __syncthreads();
        LAS float* red = (LAS float*)lds;
#pragma unroll
        for (int b = 0; b < 32; ++b) red[(wave * 32 + b) * 64 + lane] = acc[b];
        __syncthreads();
        float* MOD = (float*)(ws + WS_MOD);
        for (int e = tid; e < 32 * 64; e += NTHR) { const int b = e >> 6, j = e & 63; float s = 0.f;
#pragma unroll
            for (int w = 0; w < 8; ++w) s += red[(w * 32 + b) * 64 + j];
            MOD[((size_t)l * 32 + b) * 6144 + n0 + j] = s + A.in[I_BADA][l * 6144 + n0 + j]; }
        __syncthreads();
    }
    LAS float* scr = (LAS float*)(lds + wave * 16384);
    const int gw = vcu * NWAVES + wave, NGW = G * NWAVES;
    constexpr int I_IN = 16 * 96, I_OUT = 16 * 32, I_F1 = 16 * 176, I_F2 = 44 * 32, I_M1 = 16 * 224, I_M2 = 56 * 32;
    constexpr int NITEMS = 2 * I_IN + 2 * I_OUT + I_F1 + I_F2 + 8 * I_M1 + 8 * I_M2;
    for (int it = gw; it < NITEMS; it += NGW) {
        int r = it;
        if (r < 2 * I_IN) { const int l = r / I_IN; r %= I_IN;
            p0_transpose_item(A.in[I_WIN] + (size_t)l * DM * INSRC, DM, INSRC, (bf16_t*)(ws + WS_WIN) + (size_t)l * NIN * DM, scr, r / 96, r % 96, lane, [](int n) { return inproj_srccol(n); }); continue; }
        r -= 2 * I_IN;
        if (r < 2 * I_OUT) { const int l = r / I_OUT; r %= I_OUT;
            p0_transpose_item(A.in[I_WOUT] + (size_t)l * DM * DM, DM, DM, (bf16_t*)(ws + WS_WOUT) + (size_t)l * DM * DM, scr, r / 32, r % 32, lane, [](int n) { return n; }); continue; }
        r -= 2 * I_OUT;
        if (r < I_F1) { const int nb = r % 176; const float* src = ((nb >> 2) & 1) ? A.in[I_FU] : A.in[I_FG];
            p0_transpose_item(src, DM, FD, (bf16_t*)(ws + WS_WF1), scr, r / 176, nb, lane, [](int n) { return 128 * (n >> 8) + (n & 127); }); continue; }
        r -= I_F1;
        if (r < I_F2) { p0_transpose_item(A.in[I_FD], FD, DM, (bf16_t*)(ws + WS_WF2), scr, r / 32, r % 32, lane, [](int n) { return n; }); continue; }
        r -= I_F2;
        if (r < 8 * I_M1) { const int e = r / I_M1; r %= I_M1; const int nb = r % 224; const float* src = (((nb >> 2) & 1) ? A.in[I_MU] : A.in[I_MG]) + (size_t)e * DM * FE;
            p0_transpose_item(src, DM, FE, (bf16_t*)(ws + WS_WM1) + (size_t)e * 7168 * DM, scr, r / 224, nb, lane, [](int n) { return 128 * (n >> 8) + (n & 127); }); continue; }
        r -= 8 * I_M1;
        { const int e = r / I_M2; r %= I_M2;
            p0_transpose_item(A.in[I_MD] + (size_t)e * FE * DM, FE, DM, (bf16_t*)(ws + WS_WM2) + (size_t)e * DM * FE, scr, r / 32, r % 32, lane, [](int n) { return n; }); }
    }
}

__device__ __forceinline__ void norm_phase(const float* x, const float* g, const float* sh, const float* sc, bf16_t* O, int vcu, int G) {
    const int lane = opaque_tid0() & 63, wave = opaque_tid0() >> 6, gw = vcu * NWAVES + wave, NGW = G * NWAVES;
    for (int rb = gw; rb < T / 32; rb += NGW) {
        const int b = (rb * 32) >> 11;
        f32x4 gv[4], sv[4];
#pragma unroll
        for (int j = 0; j < 4; ++j) { const int c = 4 * lane + 256 * j; const f32x4 gg = *(const f32x4*)(g + c), s1 = *(const f32x4*)(sc + (size_t)b * 6144 + c); gv[j] = gg * (s1 + 1.f); sv[j] = *(const f32x4*)(sh + (size_t)b * 6144 + c); }
#pragma unroll 1
        for (int r = 0; r < 32; ++r) {
            const size_t row = (size_t)rb * 32 + r; const f32x4* xr = (const f32x4*)(x + row * DM) + lane;
            f32x4 v[4]; float s = 0.f;
#pragma unroll
            for (int j = 0; j < 4; ++j) { v[j] = xr[64 * j]; s += (v[j][0] * v[j][0] + v[j][1] * v[j][1]) + (v[j][2] * v[j][2] + v[j][3] * v[j][3]); }
            const float rs = 1.f / sqrtf(wave_sum(s) * (1.f / DM) + EPS);
            unsigned long long* o8 = (unsigned long long*)(O + row * DM) + lane;
#pragma unroll
            for (int j = 0; j < 4; ++j) { const f32x4 y = v[j] * rs * gv[j] + sv[j]; o8[64 * j] = (unsigned long long)pk2(y[0], y[1]) | ((unsigned long long)pk2(y[2], y[3]) << 32); }
        }
    }
}
__device__ __forceinline__ void final_norm_phase(float* x, const float* g, int vcu, int G) {
    const int lane = opaque_tid0() & 63, wave = opaque_tid0() >> 6, gw = vcu * NWAVES + wave, NGW = G * NWAVES;
    f32x4 gv[4];
#pragma unroll
    for (int j = 0; j < 4; ++j) gv[j] = *(const f32x4*)(g + 4 * lane + 256 * j);
    for (int row = gw; row < T; row += NGW) {
        f32x4* xr = (f32x4*)(x + (size_t)row * DM) + lane;
        f32x4 v[4]; float s = 0.f;
#pragma unroll
        for (int j = 0; j < 4; ++j) { v[j] = xr[64 * j]; s += (v[j][0] * v[j][0] + v[j][1] * v[j][1]) + (v[j][2] * v[j][2] + v[j][3] * v[j][3]); }
        const float rs = 1.f / sqrtf(wave_sum(s) * (1.f / DM) + EPS);
#pragma unroll
        for (int j = 0; j < 4; ++j) xr[64 * j] = v[j] * rs * gv[j];
    }
}
__device__ __forceinline__ void norm_route_phase(const float* x, const float* g, const float* sh, const float* sc, const float* wr_, bf16_t* O, int* TOK, unsigned* cnt, LAS unsigned char* lds, int vcu, int G) {
    const int tid = opaque_tid0(), lane = tid & 63, wave = tid >> 6;
    LAS float* WR = (LAS float*)lds;
    LAS int* lcnt = (LAS int*)(lds + 32768);
    LAS int* lbase = (LAS int*)(lds + 32768 + 64);
    LAS int* tinfo = (LAS int*)(lds + 32768 + 128);
    for (int e = tid; e < DM * NE; e += NTHR) WR[e] = wr_[e];
    for (int blk = vcu; blk < T / 256; blk += G) {
        __syncthreads();
        if (tid < 16) lcnt[tid] = 0;
        __syncthreads();
        const int b = (blk * 256) >> 11;
        f32x4 gv[4], sv[4];
#pragma unroll
        for (int j = 0; j < 4; ++j) { const int c = 4 * lane + 256 * j; const f32x4 gg = *(const f32x4*)(g + c), s1 = *(const f32x4*)(sc + (size_t)b * 6144 + c); gv[j] = gg * (s1 + 1.f); sv[j] = *(const f32x4*)(sh + (size_t)b * 6144 + c); }
#pragma unroll 1
        for (int r = 0; r < 32; ++r) {
            const int tl = wave * 32 + r; const size_t row = (size_t)blk * 256 + tl; const f32x4* xr = (const f32x4*)(x + row * DM) + lane;
            f32x4 v[4]; float s = 0.f;
#pragma unroll
            for (int j = 0; j < 4; ++j) { v[j] = xr[64 * j]; s += (v[j][0] * v[j][0] + v[j][1] * v[j][1]) + (v[j][2] * v[j][2] + v[j][3] * v[j][3]); }
            const float rs = 1.f / sqrtf(wave_sum(s) * (1.f / DM) + EPS);
            unsigned long long* o8 = (unsigned long long*)(O + row * DM) + lane;
            float lg[8];
#pragma unroll
            for (int e = 0; e < 8; ++e) lg[e] = 0.f;
#pragma unroll
            for (int j = 0; j < 4; ++j) { const f32x4 y = v[j] * rs * gv[j] + sv[j]; o8[64 * j] = (unsigned long long)pk2(y[0], y[1]) | ((unsigned long long)pk2(y[2], y[3]) << 32);
#pragma unroll
                for (int q = 0; q < 4; ++q) { const LAS f32x4* wp = (const LAS f32x4*)(WR + (size_t)(4 * lane + 256 * j + q) * 8); const f32x4 wa = wp[0], wb = wp[1];
                    lg[0] += y[q] * wa[0]; lg[1] += y[q] * wa[1]; lg[2] += y[q] * wa[2]; lg[3] += y[q] * wa[3]; lg[4] += y[q] * wb[0]; lg[5] += y[q] * wb[1]; lg[6] += y[q] * wb[2]; lg[7] += y[q] * wb[3]; } }
#pragma unroll
            for (int e = 0; e < 8; ++e) lg[e] = wave_sum(lg[e]);
            if (lane == 0) {
                int e0 = 0; float v0 = lg[0];
#pragma unroll
                for (int e = 1; e < 8; ++e) if (lg[e] > v0) { v0 = lg[e]; e0 = e; }
                int e1 = -1; float v1 = -3.0e38f;
#pragma unroll
                for (int e = 0; e < 8; ++e) if (e != e0 && lg[e] > v1) { v1 = lg[e]; e1 = e; }
                const float w1 = fast_exp(v1 - v0), g0 = 1.f / (1.f + w1), g1 = w1 * g0;
                const int p0 = atomicAdd((int*)&lcnt[e0], 1), p1 = atomicAdd((int*)&lcnt[8 + e1], 1);
                tinfo[tl * 6 + 0] = e0; tinfo[tl * 6 + 1] = e1; tinfo[tl * 6 + 2] = p0; tinfo[tl * 6 + 3] = p1; tinfo[tl * 6 + 4] = __builtin_bit_cast(int, g0); tinfo[tl * 6 + 5] = __builtin_bit_cast(int, g1);
            }
        }
        __syncthreads();
        if (tid < 16) lbase[tid] = (int)__hip_atomic_fetch_add(cnt + 64 * tid, (unsigned)lcnt[tid], RLX_AGENT);
        __syncthreads();
        if (tid < 256) { int* o = TOK + ((size_t)blk * 256 + tid) * 8; const int e0 = tinfo[tid * 6], e1 = tinfo[tid * 6 + 1];
            o[0] = e0; o[1] = e1; o[2] = tinfo[tid * 6 + 2] + lbase[e0]; o[3] = tinfo[tid * 6 + 3] + lbase[8 + e1]; o[4] = tinfo[tid * 6 + 4]; o[5] = tinfo[tid * 6 + 5]; }
    }
}
__device__ __forceinline__ void moe_prefix(unsigned* cnt, int k, LAS int* tp) {
    if (opaque_tid0() == 0) { int a = 0; for (int e = 0; e < 8; ++e) { tp[e] = a; a += ((int)__hip_atomic_load(cnt + 64 * (k * 8 + e), RLX_AGENT) + 255) >> 8; } tp[8] = a; }
    __syncthreads();
}
__device__ __forceinline__ void moe_gather_phase(const bf16_t* HB, bf16_t* HS, const int* TOK, int* RI, unsigned* cnt, LAS unsigned char* lds, int vcu, int G) {
    const int tid = opaque_tid0(), lane = tid & 63, wave = tid >> 6, gw = vcu * NWAVES + wave, NGW = G * NWAVES;
    LAS int* tp = (LAS int*)lds;
    moe_prefix(cnt, 0, tp); moe_prefix(cnt, 1, tp + 9);
    for (int tok = gw; tok < T; tok += NGW) {
        const int* ti = TOK + (size_t)tok * 8;
        const u32x4 a = *((const u32x4*)(HB + (size_t)tok * DM) + lane), b = *((const u32x4*)(HB + (size_t)tok * DM) + 64 + lane);
#pragma unroll
        for (int k = 0; k < 2; ++k) { const int e = ti[k], row = 256 * tp[k * 9 + e] + ti[2 + k];
            u32x4* d = (u32x4*)(HS + ((size_t)k * HSROWS + row) * DM); d[lane] = a; d[64 + lane] = b;
            if (lane == 0) { RI[((size_t)k * HSROWS + row) * 2] = tok; RI[((size_t)k * HSROWS + row) * 2 + 1] = ti[4 + k]; } }
    }
    for (int it = vcu; it < 16; it += G) { const int k = it >> 3, e = it & 7; const int c = (int)__hip_atomic_load(cnt + 64 * it, RLX_AGENT), base = 256 * tp[k * 9 + e];
        for (int r = c + tid; r < ((c + 255) & ~255); r += NTHR) RI[((size_t)k * HSROWS + base + r) * 2] = -1; }
}

typedef f32x16 acc16;
__device__ __forceinline__ acc16 zero16() { acc16 z;
#pragma unroll
    for (int i = 0; i < 16; ++i) z[i] = 0.f; return z; }
#define MFMA32(a, b, c) __builtin_amdgcn_mfma_f32_32x32x16_bf16((a), (b), (c), 0, 0, 0)
__device__ __forceinline__ bf16x8 ld_lds8(const LAS bf16_t* p) { return *(const LAS bf16x8*)p; }

struct MixPtrs { const bf16_t *QA, *KA, *VAT, *IQ, *IK; const float* IW; const bf16_t *HQ, *HKK, *HI, *HG; const float* HLF; const bf16_t *GU, *GV; unsigned long long* BM; bf16_t* MIX; };

__device__ __forceinline__ void hgrn_unit(LAS unsigned char* lds, const MixPtrs& P, int b, int h, const float* onorm) {
    const int tid = opaque_tid0(), lane = tid & 63, w = tid >> 6, l32 = lane & 31, hh = lane >> 5;
    LAS float* BC = (LAS float*)lds;
    LAS float* GT = (LAS float*)(lds + 16384);
    LAS bf16_t* QA_ = (LAS bf16_t*)(lds + 18432);
    LAS bf16_t* KA_ = (LAS bf16_t*)(lds + 27648);
    LAS bf16_t* QB_ = (LAS bf16_t*)(lds + 36864);
    LAS bf16_t* KB_ = (LAS bf16_t*)(lds + 41472);
    LAS bf16_t* QE_ = (LAS bf16_t*)(lds + 46080);
    LAS bf16_t* KST = (LAS bf16_t*)(lds + 55296);
    LAS bf16_t* VT_ = (LAS bf16_t*)(lds + 64512);
    LAS bf16_t* AM_ = (LAS bf16_t*)(lds + 73728);
    LAS float* ST_ = (LAS float*)(lds + 82944);
    LAS float* OO_ = (LAS float*)(lds + 100352);
    for (int e = tid; e < 64 * 68; e += NTHR) ST_[e] = 0.f;
    const int te = tid >> 3, d0 = (tid & 7) * 8;
    const size_t rowb = (size_t)b * SEQ;
    float og[8];
#pragma unroll
    for (int i = 0; i < 8; ++i) og[i] = onorm[d0 + i];
    float nlf[8]; u32x4 nq, nk, nv, ng;
    {
#pragma unroll
        for (int i = 0; i < 8; ++i) nlf[i] = P.HLF[((rowb + 8 * w + i) * 6 + h) * 64 + lane];
        const size_t o = ((rowb + te) * 6 + h) * 64 + d0; nq = *(const u32x4*)(P.HQ + o); nk = *(const u32x4*)(P.HKK + o); nv = *(const u32x4*)(P.HI + o); ng = *(const u32x4*)(P.HG + o);
    }
    for (int c = 0; c < 32; ++c) {
        float lf[8]; u32x4 cq = nq, ck = nk, cv = nv, cg = ng;
#pragma unroll
        for (int i = 0; i < 8; ++i) lf[i] = nlf[i];
        if (c + 1 < 32) {
            const size_t r1 = rowb + (size_t)(c + 1) * 64;
#pragma unroll
            for (int i = 0; i < 8; ++i) nlf[i] = P.HLF[((r1 + 8 * w + i) * 6 + h) * 64 + lane];
            const size_t o = ((r1 + te) * 6 + h) * 64 + d0; nq = *(const u32x4*)(P.HQ + o); nk = *(const u32x4*)(P.HKK + o); nv = *(const u32x4*)(P.HI + o); ng = *(const u32x4*)(P.HG + o);
        }
#pragma unroll
        for (int i = 1; i < 8; ++i) lf[i] += lf[i - 1];
        GT[w * 64 + lane] = lf[7];
        __syncthreads();
        { float off = 0.f;
#pragma unroll
            for (int ww = 0; ww < 7; ++ww) off += (ww < w) ? GT[ww * 64 + lane] : 0.f;
#pragma unroll
            for (int i = 0; i < 8; ++i) BC[(8 * w + i) * 64 + lane] = lf[i] + off; }
        __syncthreads();
        {
            const f32x4 ba = *(const LAS f32x4*)(BC + te * 64 + d0), bb = *(const LAS f32x4*)(BC + te * 64 + d0 + 4);
            const int rr = (te < 32) ? 16 : 48;
            const f32x4 ra = *(const LAS f32x4*)(BC + rr * 64 + d0), rb = *(const LAS f32x4*)(BC + rr * 64 + d0 + 4);
            const f32x4 ma = *(const LAS f32x4*)(BC + 31 * 64 + d0), mb = *(const LAS f32x4*)(BC + 31 * 64 + d0 + 4);
            const f32x4 la = *(const LAS f32x4*)(BC + 63 * 64 + d0), lb_ = *(const LAS f32x4*)(BC + 63 * 64 + d0 + 4);
            float q[8], k[8], bt[8], rf[8], md[8], ls[8];
#pragma unroll
            for (int i = 0; i < 4; ++i) { q[2 * i] = bf2f((unsigned short)(cq[i] & 0xffff)); q[2 * i + 1] = bf2f((unsigned short)(cq[i] >> 16)); k[2 * i] = bf2f((unsigned short)(ck[i] & 0xffff)); k[2 * i + 1] = bf2f((unsigned short)(ck[i] >> 16)); }
#pragma unroll
            for (int i = 0; i < 4; ++i) { bt[i] = ba[i]; bt[4 + i] = bb[i]; rf[i] = ra[i]; rf[4 + i] = rb[i]; md[i] = ma[i]; md[4 + i] = mb[i]; ls[i] = la[i]; ls[4 + i] = lb_[i]; }
            float qa[8], ka[8], qe[8], xb[8], ks[8];
#pragma unroll
            for (int i = 0; i < 8; ++i) { qa[i] = q[i] * fast_exp(bt[i] - rf[i]); ka[i] = k[i] * fast_exp(rf[i] - bt[i]); qe[i] = q[i] * fast_exp(bt[i]);
                xb[i] = (te < 32) ? k[i] * fast_exp(md[i] - bt[i]) : q[i] * fast_exp(bt[i] - md[i]); ks[i] = k[i] * fast_exp(ls[i] - bt[i]); }
            u32x4 pq, pk, pe, px;
#pragma unroll
            for (int i = 0; i < 4; ++i) { pq[i] = pk2(qa[2 * i], qa[2 * i + 1]); pk[i] = pk2(ka[2 * i], ka[2 * i + 1]); pe[i] = pk2(qe[2 * i], qe[2 * i + 1]); px[i] = pk2(xb[2 * i], xb[2 * i + 1]); }
            *(LAS u32x4*)(QA_ + te * 72 + d0) = pq; *(LAS u32x4*)(KA_ + te * 72 + d0) = pk; *(LAS u32x4*)(QE_ + te * 72 + d0) = pe;
            if (te < 32) *(LAS u32x4*)(KB_ + te * 72 + d0) = px; else *(LAS u32x4*)(QB_ + (te - 32) * 72 + d0) = px;
#pragma unroll
            for (int i = 0; i < 8; ++i) KST[(d0 + i) * 72 + te] = (bf16_t)f2bf(ks[i]);
#pragma unroll
            for (int i = 0; i < 4; ++i) { VT_[(d0 + 2 * i) * 72 + te] = (bf16_t)(cv[i] & 0xffff); VT_[(d0 + 2 * i + 1) * 72 + te] = (bf16_t)(cv[i] >> 16); }
        }
        __syncthreads();
        acc16 oacc = zero16();
        if (w < 3) {
            const LAS bf16_t* Qs = (w == 0) ? QA_ : (w == 1) ? QA_ + 32 * 72 : QB_;
            const LAS bf16_t* Ks = (w == 0) ? KA_ : (w == 1) ? KA_ + 32 * 72 : KB_;
            acc16 a = zero16();
#pragma unroll
            for (int kk = 0; kk < 4; ++kk) a = MFMA32(ld_lds8(Qs + l32 * 72 + 8 * hh + 16 * kk), ld_lds8(Ks + l32 * 72 + 8 * hh + 16 * kk), a);
            const int tb = (w == 0) ? 0 : 32, sb = (w == 1) ? 32 : 0;
#pragma unroll
            for (int i = 0; i < 16; ++i) { const int tl = 8 * (i >> 2) + 4 * hh + (i & 3); const float v = (w < 2 && l32 > tl) ? 0.f : a[i]; AM_[(tb + tl) * 72 + sb + l32] = (bf16_t)f2bf(v); }
        } else if (w < 7) {
            const int th = (w - 3) >> 1, vh = (w - 3) & 1;
#pragma unroll
            for (int kk = 0; kk < 4; ++kk) {
                const LAS float* sp = ST_ + (vh * 32 + l32) * 68 + 8 * hh + 16 * kk; const f32x4 s0 = *(const LAS f32x4*)sp, s1 = *(const LAS f32x4*)(sp + 4);
                u32x4 sbv; sbv[0] = pk2(s0[0], s0[1]); sbv[1] = pk2(s0[2], s0[3]); sbv[2] = pk2(s1[0], s1[1]); sbv[3] = pk2(s1[2], s1[3]);
                oacc = MFMA32(ld_lds8(QE_ + (th * 32 + l32) * 72 + 8 * hh + 16 * kk), __builtin_bit_cast(bf16x8, sbv), oacc);
            }
        }
        __syncthreads();
        if (w >= 3 && w < 7) {
            const int th = (w - 3) >> 1, vh = (w - 3) & 1; const int nk = th ? 4 : 2;
            for (int kk = 0; kk < nk; ++kk) oacc = MFMA32(ld_lds8(AM_ + (th * 32 + l32) * 72 + 8 * hh + 16 * kk), ld_lds8(VT_ + (vh * 32 + l32) * 72 + 8 * hh + 16 * kk), oacc);
#pragma unroll
            for (int i = 0; i < 16; ++i) { const int tl = 8 * (i >> 2) + 4 * hh + (i & 3); OO_[(th * 32 + tl) * 68 + vh * 32 + l32] = oacc[i]; }
        } else {
            const int idx = (w == 7) ? 3 : w, vh = idx >> 1, dh = idx & 1;
            acc16 a = zero16();
#pragma unroll
            for (int kk = 0; kk < 4; ++kk) a = MFMA32(ld_lds8(VT_ + (vh * 32 + l32) * 72 + 8 * hh + 16 * kk), ld_lds8(KST + (dh * 32 + l32) * 72 + 8 * hh + 16 * kk), a);
            const float dec = fast_exp(BC[63 * 64 + dh * 32 + l32]);
#pragma unroll
            for (int i = 0; i < 16; ++i) { const int vl = 8 * (i >> 2) + 4 * hh + (i & 3); LAS float* sp = ST_ + (vh * 32 + vl) * 68 + dh * 32 + l32; *sp = dec * (*sp) + a[i]; }
        }
        __syncthreads();
        {
            const f32x4 oa = *(const LAS f32x4*)(OO_ + te * 68 + d0), ob = *(const LAS f32x4*)(OO_ + te * 68 + d0 + 4);
            float ss = (oa[0] * oa[0] + oa[1] * oa[1]) + (oa[2] * oa[2] + oa[3] * oa[3]) + (ob[0] * ob[0] + ob[1] * ob[1]) + (ob[2] * ob[2] + ob[3] * ob[3]);
            ss += __shfl_xor(ss, 1); ss += __shfl_xor(ss, 2); ss += __shfl_xor(ss, 4);
            const float rs = 1.f / sqrtf(ss * (1.f / 64.f) + EPS);
            float r[8];
#pragma unroll
            for (int i = 0; i < 4; ++i) { r[i] = oa[i] * rs * og[i]; r[4 + i] = ob[i] * rs * og[4 + i]; }
#pragma unroll
            for (int i = 0; i < 4; ++i) { r[2 * i] *= bf2f((unsigned short)(cg[i] & 0xffff)); r[2 * i + 1] *= bf2f((unsigned short)(cg[i] >> 16)); }
            u32x4 o; o[0] = pk2(r[0], r[1]); o[1] = pk2(r[2], r[3]); o[2] = pk2(r[4], r[5]); o[3] = pk2(r[6], r[7]);
            *(u32x4*)(P.MIX + (rowb + (size_t)c * 64 + te) * DM + 384 + h * 64 + d0) = o;
        }
    }
}

__device__ __forceinline__ void gmlp_unit(LAS unsigned char* lds, const MixPtrs& P, int b, int n, const float* vng, const float* vnb, const bf16_t* GW, const float* gbs) {
    const int tid = opaque_tid0(), lane = tid & 63, w = tid >> 6, l32 = lane & 31, hh = lane >> 5;
    LAS bf16_t* VT = (LAS bf16_t*)lds;
    const size_t row0 = (size_t)b * SEQ + (size_t)n * 128;
    {
        const int s = 16 * w + (lane >> 2), c0 = 64 * (lane & 3);
        float x[64];
#pragma unroll
        for (int i = 0; i < 8; ++i) { const u32x4 v = *(const u32x4*)(P.GV + (row0 + s) * 256 + c0 + 8 * i);
#pragma unroll
            for (int j = 0; j < 4; ++j) { x[8 * i + 2 * j] = bf2f((unsigned short)(v[j] & 0xffff)); x[8 * i + 2 * j + 1] = bf2f((unsigned short)(v[j] >> 16)); } }
        float sm = 0.f;
#pragma unroll
        for (int i = 0; i < 64; ++i) sm += x[i];
        sm += __shfl_xor(sm, 1); sm += __shfl_xor(sm, 2);
        const float mu = sm * (1.f / 256.f); float vq = 0.f;
#pragma unroll
        for (int i = 0; i < 64; ++i) { x[i] -= mu; vq += x[i] * x[i]; }
        vq += __shfl_xor(vq, 1); vq += __shfl_xor(vq, 2);
        const float rs = 1.f / sqrtf(vq * (1.f / 256.f) + EPS);
#pragma unroll
        for (int i = 0; i < 64; ++i) VT[(c0 + i) * 136 + s] = (bf16_t)f2bf(x[i] * rs * vng[c0 + i] + vnb[c0 + i]);
    }
    __syncthreads();
    const int g = w >> 1, db = w & 1;
    acc16 acc[4];
#pragma unroll
    for (int tb = 0; tb < 4; ++tb) { acc[tb] = zero16();
#pragma unroll
        for (int kk = 0; kk < 8; ++kk) if (kk < 2 * (tb + 1))
            acc[tb] = MFMA32(*(const bf16x8*)(GW + ((size_t)g * 128 + tb * 32 + l32) * 128 + 8 * hh + 16 * kk), ld_lds8(VT + (g * 64 + db * 32 + l32) * 136 + 8 * hh + 16 * kk), acc[tb]); }
    const int cch = g * 64 + db * 32 + l32;
#pragma unroll
    for (int tb = 0; tb < 4; ++tb)
#pragma unroll
        for (int i = 0; i < 16; ++i) { const int t = tb * 32 + 8 * (i >> 2) + 4 * hh + (i & 3);
            const float u = bf2f(P.GU[(row0 + t) * 256 + cch]);
            P.MIX[(row0 + t) * DM + 768 + cch] = (bf16_t)f2bf(u * (acc[tb][i] + gbs[g * 128 + t])); }
}

constexpr int SC_STRIDE = 2052;
__device__ __forceinline__ void dsa_select_unit(LAS unsigned char* lds, const MixPtrs& P, int b, int j) {
    const int tid = opaque_tid0(), lane = tid & 63, w = tid >> 6, l32 = lane & 31, hh = lane >> 5;
    LAS unsigned short* SC = (LAS unsigned short*)lds;
    const size_t rowb = (size_t)b * SEQ;
    {
        bf16x8 qf[4][4];
        const size_t qrow = rowb + (size_t)j * 32 + l32;
#pragma unroll
        for (int hd = 0; hd < 4; ++hd)
#pragma unroll
            for (int kk = 0; kk < 4; ++kk) qf[hd][kk] = *(const bf16x8*)(P.IQ + (qrow * 4 + hd) * 64 + 8 * hh + 16 * kk);
        f32x4 iw = *(const f32x4*)(P.IW + qrow * 4); iw *= 0.5f;
        for (int kt = w; kt <= j; kt += 8) {
            bf16x8 kf[4];
#pragma unroll
            for (int kk = 0; kk < 4; ++kk) kf[kk] = *(const bf16x8*)(P.IK + (rowb + (size_t)kt * 32 + l32) * 64 + 8 * hh + 16 * kk);
            acc16 a[4];
#pragma unroll
            for (int hd = 0; hd < 4; ++hd) { a[hd] = zero16();
#pragma unroll
                for (int kk = 0; kk < 4; ++kk) a[hd] = MFMA32(kf[kk], qf[hd][kk], a[hd]); }
#pragma unroll
            for (int gq = 0; gq < 4; ++gq) {
                unsigned short ky[4];
#pragma unroll
                for (int i4 = 0; i4 < 4; ++i4) { const int i = 4 * gq + i4;
                    float sc = iw[0] * fmaxf(a[0][i] * 0.125f, 0.f) + iw[1] * fmaxf(a[1][i] * 0.125f, 0.f) + iw[2] * fmaxf(a[2][i] * 0.125f, 0.f) + iw[3] * fmaxf(a[3][i] * 0.125f, 0.f);
                    sc = fminf(fmaxf(sc, -60000.f), 60000.f);
                    const unsigned short hb = __builtin_bit_cast(unsigned short, (_Float16)sc);
                    unsigned short key = (hb & 0x8000) ? (unsigned short)~hb : (unsigned short)(hb | 0x8000);
                    if (kt == j && (8 * gq + 4 * hh + i4) > l32) key = 0;
                    ky[i4] = key; }
                u32x2 pk; pk[0] = (unsigned)ky[0] | ((unsigned)ky[1] << 16); pk[1] = (unsigned)ky[2] | ((unsigned)ky[3] << 16);
                *(LAS u32x2*)(SC + l32 * SC_STRIDE + kt * 32 + 8 * gq + 4 * hh) = pk;
            }
        }
    }
    __syncthreads();
    const int NK = 32 * (j + 1), Mw = (j + 2) >> 1;
    for (int r = 0; r < 4; ++r) {
        const int q = 4 * w + r, t = 32 * j + q;
        unsigned k[32];
#pragma unroll
        for (int m = 0; m < 32; ++m) { k[m] = 0u; if (m < Mw) { const int s = 64 * m + lane; k[m] = (s < NK) ? (unsigned)SC[q * SC_STRIDE + s] : 0u; } }
        unsigned long long myw = 0ull;
        if (t + 1 <= 256) {
#pragma unroll
            for (int m = 0; m < 32; ++m) if (m < Mw) { const unsigned long long bm = __ballot(64 * m + lane <= t); if (lane == m) myw = bm; }
        } else {
            unsigned v = 0u;
            for (int bit = 15; bit >= 0; --bit) { const unsigned cand = v | (1u << bit); int cnt = 0;
#pragma unroll
                for (int m = 0; m < 32; ++m) if (m < Mw) cnt += __popcll(__ballot(k[m] >= cand));
                if (cnt >= 256) v = cand; }
            int ngt = 0;
#pragma unroll
            for (int m = 0; m < 32; ++m) if (m < Mw) ngt += __popcll(__ballot(k[m] > v));
            int need = 256 - ngt;
#pragma unroll
            for (int m = 0; m < 32; ++m) if (m < Mw) {
                const unsigned long long gtm = __ballot(k[m] > v), eqm = __ballot(k[m] == v);
                unsigned long long sel = 0ull; const int c = __popcll(eqm);
                if (need > 0) { if (c <= need) { sel = eqm; need -= c; }
                    else { const int pre = __builtin_amdgcn_mbcnt_hi((unsigned)(eqm >> 32), __builtin_amdgcn_mbcnt_lo((unsigned)eqm, 0u)); sel = __ballot(((eqm >> lane) & 1ull) && pre < need); need = 0; } }
                if (lane == m) myw = gtm | sel; }
        }
        if (lane < 32) P.BM[(rowb + t) * 32 + lane] = myw;
    }
}

constexpr int QL_STRIDE = 392;
__device__ __forceinline__ void dsa_attn_unit(LAS unsigned char* lds, const MixPtrs& P, int b, int J, float kmaxn) {
    const int tid = opaque_tid0(), lane = tid & 63, w = tid >> 6, qi = lane & 31, hh = lane >> 5;
    LAS bf16_t* KT = (LAS bf16_t*)lds;
    LAS bf16_t* VTT = (LAS bf16_t*)(lds + 2 * 64 * 72 * 2);
    LAS bf16_t* QL = (LAS bf16_t*)(lds + 4 * 64 * 72 * 2);
    const int qblk = w >> 1, hs = (w & 1) * 3;
    const size_t rowb = (size_t)b * SEQ; const int t = 128 * J + 32 * qblk + qi; const size_t row = rowb + t;
    for (int e = tid; e < 128 * 48; e += NTHR) { const int r = e / 48, p = e % 48; *(LAS u32x4*)(QL + r * QL_STRIDE + 8 * p) = *(const u32x4*)(P.QA + (rowb + (size_t)128 * J + r) * 384 + 8 * p); }
    __syncthreads();
    const LAS bf16_t* qp = QL + (32 * qblk + qi) * QL_STRIDE + hs * 64 + 8 * hh;
    float negb[3];
#pragma unroll
    for (int h3 = 0; h3 < 3; ++h3) { float ss = 0.f;
#pragma unroll
        for (int kk = 0; kk < 4; ++kk) { const bf16x8 q8 = ld_lds8(qp + h3 * 64 + 16 * kk);
#pragma unroll
            for (int e = 0; e < 8; ++e) { const float f = bf2f((unsigned short)q8[e]); ss += f * f; } }
        ss += __shfl_xor(ss, 32);
        negb[h3] = -(sqrtf(ss) * kmaxn * 1.02f + 1e-3f); }
    acc16 O[3][2]; float lsum[3];
#pragma unroll
    for (int h3 = 0; h3 < 3; ++h3) { O[h3][0] = zero16(); O[h3][1] = zero16(); lsum[h3] = 0.f; }
    const int nt = 2 * (J + 1);
    const int lr = tid >> 3, lp = (tid & 7) * 8;
    u32x4 rk = *(const u32x4*)(P.KA + (rowb + lr) * 64 + lp), rv = *(const u32x4*)(P.VAT + ((size_t)b * 64 + lr) * 2048 + lp);
    unsigned long long mw = P.BM[row * 32 + 0];
#pragma unroll 1
    for (int tile = 0; tile < nt; ++tile) {
        const int buf = tile & 1;
        *(LAS u32x4*)(KT + (buf * 64 + lr) * 72 + lp) = rk; *(LAS u32x4*)(VTT + (buf * 64 + lr) * 72 + lp) = rv;
        const unsigned long long cmw = mw;
        __syncthreads();
        if (tile + 1 < nt) { rk = *(const u32x4*)(P.KA + (rowb + (size_t)(tile + 1) * 64 + lr) * 64 + lp); rv = *(const u32x4*)(P.VAT + ((size_t)b * 64 + lr) * 2048 + (tile + 1) * 64 + lp); mw = P.BM[row * 32 + tile + 1]; }
#pragma unroll
        for (int sub = 0; sub < 2; ++sub) {
            const int msh = (int)((unsigned)(cmw >> (32 * sub)) >> (4 * hh));
            const LAS bf16_t* kp = KT + (buf * 64 + sub * 32 + qi) * 72 + 8 * hh;
            const LAS bf16_t* vp = VTT + (buf * 64 + qi) * 72 + sub * 32 + 4 * hh;
#pragma unroll
            for (int h3 = 0; h3 < 3; ++h3) {
                asm volatile("" ::: "memory"); __builtin_amdgcn_sched_barrier(0);
                acc16 s;
#pragma unroll
                for (int i = 0; i < 16; ++i) s[i] = negb[h3];
#pragma unroll
                for (int kk = 0; kk < 4; ++kk) s = MFMA32(ld_lds8(kp + 16 * kk), ld_lds8(qp + h3 * 64 + 16 * kk), s);
#pragma unroll
                for (int s2 = 0; s2 < 2; ++s2) {
                    float p[8];
#pragma unroll
                    for (int i = 0; i < 8; ++i) { const int ii = 8 * s2 + i; p[i] = __builtin_bit_cast(float, __builtin_bit_cast(int, __builtin_amdgcn_exp2f(s[ii])) & __builtin_amdgcn_sbfe(msh, 8 * (ii >> 2) + (ii & 3), 1)); lsum[h3] += p[i]; }
                    u32x4 pp;
#pragma unroll
                    for (int i = 0; i < 4; ++i) pp[i] = pk2(p[2 * i], p[2 * i + 1]);
#pragma unroll
                    for (int db = 0; db < 2; ++db) { const u32x2 lo = *(const LAS u32x2*)(vp + db * 32 * 72 + 16 * s2), hi = *(const LAS u32x2*)(vp + db * 32 * 72 + 16 * s2 + 8);
                        u32x4 c; c[0] = lo[0]; c[1] = lo[1]; c[2] = hi[0]; c[3] = hi[1];
                        O[h3][db] = MFMA32(__builtin_bit_cast(bf16x8, c), __builtin_bit_cast(bf16x8, pp), O[h3][db]); }
                }
            }
        }
    }
#pragma unroll
    for (int h3 = 0; h3 < 3; ++h3) {
        float l = lsum[h3]; l += __shfl_xor(l, 32); const float inv = 1.f / l;
#pragma unroll
        for (int db = 0; db < 2; ++db)
#pragma unroll
            for (int gq = 0; gq < 4; ++gq) { u32x2 o; o[0] = pk2(O[h3][db][4 * gq] * inv, O[h3][db][4 * gq + 1] * inv); o[1] = pk2(O[h3][db][4 * gq + 2] * inv, O[h3][db][4 * gq + 3] * inv);
                *(u32x2*)(P.MIX + row * DM + (hs + h3) * 64 + db * 32 + 8 * gq + 4 * hh) = o; }
    }
    __syncthreads();
}

__device__ __forceinline__ unsigned char* launder(unsigned char* p) { asm volatile("" : "+s"(p)); return p; }
__device__ __forceinline__ MixPtrs make_mp(unsigned char* ws) {
    MixPtrs MP;
    MP.QA = (bf16_t*)(ws + WS_QA); MP.KA = (bf16_t*)(ws + WS_KA); MP.VAT = (bf16_t*)(ws + WS_VAT); MP.IQ = (bf16_t*)(ws + WS_IQ); MP.IK = (bf16_t*)(ws + WS_IK); MP.IW = (float*)(ws + WS_IW);
    MP.HQ = (bf16_t*)(ws + WS_HQ); MP.HKK = (bf16_t*)(ws + WS_HKK); MP.HI = (bf16_t*)(ws + WS_HI); MP.HG = (bf16_t*)(ws + WS_HG); MP.HLF = (float*)(ws + WS_HLF);
    MP.GU = (bf16_t*)(ws + WS_GU); MP.GV = (bf16_t*)(ws + WS_GV); MP.BM = (unsigned long long*)(ws + WS_BM); MP.MIX = (bf16_t*)(ws + WS_ACT1);
    return MP;
}
constexpr int NPH = 26;
__global__ void __launch_bounds__(NTHR, 2) fwd_kernel(Args args) {
    extern __shared__ __attribute__((aligned(16))) unsigned char lds_raw[];
    LAS unsigned char* lds = (LAS unsigned char*)lds_raw;
    volatile LAS unsigned* MISC = (volatile LAS unsigned*)(lds + LDS_MISC);
    const int tid = opaque_tid0();
    const int G = gridDim.x; const int bx = blockIdx.x; const int vcu = (G % 8 == 0) ? (bx % 8) * (G / 8) + bx / 8 : bx;
    unsigned char* ws = args.ws;
    unsigned* ctl = (unsigned*)(ws + WS_CTL);
    if (tid < 64) MISC[tid] = 0u;
    __syncthreads();
    XcdBarrier bar = xcd_barrier_post(ctl + CW_BAR, MISC + 8);
    volatile LAS int* qslot = (volatile LAS int*)(MISC + 16);
    LAS int* tpl = (LAS int*)(lds + LDS_MISC + 128);
    const int lo = args.ph_lo, hi = args.ph_hi;
#ifndef PHMASK
#define PHMASK 0xFFFFFFFFu
#endif
#define PH(k) (lo <= (k) && (k) < hi)
#define PHM(j) ((PHMASK >> ((j) + 1)) & 1u)
#define PHL(j) (PHM(j) && PH(pb + (j)))
#define SEAM(k) do { if ((k) + 1 < hi) xcd_barrier(bar); } while (0)
    if ((PHMASK & 1u) && PH(0)) { p0_prologue(args, lds, vcu, G); SEAM(0); }

    for (int l = 0; l < 2; ++l) {
        const int pb = 1 + 12 * l;
        if (PHL(0)) { unsigned char* w = launder(ws); const float* modl = (const float*)(w + WS_MOD) + (size_t)l * 32 * 6144;
            norm_phase((l == 0) ? args.in[I_X] : args.out, args.in[I_GMIX] + l * DM, modl + 0, modl + 1024, (bf16_t*)(w + WS_ACT1), vcu, G); SEAM(pb + 0); }
        if (PHL(1)) {
            unsigned char* w = launder(ws); const MixPtrs MP = make_mp(w);
            pg8::Gemm g{(const bf16_t*)(w + WS_ACT1), (const bf16_t*)(w + WS_WIN) + (size_t)l * NIN * DM, T, NIN, DM}; pg8::StaticOrder S; S.init(T, NIN, G, bx);
            EpiInproj E; E.QA = (bf16_t*)MP.QA; E.KA = (bf16_t*)MP.KA; E.VAT = (bf16_t*)MP.VAT; E.IQ = (bf16_t*)MP.IQ; E.IK = (bf16_t*)MP.IK; E.IW = (float*)MP.IW; E.HQ = (bf16_t*)MP.HQ; E.HKK = (bf16_t*)MP.HKK; E.HI = (bf16_t*)MP.HI; E.HG = (bf16_t*)MP.HG; E.HLF = (float*)MP.HLF;
            E.GU = (bf16_t*)MP.GU; E.GV = (bf16_t*)MP.GV; E.CS = (const float*)(w + WS_CS); E.pos = (const int*)args.in[I_POS]; E.lb = (const float*)(w + WS_LB) + l * 384; E.kmax = (unsigned*)(w + WS_CTL) + CW_KMAX + l * 32;
            pg8::gemm_phase<EpiInproj, pg8::StaticOrder>(lds, g, S, E);
            SEAM(pb + 1);
        }
        if (PHL(2)) {
#if EN_HGRN
            { unsigned char* w = launder(ws); const MixPtrs MP = make_mp(w); unsigned* ctr = (unsigned*)(w + WS_CTL) + CW_Q + 64 * (4 * l + 0);
              for (;;) { const int u = q_next(ctr, qslot); if (u >= 192) break; hgrn_unit(lds, MP, u / 6, u % 6, args.in[I_ONORM] + l * 64); } }
#endif
#if EN_DSA
            { unsigned char* w = launder(ws); const MixPtrs MP = make_mp(w); unsigned* ctr = (unsigned*)(w + WS_CTL) + CW_Q + 64 * (4 * l + 1);
              for (;;) { const int u = q_next(ctr, qslot); if (u >= 2048) break; dsa_select_unit(lds, MP, u & 31, 63 - (u >> 5)); } }
#endif
#if EN_GMLP
            { unsigned char* w = launder(ws); const MixPtrs MP = make_mp(w); unsigned* ctr = (unsigned*)(w + WS_CTL) + CW_Q + 64 * (4 * l + 2);
              for (;;) { const int u = q_next(ctr, qslot); if (u >= 512) break;
                  gmlp_unit(lds, MP, u >> 4, u & 15, args.in[I_VNG] + l * 256, args.in[I_VNB] + l * 256, (const bf16_t*)(w + WS_GW) + (size_t)l * 4 * 128 * 128, args.in[I_GBS] + l * 512); } }
#endif
#if !EN_HGRN || !EN_GMLP || !EN_DSA
            {
                unsigned char* w = launder(ws); bf16_t* A1 = (bf16_t*)(w + WS_ACT1); const int tz = opaque_tid0();
                for (size_t e = (size_t)vcu * NTHR + tz; e < (size_t)T * 1024; e += (size_t)G * NTHR) { const int c = (int)(e & 1023);
                    const bool z = (!EN_DSA && c < 384) || (!EN_HGRN && c >= 384 && c < 768) || (!EN_GMLP && c >= 768); if (z) A1[e] = 0; }
            }
#endif
            SEAM(pb + 2);
        }
        if (PHL(3)) {
#if EN_DSA
            unsigned char* w = launder(ws); const MixPtrs MP = make_mp(w); unsigned* cw = (unsigned*)(w + WS_CTL); unsigned* ctr = cw + CW_Q + 64 * (4 * l + 3);
            for (;;) {
                const int u = q_next(ctr, qslot);
                if (u >= 512) break;
                const int b = u & 31, J = 15 - (u >> 5);
                const float km = sqrtf(__builtin_bit_cast(float, __hip_atomic_load(cw + CW_KMAX + l * 32 + b, RLX_AGENT)));
                dsa_attn_unit(lds, MP, b, J, km);
            }
#endif
            SEAM(pb + 3);
        }
        if (PHL(4)) {
            unsigned char* w = launder(ws); const float* modl = (const float*)(w + WS_MOD) + (size_t)l * 32 * 6144;
            pg8::Gemm g{(const bf16_t*)(w + WS_ACT1), (const bf16_t*)(w + WS_WOUT) + (size_t)l * DM * DM, T, DM, DM}; pg8::StaticOrder S; S.init(T, DM, G, bx);
            EpiResid E{(l == 0) ? args.in[I_X] : args.out, args.out, modl + 2 * 1024};
            pg8::gemm_phase<EpiResid, pg8::StaticOrder>(lds, g, S, E);
            SEAM(pb + 4);
        }
        if (l == 0) {
            if (PHL(5)) { unsigned char* w = launder(ws); const float* modl = (const float*)(w + WS_MOD) + (size_t)l * 32 * 6144;
                norm_phase(args.out, args.in[I_GFFN] + l * DM, modl + 3 * 1024, modl + 4 * 1024, (bf16_t*)(w + WS_ACT1), vcu, G); SEAM(pb + 5); }
            if (PHL(7)) {
                unsigned char* w = launder(ws);
                pg8::Gemm g{(const bf16_t*)(w + WS_ACT1), (const bf16_t*)(w + WS_WF1), T, 2 * FD, DM}; pg8::StaticOrder S; S.init(T, 2 * FD, G, bx);
                EpiSwiglu E{(bf16_t*)(w + WS_ACTF), FD, 22};
                pg8::gemm_phase<EpiSwiglu, pg8::StaticOrder>(lds, g, S, E);
                SEAM(pb + 7);
            }
            if (PHL(8)) {
                unsigned char* w = launder(ws); const float* modl = (const float*)(w + WS_MOD) + (size_t)l * 32 * 6144;
                pg8::Gemm g{(const bf16_t*)(w + WS_ACTF), (const bf16_t*)(w + WS_WF2), T, DM, FD}; pg8::StaticOrder S; S.init(T, DM, G, bx);
                EpiResid E{args.out, args.out, modl + 5 * 1024};
                pg8::gemm_phase<EpiResid, pg8::StaticOrder>(lds, g, S, E);
                SEAM(pb + 8);
            }
        } else {
            if (PHL(5)) { unsigned char* w = launder(ws); const float* modl = (const float*)(w + WS_MOD) + (size_t)l * 32 * 6144;
                norm_route_phase(args.out, args.in[I_GFFN] + l * DM, modl + 3 * 1024, modl + 4 * 1024, args.in[I_MR], (bf16_t*)(w + WS_HBM), (int*)(w + WS_TOK), (unsigned*)(w + WS_CTL) + CW_CNT, lds, vcu, G); SEAM(pb + 5); }
            if (PHL(6)) { unsigned char* w = launder(ws);
                moe_gather_phase((const bf16_t*)(w + WS_HBM), (bf16_t*)(w + WS_HS), (const int*)(w + WS_TOK), (int*)(w + WS_ROWINFO), (unsigned*)(w + WS_CTL) + CW_CNT, lds, vcu, G); SEAM(pb + 6); }
            for (int k = 0; k < 2; ++k) {
                if (PHM(7) && PH(pb + 7 + 2 * k)) {
                    unsigned char* w = launder(ws); unsigned* cnt = (unsigned*)(w + WS_CTL) + CW_CNT;
                    __syncthreads(); moe_prefix(cnt, k, tpl);
                    const int NT = tpl[8];
                    pg8::Gemm g{(const bf16_t*)(w + WS_HS) + (size_t)k * HSROWS * DM, (const bf16_t*)(w + WS_WM1), NT * 256, 2 * FE, DM};
                    pg8::MoeOrder S; S.init(NT * 256, 2 * FE, G, bx); S.tp = tpl; S.nNl = 28;
                    EpiSwiglu E{(bf16_t*)(w + WS_ACTM), FE, 28};
                    pg8::gemm_phase<EpiSwiglu, pg8::MoeOrder>(lds, g, S, E);
                    SEAM(pb + 7 + 2 * k);
                }
                if (PHM(8) && PH(pb + 8 + 2 * k)) {
                    unsigned char* w = launder(ws); unsigned* cnt = (unsigned*)(w + WS_CTL) + CW_CNT; const float* modl = (const float*)(w + WS_MOD) + (size_t)l * 32 * 6144;
                    __syncthreads(); moe_prefix(cnt, k, tpl);
                    const int NT = tpl[8];
                    pg8::Gemm g{(const bf16_t*)(w + WS_ACTM), (const bf16_t*)(w + WS_WM2), NT * 256, DM, FE};
                    pg8::MoeOrder S; S.init(NT * 256, DM, G, bx); S.tp = tpl; S.nNl = 4;
                    EpiMoeDown E{args.out, modl + 5 * 1024, (const int*)(w + WS_ROWINFO) + (size_t)k * HSROWS * 2};
                    pg8::gemm_phase<EpiMoeDown, pg8::MoeOrder>(lds, g, S, E);
                    SEAM(pb + 8 + 2 * k);
                }
            }
        }
    }
    if (((PHMASK >> 13) & 1u) && PH(25)) final_norm_phase(args.out, args.in[I_GFIN], vcu, G);
#undef PH
#undef SEAM
}

extern "C" void kernel_launch(void* const* d_in, const int* in_sizes, int n_in, void* d_out, int out_size, void* d_ws, size_t ws_size, hipStream_t stream) {
    static int grid = 0;
    if (grid == 0) {
        if (n_in != 23 || out_size != T * DM || ws_size < WS_END) { fprintf(stderr, "kernel_launch: unexpected shapes (n_in %d, out %d, ws %zu)\n", n_in, out_size, ws_size); grid = -1; return; }
        int dev = 0, cus = 0, per_cu = 0;
        if (hipGetDevice(&dev) != hipSuccess || hipDeviceGetAttribute(&cus, hipDeviceAttributeMultiprocessorCount, dev) != hipSuccess) { grid = -1; return; }
        if (hipFuncSetAttribute((const void*)fwd_kernel, hipFuncAttributeMaxDynamicSharedMemorySize, LDS_BYTES) != hipSuccess) { fprintf(stderr, "kernel_launch: hipFuncSetAttribute failed\n"); grid = -1; return; }
        if (hipOccupancyMaxActiveBlocksPerMultiprocessor(&per_cu, (const void*)fwd_kernel, NTHR, LDS_BYTES) != hipSuccess || per_cu < 1) fprintf(stderr, "kernel_launch: occupancy query reports %d\n", per_cu);
        (void)hipGetLastError();
        grid = cus;
    }
    if (grid < 0) return;
    (void)hipMemsetAsync((char*)d_ws + WS_CTL, 0, CTL_ZERO_BYTES, stream);
    Args a{};
    for (int i = 0; i < 23; ++i) a.in[i] = (const float*)d_in[i];
    a.out = (float*)d_out; a.ws = (unsigned char*)d_ws;
#if MK_PER_PHASE
    for (int p = 0; p < NPH; ++p) {
        if (p == 7 || p == 10 || p == 11 || p == 12 || p == 24) continue;
        a.ph_lo = p; a.ph_hi = p + 1;
        hipLaunchKernelGGL(fwd_kernel, dim3(grid), dim3(NTHR), LDS_BYTES, stream, a);
    }
#else
    a.ph_lo = 0; a.ph_hi = NPH;
    hipLaunchKernelGGL(fwd_kernel, dim3(grid), dim3(NTHR), LDS_BYTES, stream, a);
#endif
}
```

```cpp
#include <hip/hip_runtime.h>
#include <cstdio>
#include <cstdint>

#ifndef MK_PER_PHASE
#define MK_PER_PHASE 0
#endif
#ifndef EN_GMLP
#define EN_GMLP 1
#endif
#ifndef EN_HGRN
#define EN_HGRN 1
#endif
#ifndef EN_DSA
#define EN_DSA 1
#endif

#define GAS __attribute__((address_space(1)))
#define LAS __attribute__((address_space(3)))
typedef unsigned short bf16_t;
typedef short bf16x8 __attribute__((ext_vector_type(8)));
typedef float f32x4 __attribute__((ext_vector_type(4)));
typedef float f32x2 __attribute__((ext_vector_type(2)));
typedef float f32x16 __attribute__((ext_vector_type(16)));
typedef unsigned u32x4 __attribute__((ext_vector_type(4)));
typedef unsigned u32x2 __attribute__((ext_vector_type(2)));
typedef GAS unsigned gu32;
#define RLX_AGENT __ATOMIC_RELAXED, __HIP_MEMORY_SCOPE_AGENT

constexpr int T = 65536, DM = 1024, NB = 32, SEQ = 2048;
constexpr int NIN = 3072;
constexpr int INSRC = 2884;
constexpr int FD = 2816, FE = 3584, NE = 8;
constexpr int NWAVES = 8, NTHR = 512;
constexpr int HSROWS = T + 2048;
constexpr float EPS = 1e-6f;

constexpr size_t MiB = 1u << 20;
constexpr size_t WS_CTL = 0, CTL_ZERO_BYTES = 1 * MiB;
constexpr size_t WS_MOD = 1 * MiB;
constexpr size_t WS_CS = 3 * MiB;
constexpr size_t WS_LB = 5 * MiB;
constexpr size_t WS_GW = 5 * MiB + 512 * 1024;
constexpr size_t WS_TOK = 6 * MiB;
constexpr size_t WS_ROWINFO = 8 * MiB;
constexpr size_t WS_WIN = 16 * MiB;
constexpr size_t WS_WOUT = 28 * MiB;
constexpr size_t WS_WF1 = 32 * MiB;
constexpr size_t WS_WF2 = 43 * MiB;
constexpr size_t WS_WM1 = 49 * MiB;
constexpr size_t WS_WM2 = 161 * MiB;
constexpr size_t WS_ACT1 = 224 * MiB;
constexpr size_t WS_BIG = 352 * MiB;
constexpr size_t WS_QA = WS_BIG;
constexpr size_t WS_KA = WS_QA + 48 * MiB;
constexpr size_t WS_VAT = WS_KA + 8 * MiB;
constexpr size_t WS_IQ = WS_VAT + 8 * MiB;
constexpr size_t WS_IK = WS_IQ + 32 * MiB;
constexpr size_t WS_IW = WS_IK + 8 * MiB;
constexpr size_t WS_HQ = WS_IW + 1 * MiB;
constexpr size_t WS_HLF = WS_HQ + 48 * MiB;
constexpr size_t WS_HKK = WS_HLF + 96 * MiB;
constexpr size_t WS_HI = WS_HKK + 48 * MiB;
constexpr size_t WS_HG = WS_HI + 48 * MiB;
constexpr size_t WS_GU = WS_HG + 48 * MiB;
constexpr size_t WS_GV = WS_GU + 32 * MiB;
constexpr size_t WS_BM = WS_GV + 32 * MiB;
constexpr size_t WS_MIXEND = WS_BM + 16 * MiB;
constexpr size_t WS_ACTF = WS_BIG;
constexpr size_t WS_HS = 224 * MiB;
constexpr size_t WS_ACTM = 488 * MiB;
constexpr size_t WS_HBM = 800 * MiB;
constexpr size_t WS_END = 1024 * MiB;
static_assert(WS_MIXEND <= WS_END && WS_ACTF + (size_t)T * FD * 2 <= WS_END, "ws map");
static_assert(WS_HS + (size_t)2 * HSROWS * DM * 2 <= WS_ACTM && WS_ACTM + (size_t)HSROWS * FE * 2 <= WS_END && WS_HBM + (size_t)T * DM * 2 <= WS_ACTM + (size_t)HSROWS * FE * 2, "ws map moe");
static_assert(WS_WM2 + (size_t)NE * DM * FE * 2 <= WS_ACT1, "ws map weights");

constexpr int CW_BAR = 4096;
constexpr int CW_Q = 8192;
constexpr int CW_CNT = 12288;
constexpr int CW_KMAX = 16384;

constexpr int LDS_BYTES = 163840;
constexpr int LDS_MISC = 163840 - 256;
constexpr int PH_SCRATCH = LDS_MISC;

__device__ __forceinline__ float bf2f(unsigned short b) { return __builtin_bit_cast(float, ((unsigned)b) << 16); }
__device__ __forceinline__ unsigned f2bf(float f) { unsigned u = __builtin_bit_cast(unsigned, f); return (u + 0x7fffu + ((u >> 16) & 1u)) >> 16; }
__device__ __forceinline__ unsigned pk2(float lo, float hi) { unsigned r; asm volatile("v_cvt_pk_bf16_f32 %0, %1, %2" : "=v"(r) : "v"(lo), "v"(hi)); return r; }
__device__ __forceinline__ float wave_sum(float v) {
#pragma unroll
    for (int o = 1; o < 64; o <<= 1) v += __shfl_xor(v, o);
    return v;
}
__device__ __forceinline__ float fast_exp(float x) { return __builtin_amdgcn_exp2f(x * 1.44269504089f); }
__device__ __forceinline__ float fast_log(float x) { return __builtin_amdgcn_logf(x) * 0.69314718056f; }
__device__ __forceinline__ float sigmoidf(float x) { return __builtin_amdgcn_rcpf(1.f + fast_exp(-x)); }

__device__ __forceinline__ int opaque_tid0() { int t = threadIdx.x; asm volatile("" : "+v"(t)); return t; }
namespace pg8 {
constexpr int BM = 256, BK = 64, HALF = 128, HTB = HALF * BK * 2, STAGE_BYTES = 8 * HTB, NXCD = 8, WGM = 8;
__host__ __device__ __forceinline__ int lds_byte(int r, int c) { const int st = (r >> 4) * 2 + (c >> 5), rr = r & 15, cc = c & 31, ob = rr * 64 + cc * 2; return st * 1024 + (ob ^ (((ob >> 9) & 1) << 5)); }
__host__ __device__ __forceinline__ void stage_rc(int b, int& R, int& C) { const int st = b / 1024, sb = b % 1024, swz = sb ^ (((sb >> 9) & 1) << 5); R = (st >> 1) * 16 + swz / 64; C = (st & 1) * 32 + (swz % 64) / 2; }
__host__ __device__ __forceinline__ int perm32(int rho) { const int n = rho >> 4, i = rho & 15; return 8 * (i >> 2) + 4 * n + (i & 3); }
struct Unit { int pm, pn; };
struct Gemm { const bf16_t* A; const bf16_t* Bt; int M, N, K; };
struct StaticOrder {
    int nM, nN, nwg, G, c;
    __device__ void init(int M, int N, int G_, int c_) { nM = M / BM; nN = N / BM; nwg = nM * nN; G = G_; c = c_; }
    __device__ bool next(int i, Unit& u) const {
        const long L = (long)i * G + c; if (L >= nwg) return false;
        int wgid = (int)L; { const int q = nwg / NXCD, r = nwg % NXCD, xcd = wgid % NXCD, off = wgid / NXCD; wgid = (xcd < r ? xcd * (q + 1) : r * (q + 1) + (xcd - r) * q) + off; }
        const int nig = WGM * nN, gid = wgid / nig, fm = gid * WGM, gsz = (nM - fm) < WGM ? (nM - fm) : WGM;
        u.pm = fm + ((wgid % nig) % gsz); u.pn = (wgid % nig) / gsz; return true;
    }
};
struct MoeOrder : StaticOrder {
    const LAS int* tp; int nNl;
    __device__ bool next(int i, Unit& u) const {
        if (!StaticOrder::next(i, u)) return false;
        int e = 0;
#pragma unroll
        for (int k = 1; k < 8; ++k) e += (u.pm >= tp[k]) ? 1 : 0;
        u.pn += e * nNl; return true;
    }
};

template <class Epi, class Sched>
__device__ __forceinline__ void gemm_phase(LAS unsigned char* lds, const Gemm g, const Sched& S, const Epi& E) {
    const int tid = opaque_tid0(), wid = __builtin_amdgcn_readfirstlane(tid >> 6), lane = tid & 63, wr = wid >> 2, wc = wid & 3, fr = lane & 15, fq = lane >> 4;
    const int K = g.K, nt = K / BK;
    unsigned voffA[2], voffB[2];
#pragma unroll
    for (int i = 0; i < 2; ++i) { int R, C; stage_rc(tid * 16 + i * 8192, R, C); const int Rb = Epi::PERM ? ((R & ~31) + perm32(R & 31)) : R;
        voffA[i] = (unsigned)(R * K + C) * 2u; voffB[i] = (unsigned)(Rb * K + C) * 2u; }
    const size_t kstep = (size_t)(BK * 2);
    const size_t hstep = (size_t)HALF * K * 2;
    const size_t tstep = 2 * hstep;
    const unsigned ldsw = (unsigned)wid * 1024u;
    const int aoff = lds_byte(wr * 64 + fr, fq * 8), boff = lds_byte(wc * 32 + fr, fq * 8);
#define PG8_SA(b, h) (((b) * 2 + (h)) * HTB)
#define PG8_SB(b, h) ((4 + (b) * 2 + (h)) * HTB)
#define PG8_STAGE(bufoff, gbase, voff) do { _Pragma("unroll") for (int _i = 0; _i < 2; ++_i) \
        __builtin_amdgcn_global_load_lds((const unsigned*)((const char*)(gbase) + (voff)[_i]), (LAS unsigned*)(lds + (bufoff) + ldsw + _i * 8192), 16, 0, 0); } while (0)
#define PG8_LDA(dst, b, h) do { _Pragma("unroll") for (int m = 0; m < 4; ++m) _Pragma("unroll") for (int k = 0; k < 2; ++k) dst[m][k] = *(const LAS bf16x8*)(lds + PG8_SA(b, h) + aoff + m * 2048 + k * 1024); } while (0)
#define PG8_LDB(dst, b, h) do { _Pragma("unroll") for (int n = 0; n < 2; ++n) _Pragma("unroll") for (int k = 0; k < 2; ++k) dst[n][k] = *(const LAS bf16x8*)(lds + PG8_SB(b, h) + boff + n * 2048 + k * 1024); } while (0)
#define PG8_MMA(ai, bj, At, Bt) do { __builtin_amdgcn_s_setprio(1); _Pragma("unroll") for (int m = 0; m < 4; ++m) _Pragma("unroll") for (int n = 0; n < 2; ++n) _Pragma("unroll") for (int k = 0; k < 2; ++k) \
        acc[ai][bj][m][n] = __builtin_amdgcn_mfma_f32_16x16x32_bf16(Bt[n][k], At[m][k], acc[ai][bj][m][n], 0, 0, 0); __builtin_amdgcn_s_setprio(0); } while (0)
#define PG8_WAIT_V(n) asm volatile("s_waitcnt vmcnt(" #n ")" ::: "memory")
#define PG8_WAIT_L(n) asm volatile("s_waitcnt lgkmcnt(" #n ")" ::: "memory")
#define PG8_BAR __builtin_amdgcn_s_barrier()
#define PG8_SCHED __builtin_amdgcn_sched_barrier(0)
    Unit cur, nxt; int ui = 0;
    if (!S.next(0, cur)) return;
    f32x4 acc[2][2][4][2];
#pragma unroll
    for (int a = 0; a < 2; ++a)
#pragma unroll
        for (int b = 0; b < 2; ++b)
#pragma unroll
            for (int m = 0; m < 4; ++m)
#pragma unroll
                for (int n = 0; n < 2; ++n) acc[a][b][m][n] = (f32x4){0.f, 0.f, 0.f, 0.f};
    bf16x8 At[4][2], B0[2][2], B1[2][2];
    const char* cA = (const char*)g.A + (size_t)cur.pm * tstep; const char* cB = (const char*)g.Bt + (size_t)cur.pn * tstep;
    PG8_STAGE(PG8_SB(0, 0), cB, voffB); PG8_STAGE(PG8_SB(0, 1), cB + hstep, voffB); PG8_STAGE(PG8_SA(0, 0), cA, voffA); PG8_STAGE(PG8_SA(0, 1), cA + hstep, voffA);
    if (wr == 1) PG8_BAR;
    PG8_WAIT_V(2); PG8_BAR;
    PG8_STAGE(PG8_SB(1, 0), cB + kstep, voffB); PG8_STAGE(PG8_SA(1, 0), cA + kstep, voffA); PG8_STAGE(PG8_SB(1, 1), cB + hstep + kstep, voffB);
    PG8_WAIT_V(6); PG8_BAR;
    for (;;) {
        const bool has_next = S.next(ui + 1, nxt);
        const char* nA = has_next ? (const char*)g.A + (size_t)nxt.pm * tstep : cA; const char* nB = has_next ? (const char*)g.Bt + (size_t)nxt.pn * tstep : cB;
        for (int t = 0; t < nt; t += 2) {
            const bool last = (t == nt - 2);
            const char* a1 = cA + (size_t)(t + 1) * kstep;
            const char* a2 = last ? nA : cA + (size_t)(t + 2) * kstep; const char* b2 = last ? nB : cB + (size_t)(t + 2) * kstep;
            const char* a3 = a2 + kstep; const char* b3 = b2 + kstep;
            PG8_LDB(B0, 0, 0); PG8_LDB(B1, 0, 1); PG8_SCHED; PG8_LDA(At, 0, 0); PG8_STAGE(PG8_SA(1, 1), a1 + hstep, voffA);
            PG8_WAIT_V(8); PG8_WAIT_L(0); PG8_BAR; PG8_MMA(0, 0, At, B0); PG8_MMA(0, 1, At, B1); PG8_BAR; PG8_SCHED;
            PG8_LDA(At, 0, 1); PG8_STAGE(PG8_SB(0, 0), b2, voffB); PG8_STAGE(PG8_SB(0, 1), b2 + hstep, voffB); PG8_STAGE(PG8_SA(0, 0), a2, voffA);
            PG8_WAIT_V(8); PG8_WAIT_L(0); PG8_BAR; PG8_MMA(1, 0, At, B0); PG8_MMA(1, 1, At, B1); PG8_BAR; PG8_SCHED;
            PG8_LDB(B0, 1, 0); PG8_LDB(B1, 1, 1); PG8_SCHED; PG8_LDA(At, 1, 0); PG8_STAGE(PG8_SA(0, 1), a2 + hstep, voffA);
            PG8_WAIT_V(8); PG8_WAIT_L(0); PG8_BAR; PG8_MMA(0, 0, At, B0); PG8_MMA(0, 1, At, B1); PG8_BAR; PG8_SCHED;
            PG8_LDA(At, 1, 1); PG8_STAGE(PG8_SB(1, 0), b3, voffB); PG8_STAGE(PG8_SB(1, 1), b3 + hstep, voffB); PG8_STAGE(PG8_SA(1, 0), a3, voffA);
            PG8_WAIT_V(8); PG8_WAIT_L(0); PG8_BAR; PG8_MMA(1, 0, At, B0); PG8_MMA(1, 1, At, B1); PG8_BAR; PG8_SCHED;
        }
        if (wr == 0) PG8_BAR;
        E(acc, cur, wr, wc, fr, fq);
        if (!has_next) break;
#pragma unroll
        for (int a = 0; a < 2; ++a)
#pragma unroll
            for (int b = 0; b < 2; ++b)
#pragma unroll
                for (int m = 0; m < 4; ++m)
#pragma unroll
                    for (int n = 0; n < 2; ++n) acc[a][b][m][n] = (f32x4){0.f, 0.f, 0.f, 0.f};
        cur = nxt; cA = nA; cB = nB; ++ui;
        if (wr == 1) PG8_BAR;
    }
    PG8_WAIT_V(0);
    PG8_BAR;
#undef PG8_SA
#undef PG8_SB
#undef PG8_STAGE
#undef PG8_LDA
#undef PG8_LDB
#undef PG8_MMA
#undef PG8_WAIT_V
#undef PG8_WAIT_L
#undef PG8_BAR
#undef PG8_SCHED
}
}

typedef f32x4 AccT[2][2][4][2];

__device__ __forceinline__ f32x2 gelu_pk(f32x2 v) {
    const f32x2 av = __builtin_elementwise_abs(v), d = av * 0.2316418882f + 1.0f;
    f32x2 t; t.x = __builtin_amdgcn_rcpf(d.x); t.y = __builtin_amdgcn_rcpf(d.y);
    f32x2 q = t * 0.5307027145f + (-0.7265760135f); q = q * t + 0.7107068705f; q = q * t + (-0.142248368f); q = q * t + 0.127414796f; q = q * t;
    const f32x2 s = (v * v) * (-0.72134752044f);
    f32x2 e; e.x = __builtin_amdgcn_exp2f(s.x); e.y = __builtin_amdgcn_exp2f(s.y);
    const f32x2 m = v * (q * e), r = v - m;
    f32x2 o; o.x = v.x < 0.f ? m.x : r.x; o.y = v.y < 0.f ? m.y : r.y; return o;
}
__device__ __forceinline__ float gelu1(float x) { f32x2 r = gelu_pk((f32x2){x, x}); return r.x; }
__device__ __forceinline__ u32x4 pack8(const f32x4 a, const f32x4 b) { u32x4 w; w.x = pk2(a[0], a[1]); w.y = pk2(a[2], a[3]); w.z = pk2(b[0], b[1]); w.w = pk2(b[2], b[3]); return w; }

constexpr float QSCALE = 0.125f * 1.44269504089f;

struct EpiInproj {
    static constexpr bool PERM = true;
    bf16_t *QA, *KA, *VAT, *IQ, *IK; float* IW; bf16_t *HQ, *HKK, *HI, *HG; float* HLF; bf16_t *GU, *GV;
    const float* CS; const int* pos; const float* lb; unsigned* kmax;
    __device__ __forceinline__ void operator()(const AccT& acc, const pg8::Unit& u, int wr, int wc, int fr, int fq) const {
        const int row0 = u.pm * 256 + wr * 64 + fr, pn = u.pn;
        if (pn < 4) {
            float kmx = 0.f;
#pragma unroll
            for (int ai = 0; ai < 2; ++ai)
#pragma unroll
                for (int m = 0; m < 4; ++m) {
                    asm volatile("" ::: "memory"); __builtin_amdgcn_sched_barrier(0);
                    const int row = row0 + ai * 128 + m * 16;
                    const f32x4 x1a = acc[ai][0][m][0], x1b = acc[ai][0][m][1], x2a = acc[ai][1][m][0], x2b = acc[ai][1][m][1];
                    if (pn == 1 && wc == 3) {
                        const int b = row >> 11, s = row & 2047; bf16_t* vp = VAT + ((size_t)b * 64) * 2048 + s;
#pragma unroll
                        for (int j = 0; j < 4; ++j) { vp[(size_t)(8 * fq + j) * 2048] = (bf16_t)f2bf(x1a[j]); vp[(size_t)(8 * fq + 4 + j) * 2048] = (bf16_t)f2bf(x1b[j]);
                            vp[(size_t)(32 + 8 * fq + j) * 2048] = (bf16_t)f2bf(x2a[j]); vp[(size_t)(32 + 8 * fq + 4 + j) * 2048] = (bf16_t)f2bf(x2b[j]); }
                        continue;
                    }
                    if (pn == 3 && wc >= 1) {
                        if (wc == 1 && fq == 0) *(f32x4*)(IW + (size_t)row * 4) = x1a;
                        continue;
                    }
                    const int p = pos[row]; const float* cs = CS + (size_t)p * 64 + 8 * fq;
                    const f32x4 ca = *(const f32x4*)cs, cb = *(const f32x4*)(cs + 4), sa = *(const f32x4*)(cs + 32), sb = *(const f32x4*)(cs + 36);
                    f32x4 o1a = x1a * ca - x2a * sa, o1b = x1b * cb - x2b * sb, o2a = x2a * ca + x1a * sa, o2b = x2b * cb + x1b * sb;
                    bf16_t* dst;
                    if (pn == 0) { dst = QA + ((size_t)row * 6 + wc) * 64; o1a *= QSCALE; o1b *= QSCALE; o2a *= QSCALE; o2b *= QSCALE; }
                    else if (pn == 1) { if (wc < 2) { dst = QA + ((size_t)row * 6 + 4 + wc) * 64; o1a *= QSCALE; o1b *= QSCALE; o2a *= QSCALE; o2b *= QSCALE; }
                        else { dst = KA + (size_t)row * 64;
                            float ss = 0.f;
#pragma unroll
                            for (int j = 0; j < 4; ++j) ss += o1a[j] * o1a[j] + o1b[j] * o1b[j] + o2a[j] * o2a[j] + o2b[j] * o2b[j];
                            ss += __shfl_xor(ss, 16); ss += __shfl_xor(ss, 32); kmx = fmaxf(kmx, ss); } }
                    else if (pn == 2) dst = IQ + ((size_t)row * 4 + wc) * 64;
                    else dst = IK + (size_t)row * 64;
                    *(u32x4*)(dst + 8 * fq) = pack8(o1a, o1b);
                    *(u32x4*)(dst + 32 + 8 * fq) = pack8(o2a, o2b);
                }
            if (pn == 1 && wc == 2) {
#pragma unroll
                for (int o = 1; o < 16; o <<= 1) kmx = fmaxf(kmx, __shfl_xor(kmx, o));
                if ((threadIdx.x & 63) == 0) atomicMax(kmax + (row0 >> 11), __builtin_bit_cast(unsigned, kmx));
            }
        } else if (pn < 10) {
            const int h = pn - 4; const int dq = 32 * (wc & 1) + 8 * fq;
            f32x4 lba, lbb;
            if (wc >= 2) { lba = *(const f32x4*)(lb + h * 64 + dq); lbb = *(const f32x4*)(lb + h * 64 + dq + 4); }
#pragma unroll
            for (int ai = 0; ai < 2; ++ai)
#pragma unroll
                for (int m = 0; m < 4; ++m) {
                    asm volatile("" ::: "memory"); __builtin_amdgcn_sched_barrier(0);
                    const int row = row0 + ai * 128 + m * 16; const size_t o = ((size_t)row * 6 + h) * 64 + dq;
                    if (wc < 2) {
                        *(u32x4*)(HQ + o) = pack8(acc[ai][0][m][0], acc[ai][0][m][1]);
                        *(u32x4*)(HI + o) = pack8(acc[ai][1][m][0], acc[ai][1][m][1]);
                    } else {
                        f32x4 lf[2], kk[2], sg[2];
#pragma unroll
                        for (int n = 0; n < 2; ++n)
#pragma unroll
                            for (int j = 0; j < 4; ++j) {
                                const float z = acc[ai][0][m][n][j], lbv = n ? lbb[j] : lba[j];
                                const float ls = fminf(z, 0.f) - fast_log(1.f + fast_exp(-fabsf(z)));
                                lf[n][j] = (lbv > 0.f) ? fast_log(lbv + (1.f - lbv) * fast_exp(ls)) : ls;
                                kk[n][j] = (1.f - lbv) * fast_exp(ls - z);
                                const float gg = acc[ai][1][m][n][j]; sg[n][j] = gg * sigmoidf(gg);
                            }
                        *(f32x4*)(HLF + o) = lf[0]; *(f32x4*)(HLF + o + 4) = lf[1];
                        *(u32x4*)(HKK + o) = pack8(kk[0], kk[1]);
                        *(u32x4*)(HG + o) = pack8(sg[0], sg[1]);
                    }
                }
        } else {
            bf16_t* dstb = (pn == 10) ? GU : GV;
#pragma unroll
            for (int ai = 0; ai < 2; ++ai)
#pragma unroll
                for (int m = 0; m < 4; ++m) {
                    asm volatile("" ::: "memory"); __builtin_amdgcn_sched_barrier(0);
                    const int row = row0 + ai * 128 + m * 16;
#pragma unroll
                    for (int bj = 0; bj < 2; ++bj) {
                        const f32x4 v0 = acc[ai][bj][m][0], v1 = acc[ai][bj][m][1];
                        const f32x2 a = gelu_pk((f32x2){v0[0], v0[1]}), b = gelu_pk((f32x2){v0[2], v0[3]}), c = gelu_pk((f32x2){v1[0], v1[1]}), d = gelu_pk((f32x2){v1[2], v1[3]});
                        u32x4 w; w.x = pk2(a.x, a.y); w.y = pk2(b.x, b.y); w.z = pk2(c.x, c.y); w.w = pk2(d.x, d.y);
                        *(u32x4*)(dstb + (size_t)row * 256 + bj * 128 + wc * 32 + 8 * fq) = w;
                    }
                }
        }
    }
};

struct EpiResid {
    static constexpr bool PERM = true;
    const float* xin; float* out; const float* gate;
    __device__ __forceinline__ void operator()(const AccT& acc, const pg8::Unit& u, int wr, int wc, int fr, int fq) const {
        const int row0 = u.pm * 256 + wr * 64 + fr, col0 = u.pn * 256 + wc * 32 + 8 * fq;
        const float* gp = gate + (size_t)(row0 >> 11) * 6144 + col0;
        f32x4 gv[2][2];
#pragma unroll
        for (int bj = 0; bj < 2; ++bj)
#pragma unroll
            for (int n = 0; n < 2; ++n) gv[bj][n] = *(const f32x4*)(gp + bj * 128 + 4 * n);
#pragma unroll
        for (int ai = 0; ai < 2; ++ai)
#pragma unroll
            for (int m = 0; m < 4; ++m) { asm volatile("" ::: "memory"); __builtin_amdgcn_sched_barrier(0); const size_t o = (size_t)(row0 + ai * 128 + m * 16) * DM + col0;
#pragma unroll
                for (int bj = 0; bj < 2; ++bj)
#pragma unroll
                    for (int n = 0; n < 2; ++n) { const f32x4 xv = *(const f32x4*)(xin + o + bj * 128 + 4 * n); *(f32x4*)(out + o + bj * 128 + 4 * n) = xv + gv[bj][n] * acc[ai][bj][m][n]; } }
    }
};

struct EpiSwiglu {
    static constexpr bool PERM = true;
    bf16_t* O; int ldo; int nNl;
    __device__ __forceinline__ void operator()(const AccT& acc, const pg8::Unit& u, int wr, int wc, int fr, int fq) const {
        const int row0 = u.pm * 256 + wr * 64 + fr, pnl = u.pn % nNl, col0 = pnl * 128 + wc * 32 + 8 * fq;
#pragma unroll
        for (int ai = 0; ai < 2; ++ai)
#pragma unroll
            for (int m = 0; m < 4; ++m) {
                asm volatile("" ::: "memory"); __builtin_amdgcn_sched_barrier(0);
                f32x4 r[2];
#pragma unroll
                for (int n = 0; n < 2; ++n)
#pragma unroll
                    for (int j = 0; j < 4; ++j) { const float g = acc[ai][0][m][n][j]; r[n][j] = g * sigmoidf(g) * acc[ai][1][m][n][j]; }
                *(u32x4*)(O + (size_t)(row0 + ai * 128 + m * 16) * ldo + col0) = pack8(r[0], r[1]);
            }
    }
};

struct EpiMoeDown {
    static constexpr bool PERM = true;
    float* out; const float* g2; const int* rowinfo;
    __device__ __forceinline__ void operator()(const AccT& acc, const pg8::Unit& u, int wr, int wc, int fr, int fq) const {
        const int row0 = u.pm * 256 + wr * 64 + fr, col0 = (u.pn & 3) * 256 + wc * 32 + 8 * fq;
#pragma unroll
        for (int ai = 0; ai < 2; ++ai)
#pragma unroll
            for (int m = 0; m < 4; ++m) {
                asm volatile("" ::: "memory"); __builtin_amdgcn_sched_barrier(0);
                const int row = row0 + ai * 128 + m * 16; const int tok = rowinfo[2 * row]; const float gt = __builtin_bit_cast(float, rowinfo[2 * row + 1]);
                if (tok >= 0) { const float* gp = g2 + (size_t)(tok >> 11) * 6144 + col0; float* op = out + (size_t)tok * DM + col0;
#pragma unroll
                    for (int bj = 0; bj < 2; ++bj)
#pragma unroll
                        for (int n = 0; n < 2; ++n) { const f32x4 gv = *(const f32x4*)(gp + bj * 128 + 4 * n); const f32x4 xv = *(const f32x4*)(op + bj * 128 + 4 * n);
                            *(f32x4*)(op + bj * 128 + 4 * n) = xv + gv * gt * acc[ai][bj][m][n]; } }
            }
    }
};

#define XB_TMO      128
#define XB_XCNT(j)  (256  + 64 * (j))
#define XB_XSUB(j)  (1280 + 64 * (j))
#define XB_XGEN(j)  (2304 + 64 * (j))
#define XB_TOP      3328
#define XB_TOPGEN   3392
#define XCD_BAR_WORDS 3456
#define XB_SPIN_CAP (1u << 18)
__device__ __forceinline__ unsigned xb_ld(unsigned* p)              { return __hip_atomic_load(p, __ATOMIC_RELAXED, __HIP_MEMORY_SCOPE_AGENT); }
__device__ __forceinline__ unsigned xb_add(unsigned* p, unsigned v) { return __hip_atomic_fetch_add(p, v, __ATOMIC_RELAXED, __HIP_MEMORY_SCOPE_AGENT); }
__device__ __forceinline__ unsigned xb_xcc_id() { return (unsigned)__builtin_amdgcn_s_getreg((3 << 11) | 20) & 0xFu; }
#define XB_SPIN(cond, bar) do { unsigned _sp = 0; while (cond) { __builtin_amdgcn_s_sleep(1); \
    if ((++_sp & 255u) == 0u) { if (xb_ld(&(bar)[XB_TMO])) break; if (_sp > XB_SPIN_CAP) { atomicAdd(&(bar)[XB_TMO], 1u); break; } } } } while (0)
struct XcdBarrier { unsigned* bar; unsigned x; volatile LAS unsigned* st; };
__device__ __forceinline__ XcdBarrier xcd_barrier_post(unsigned* bar, volatile LAS unsigned* st) {
    XcdBarrier b; b.bar = bar; b.x = xb_xcc_id(); b.st = st;
    if (threadIdx.x == 0) (void)xb_add(&bar[XB_XCNT(b.x)], 1u);
    return b;
}
__device__ __forceinline__ void xcd_barrier_complete(unsigned* bar, unsigned x, unsigned& nloc, unsigned& nx) {
    const unsigned G = gridDim.x * gridDim.y * gridDim.z;
    unsigned sum, cnt, mine, sp = 0u;
    for (;;) {
        sum = 0u; cnt = 0u; mine = 0u;
#pragma unroll
        for (unsigned j = 0; j < 16; ++j) { const unsigned c = xb_ld(&bar[XB_XCNT(j)]); sum += c; cnt += (c > 0u) ? 1u : 0u; mine = (j == x) ? c : mine; }
        if (sum == G) break;
        __builtin_amdgcn_s_sleep(1);
        if ((++sp & 255u) == 0u) { if (xb_ld(&bar[XB_TMO])) break; if (sp > XB_SPIN_CAP) { atomicAdd(&bar[XB_TMO], 1u); break; } }
    }
    nloc = mine > 0u ? mine : 1u; nx = cnt > 0u ? cnt : 1u;
}
__device__ __forceinline__ void xcd_barrier(const XcdBarrier& b) {
    asm volatile("s_waitcnt vmcnt(0)" ::: "memory");
    __syncthreads();
    if (threadIdx.x == 0) {
        unsigned* bar = b.bar;
        __builtin_amdgcn_s_waitcnt(0);
        unsigned nloc = b.st[0], nx = b.st[1];
        if (nloc == 0u) { xcd_barrier_complete(bar, b.x, nloc, nx); b.st[0] = nloc; b.st[1] = nx; }
        const unsigned old = xb_add(&bar[XB_XSUB(b.x)], 1u);
        const unsigned gen = old / nloc;
        if (old + 1u == (gen + 1u) * nloc) {
            __builtin_amdgcn_fence(__ATOMIC_RELEASE, "agent");
            asm volatile("s_waitcnt vmcnt(0)" ::: "memory");
            const unsigned og = xb_add(&bar[XB_TOP], 1u);
            const unsigned tg = og / nx;
            if (og + 1u == (tg + 1u) * nx) xb_add(&bar[XB_TOPGEN], 1u);
            else XB_SPIN(xb_ld(&bar[XB_TOPGEN]) == tg, bar);
            __builtin_amdgcn_fence(__ATOMIC_ACQUIRE, "agent");
            xb_add(&bar[XB_XGEN(b.x)], 1u);
            asm volatile("s_waitcnt vmcnt(0)" ::: "memory");
        } else {
            XB_SPIN(xb_ld(&bar[XB_XGEN(b.x)]) == gen, bar);
            __builtin_amdgcn_fence(__ATOMIC_ACQUIRE, "agent");
            asm volatile("s_waitcnt vmcnt(0)" ::: "memory");
        }
    }
    __syncthreads();
}

struct Args { const float* in[23]; float* out; unsigned char* ws; int ph_lo, ph_hi; };
enum { I_X = 0, I_C, I_POS, I_WADA, I_BADA, I_GMIX, I_GFFN, I_WIN, I_WOUT, I_LBL, I_ONORM, I_VNG, I_VNB, I_GWS, I_GBS, I_FG, I_FU, I_FD, I_MR, I_MG, I_MU, I_MD, I_GFIN };

__device__ __forceinline__ int opaque_tid() { int t = threadIdx.x; asm volatile("" : "+v"(t)); return t; }
__device__ __forceinline__ int q_next(unsigned* ctr, volatile LAS int* slot) {
    __syncthreads();
    if (threadIdx.x == 0) *slot = (int)__hip_atomic_fetch_add(ctr, 1u, RLX_AGENT);
    __syncthreads();
    return *slot;
}

template <class F>
__device__ __forceinline__ void p0_transpose_item(const float* W, int K, int Nsrc, bf16_t* WT, LAS float* scr, int kb, int nb, int lane, F srccol) {
    const int k0 = 64 * kb, n0 = 32 * nb; const int sc = srccol(n0 + (lane & 31));
#pragma unroll 8
    for (int i = 0; i < 32; ++i) { const int kk = 2 * i + (lane >> 5); scr[kk * 33 + (lane & 31)] = (sc >= 0) ? W[(size_t)(k0 + kk) * Nsrc + sc] : 0.f; }
    asm volatile("s_waitcnt lgkmcnt(0)" ::: "memory");
    const int c = lane & 7;
#pragma unroll
    for (int j = 0; j < 4; ++j) { const int n = (lane >> 3) + 8 * j; const LAS float* s = scr + (8 * c) * 33 + n;
        u32x4 o; o.x = pk2(s[0 * 33], s[1 * 33]); o.y = pk2(s[2 * 33], s[3 * 33]); o.z = pk2(s[4 * 33], s[5 * 33]); o.w = pk2(s[6 * 33], s[7 * 33]);
        *(u32x4*)(WT + (size_t)(n0 + n) * K + k0 + 8 * c) = o; }
    asm volatile("s_waitcnt lgkmcnt(0)" ::: "memory");
}
__device__ __forceinline__ int inproj_srccol(int n) {
    const int t = n >> 8, c = n & 255;
    if (t < 4) { const int half = c >> 7, hh = (c >> 5) & 3, dd = c & 31; const int s = 256 * t + 64 * hh + 32 * half + dd; return (t == 3 && s >= 836) ? -1 : s; }
    if (t < 10) { const int seg = c >> 6, dd = c & 63; return 836 + 384 * seg + 64 * (t - 4) + dd; }
    return 2372 + 256 * (t - 10) + c;
}
__constant__ float ROPE_INV[32] = {1.000000000e+00f, 7.498942018e-01f, 5.623413324e-01f, 4.216965139e-01f, 3.162277639e-01f, 2.371373773e-01f, 1.778279394e-01f, 1.333521456e-01f, 1.000000015e-01f, 7.498942316e-02f, 5.623413250e-02f, 4.216964915e-02f, 3.162277490e-02f, 2.371373773e-02f, 1.778279431e-02f, 1.333521400e-02f, 9.999999776e-03f, 7.498942316e-03f, 5.623413250e-03f, 4.216964822e-03f, 3.162277630e-03f, 2.371373819e-03f, 1.778279431e-03f, 1.333521446e-03f, 1.000000047e-03f, 7.498941850e-04f, 5.623413017e-04f, 4.216965172e-04f, 3.162277571e-04f, 2.371373703e-04f, 1.778279402e-04f, 1.333521504e-04f};

__device__ __forceinline__ void p0_prologue(const Args& A, LAS unsigned char* lds, int vcu, int G) {
    const int tid = opaque_tid0(), lane = tid & 63, wave = __builtin_amdgcn_readfirstlane(tid >> 6);
    unsigned char* ws = A.ws;
    const int gt = vcu * NTHR + tid, NGT = G * NTHR;
    {
        float* CS = (float*)(ws + WS_CS);
        for (int e = gt; e < 6144 * 32; e += NGT) {
            const int p = e >> 5, i = e & 31; const float a = (float)p * ROPE_INV[i];
            const double ad = (double)a; const double kq = __builtin_rint(ad * 0.63661977236758134308); const float y = (float)(ad - kq * 1.57079632679489661923);
            const int q = ((int)kq) & 3; const float y2 = y * y;
            const float sn = y + y * y2 * (-1.6666654611e-1f + y2 * (8.3321608736e-3f + y2 * (-1.9515295891e-4f)));
            const float cn = 1.f - 0.5f * y2 + y2 * y2 * (4.166664568298827e-2f + y2 * (-1.388731625493765e-3f + y2 * 2.443315711809948e-5f));
            const float s = (q == 0) ? sn : (q == 1) ? cn : (q == 2) ? -sn : -cn;
            const float c = (q == 0) ? cn : (q == 1) ? -sn : (q == 2) ? -cn : sn;
            CS[(size_t)p * 64 + i] = c; CS[(size_t)p * 64 + 32 + i] = s;
        }
        float* LB = (float*)(ws + WS_LB);
        for (int e = gt; e < 2 * 384; e += NGT) { const int l = e / 384, j = e % 384; const float l0 = A.in[I_LBL][j], l1 = A.in[I_LBL][384 + j];
            LB[e] = (l == 0) ? 0.f : 1.f / (1.f + expf(l0 - l1)); }
        bf16_t* GW = (bf16_t*)(ws + WS_GW);
        for (int e = gt; e < 2 * 4 * 128 * 128; e += NGT) { const int s = e & 127, t = (e >> 7) & 127; GW[e] = (bf16_t)((s <= t) ? f2bf(A.in[I_GWS][e]) : 0u); }
    }
    if (vcu < 192) {
        LAS float* sc = (LAS float*)lds;
        for (int e = tid; e < NB * DM; e += NTHR) { const float v = A.in[I_C][e]; sc[e] = v * sigmoidf(v); }
        __syncthreads();
        const int l = vcu / 96, n0 = (vcu % 96) * 64, n = n0 + lane;
        const float* W = A.in[I_WADA] + (size_t)l * DM * 6144;
        float acc[32];
#pragma unroll
        for (int b = 0; b < 32; ++b) acc[b] = 0.f;
        for (int k4 = wave * 128; k4 < wave * 128 + 128; k4 += 4) {
            const float w0 = W[(size_t)(k4 + 0) * 6144 + n], w1 = W[(size_t)(k4 + 1) * 6144 + n], w2 = W[(size_t)(k4 + 2) * 6144 + n], w3 = W[(size_t)(k4 + 3) * 6144 + n];
#pragma unroll
            for (int b = 0; b < 32; ++b) { const f32x4 s4 = *(const LAS f32x4*)(sc + b * DM + k4); acc[b] += s4[0] * w0 + s4[1] * w1 + s4[2] * w2 + s4[3] * w3; }
        }
        __syncthreads();
        LAS float* red = (LAS float*)lds;
#pragma unroll
        for (int b = 0; b < 32; ++b) red[(wave * 32 + b) * 64 + lane] = acc[b];
        __syncthreads();
        float* MOD = (float*)(ws + WS_MOD);
        for (int e = tid; e < 32 * 64; e += NTHR) { const int b = e >> 6, j = e & 63; float s = 0.f;
#pragma unroll
            for (int w = 0; w < 8; ++w) s += red[(w * 32 + b) * 64 + j];
            MOD[((size_t)l * 32 + b) * 6144 + n0 + j] = s + A.in[I_BADA][l * 6144 + n0 + j]; }
        __syncthreads();
    }
    LAS float* scr = (LAS float*)(lds + wave * 16384);
    const int gw = vcu * NWAVES + wave, NGW = G * NWAVES;
    constexpr int I_IN = 16 * 96, I_OUT = 16 * 32, I_F1 = 16 * 176, I_F2 = 44 * 32, I_M1 = 16 * 224, I_M2 = 56 * 32;
    constexpr int NITEMS = 2 * I_IN + 2 * I_OUT + I_F1 + I_F2 + 8 * I_M1 + 8 * I_M2;
    for (int it = gw; it < NITEMS; it += NGW) {
        int r = it;
        if (r < 2 * I_IN) { const int l = r / I_IN; r %= I_IN;
            p0_transpose_item(A.in[I_WIN] + (size_t)l * DM * INSRC, DM, INSRC, (bf16_t*)(ws + WS_WIN) + (size_t)l * NIN * DM, scr, r / 96, r % 96, lane, [](int n) { return inproj_srccol(n); }); continue; }
        r -= 2 * I_IN;
        if (r < 2 * I_OUT) { const int l = r / I_OUT; r %= I_OUT;
            p0_transpose_item(A.in[I_WOUT] + (size_t)l * DM * DM, DM, DM, (bf16_t*)(ws + WS_WOUT) + (size_t)l * DM * DM, scr, r / 32, r % 32, lane, [](int n) { return n; }); continue; }
        r -= 2 * I_OUT;
        if (r < I_F1) { const int nb = r % 176; const float* src = ((nb >> 2) & 1) ? A.in[I_FU] : A.in[I_FG];
            p0_transpose_item(src, DM, FD, (bf16_t*)(ws + WS_WF1), scr, r / 176, nb, lane, [](int n) { return 128 * (n >> 8) + (n & 127); }); continue; }
        r -= I_F1;
        if (r < I_F2) { p0_transpose_item(A.in[I_FD], FD, DM, (bf16_t*)(ws + WS_WF2), scr, r / 32, r % 32, lane, [](int n) { return n; }); continue; }
        r -= I_F2;
        if (r < 8 * I_M1) { const int e = r / I_M1; r %= I_M1; const int nb = r % 224; const float* src = (((nb >> 2) & 1) ? A.in[I_MU] : A.in[I_MG]) + (size_t)e * DM * FE;
            p0_transpose_item(src, DM, FE, (bf16_t*)(ws + WS_WM1) + (size_t)e * 7168 * DM, scr, r / 224, nb, lane, [](int n) { return 128 * (n >> 8) + (n & 127); }); continue; }
        r -= 8 * I_M1;
        { const int e = r / I_M2; r %= I_M2;
            p0_transpose_item(A.in[I_MD] + (size_t)e * FE * DM, FE, DM, (bf16_t*)(ws + WS_WM2) + (size_t)e * DM * FE, scr, r / 32, r % 32, lane, [](int n) { return n; }); }
    }
}

__device__ __forceinline__ void norm_phase(const float* x, const float* g, const float* sh, const float* sc, bf16_t* O, int vcu, int G) {
    const int lane = opaque_tid0() & 63, wave = opaque_tid0() >> 6, gw = vcu * NWAVES + wave, NGW = G * NWAVES;
    for (int rb = gw; rb < T / 32; rb += NGW) {
        const int b = (rb * 32) >> 11;
        f32x4 gv[4], sv[4];
#pragma unroll
        for (int j = 0; j < 4; ++j) { const int c = 4 * lane + 256 * j; const f32x4 gg = *(const f32x4*)(g + c), s1 = *(const f32x4*)(sc + (size_t)b * 6144 + c); gv[j] = gg * (s1 + 1.f); sv[j] = *(const f32x4*)(sh + (size_t)b * 6144 + c); }
#pragma unroll 1
        for (int r = 0; r < 32; ++r) {
            const size_t row = (size_t)rb * 32 + r; const f32x4* xr = (const f32x4*)(x + row * DM) + lane;
            f32x4 v[4]; float s = 0.f;
#pragma unroll
            for (int j = 0; j < 4; ++j) { v[j] = xr[64 * j]; s += (v[j][0] * v[j][0] + v[j][1] * v[j][1]) + (v[j][2] * v[j][2] + v[j][3] * v[j][3]); }
            const float rs = 1.f / sqrtf(wave_sum(s) * (1.f / DM) + EPS);
            unsigned long long* o8 = (unsigned long long*)(O + row * DM) + lane;
#pragma unroll
            for (int j = 0; j < 4; ++j) { const f32x4 y = v[j] * rs * gv[j] + sv[j]; o8[64 * j] = (unsigned long long)pk2(y[0], y[1]) | ((unsigned long long)pk2(y[2], y[3]) << 32); }
        }
    }
}
__device__ __forceinline__ void final_norm_phase(float* x, const float* g, int vcu, int G) {
    const int lane = opaque_tid0() & 63, wave = opaque_tid0() >> 6, gw = vcu * NWAVES + wave, NGW = G * NWAVES;
    f32x4 gv[4];
#pragma unroll
    for (int j = 0; j < 4; ++j) gv[j] = *(const f32x4*)(g + 4 * lane + 256 * j);
    for (int row = gw; row < T; row += NGW) {
        f32x4* xr = (f32x4*)(x + (size_t)row * DM) + lane;
        f32x4 v[4]; float s = 0.f;
#pragma unroll
        for (int j = 0; j < 4; ++j) { v[j] = xr[64 * j]; s += (v[j][0] * v[j][0] + v[j][1] * v[j][1]) + (v[j][2] * v[j][2] + v[j][3] * v[j][3]); }
        const float rs = 1.f / sqrtf(wave_sum(s) * (1.f / DM) + EPS);
#pragma unroll
        for (int j = 0; j < 4; ++j) xr[64 * j] = v[j] * rs * gv[j];
    }
}
__device__ __forceinline__ void norm_route_phase(const float* x, const float* g, const float* sh, const float* sc, const float* wr_, bf16_t* O, int* TOK, unsigned* cnt, LAS unsigned char* lds, int vcu, int G) {
    const int tid = opaque_tid0(), lane = tid & 63, wave = tid >> 6;
    LAS float* WR = (LAS float*)lds;
    LAS int* lcnt = (LAS int*)(lds + 32768);
    LAS int* lbase = (LAS int*)(lds + 32768 + 64);
    LAS int* tinfo = (LAS int*)(lds + 32768 + 128);
    for (int e = tid; e < DM * NE; e += NTHR) WR[e] = wr_[e];
    for (int blk = vcu; blk < T / 256; blk += G) {
        __syncthreads();
        if (tid < 16) lcnt[tid] = 0;
        __syncthreads();
        const int b = (blk * 256) >> 11;
        f32x4 gv[4], sv[4];
#pragma unroll
        for (int j = 0; j < 4; ++j) { const int c = 4 * lane + 256 * j; const f32x4 gg = *(const f32x4*)(g + c), s1 = *(const f32x4*)(sc + (size_t)b * 6144 + c); gv[j] = gg * (s1 + 1.f); sv[j] = *(const f32x4*)(sh + (size_t)b * 6144 + c); }
#pragma unroll 1
        for (int r = 0; r < 32; ++r) {
            const int tl = wave * 32 + r; const size_t row = (size_t)blk * 256 + tl; const f32x4* xr = (const f32x4*)(x + row * DM) + lane;
            f32x4 v[4]; float s = 0.f;
#pragma unroll
            for (int j = 0; j < 4; ++j) { v[j] = xr[64 * j]; s += (v[j][0] * v[j][0] + v[j][1] * v[j][1]) + (v[j][2] * v[j][2] + v[j][3] * v[j][3]); }
            const float rs = 1.f / sqrtf(wave_sum(s) * (1.f / DM) + EPS);
            unsigned long long* o8 = (unsigned long long*)(O + row * DM) + lane;
            float lg[8];
#pragma unroll
            for (int e = 0; e < 8; ++e) lg[e] = 0.f;
#pragma unroll
            for (int j = 0; j < 4; ++j) { const f32x4 y = v[j] * rs * gv[j] + sv[j]; o8[64 * j] = (unsigned long long)pk2(y[0], y[1]) | ((unsigned long long)pk2(y[2], y[3]) << 32);
#pragma unroll
                for (int q = 0; q < 4; ++q) { const LAS f32x4* wp = (const LAS f32x4*)(WR + (size_t)(4 * lane + 256 * j + q) * 8); const f32x4 wa = wp[0], wb = wp[1];
                    lg[0] += y[q] * wa[0]; lg[1] += y[q] * wa[1]; lg[2] += y[q] * wa[2]; lg[3] += y[q] * wa[3]; lg[4] += y[q] * wb[0]; lg[5] += y[q] * wb[1]; lg[6] += y[q] * wb[2]; lg[7] += y[q] * wb[3]; } }
#pragma unroll
            for (int e = 0; e < 8; ++e) lg[e] = wave_sum(lg[e]);
            if (lane == 0) {
                int e0 = 0; float v0 = lg[0];
#pragma unroll
                for (int e = 1; e < 8; ++e) if (lg[e] > v0) { v0 = lg[e]; e0 = e; }
                int e1 = -1; float v1 = -3.0e38f;
#pragma unroll
                for (int e = 0; e < 8; ++e) if (e != e0 && lg[e] > v1) { v1 = lg[e]; e1 = e; }
                const float w1 = fast_exp(v1 - v0), g0 = 1.f / (1.f + w1), g1 = w1 * g0;
                const int p0 = atomicAdd((int*)&lcnt[e0], 1), p1 = atomicAdd((int*)&lcnt[8 + e1], 1);
                tinfo[tl * 6 + 0] = e0; tinfo[tl * 6 + 1] = e1; tinfo[tl * 6 + 2] = p0; tinfo[tl * 6 + 3] = p1; tinfo[tl * 6 + 4] = __builtin_bit_cast(int, g0); tinfo[tl * 6 + 5] = __builtin_bit_cast(int, g1);
            }
        }
        __syncthreads();
        if (tid < 16) lbase[tid] = (int)__hip_atomic_fetch_add(cnt + 64 * tid, (unsigned)lcnt[tid], RLX_AGENT);
        __syncthreads();
        if (tid < 256) { int* o = TOK + ((size_t)blk * 256 + tid) * 8; const int e0 = tinfo[tid * 6], e1 = tinfo[tid * 6 + 1];
            o[0] = e0; o[1] = e1; o[2] = tinfo[tid * 6 + 2] + lbase[e0]; o[3] = tinfo[tid * 6 + 3] + lbase[8 + e1]; o[4] = tinfo[tid * 6 + 4]; o[5] = tinfo[tid * 6 + 5]; }
    }
}
__device__ __forceinline__ void moe_prefix(unsigned* cnt, int k, LAS int* tp) {
    if (opaque_tid0() == 0) { int a = 0; for (int e = 0; e < 8; ++e) { tp[e] = a; a += ((int)__hip_atomic_load(cnt + 64 * (k * 8 + e), RLX_AGENT) + 255) >> 8; } tp[8] = a; }
    __syncthreads();
}
__device__ __forceinline__ void moe_gather_phase(const bf16_t* HB, bf16_t* HS, const int* TOK, int* RI, unsigned* cnt, LAS unsigned char* lds, int vcu, int G) {
    const int tid = opaque_tid0(), lane = tid & 63, wave = tid >> 6, gw = vcu * NWAVES + wave, NGW = G * NWAVES;
    LAS int* tp = (LAS int*)lds;
    moe_prefix(cnt, 0, tp); moe_prefix(cnt, 1, tp + 9);
    for (int tok = gw; tok < T; tok += NGW) {
        const int* ti = TOK + (size_t)tok * 8;
        const u32x4 a = *((const u32x4*)(HB + (size_t)tok * DM) + lane), b = *((const u32x4*)(HB + (size_t)tok * DM) + 64 + lane);
#pragma unroll
        for (int k = 0; k < 2; ++k) { const int e = ti[k], row = 256 * tp[k * 9 + e] + ti[2 + k];
            u32x4* d = (u32x4*)(HS + ((size_t)k * HSROWS + row) * DM); d[lane] = a; d[64 + lane] = b;
            if (lane == 0) { RI[((size_t)k * HSROWS + row) * 2] = tok; RI[((size_t)k * HSROWS + row) * 2 + 1] = ti[4 + k]; } }
    }
    for (int it = vcu; it < 16; it += G) { const int k = it >> 3, e = it & 7; const int c = (int)__hip_atomic_load(cnt + 64 * it, RLX_AGENT), base = 256 * tp[k * 9 + e];
        for (int r = c + tid; r < ((c + 255) & ~255); r += NTHR) RI[((size_t)k * HSROWS + base + r) * 2] = -1; }
}

typedef f32x16 acc16;
__device__ __forceinline__ acc16 zero16() { acc16 z;
#pragma unroll
    for (int i = 0; i < 16; ++i) z[i] = 0.f; return z; }
#define MFMA32(a, b, c) __builtin_amdgcn_mfma_f32_32x32x16_bf16((a), (b), (c), 0, 0, 0)
__device__ __forceinline__ bf16x8 ld_lds8(const LAS bf16_t* p) { return *(const LAS bf16x8*)p; }

struct MixPtrs { const bf16_t *QA, *KA, *VAT, *IQ, *IK; const float* IW; const bf16_t *HQ, *HKK, *HI, *HG; const float* HLF; const bf16_t *GU, *GV; unsigned long long* BM; bf16_t* MIX; };

__device__ __forceinline__ void hgrn_unit(LAS unsigned char* lds, const MixPtrs& P, int b, int h, const float* onorm) {
    const int tid = opaque_tid0(), lane = tid & 63, w = tid >> 6, l32 = lane & 31, hh = lane >> 5;
    LAS float* BC = (LAS float*)lds;
    LAS float* GT = (LAS float*)(lds + 16384);
    LAS bf16_t* QA_ = (LAS bf16_t*)(lds + 18432);
    LAS bf16_t* KA_ = (LAS bf16_t*)(lds + 27648);
    LAS bf16_t* QB_ = (LAS bf16_t*)(lds + 36864);
    LAS bf16_t* KB_ = (LAS bf16_t*)(lds + 41472);
    LAS bf16_t* QE_ = (LAS bf16_t*)(lds + 46080);
    LAS bf16_t* KST = (LAS bf16_t*)(lds + 55296);
    LAS bf16_t* VT_ = (LAS bf16_t*)(lds + 64512);
    LAS bf16_t* AM_ = (LAS bf16_t*)(lds + 73728);
    LAS float* ST_ = (LAS float*)(lds + 82944);
    LAS float* OO_ = (LAS float*)(lds + 100352);
    for (int e = tid; e < 64 * 68; e += NTHR) ST_[e] = 0.f;
    const int te = tid >> 3, d0 = (tid & 7) * 8;
    const size_t rowb = (size_t)b * SEQ;
    float og[8];
#pragma unroll
    for (int i = 0; i < 8; ++i) og[i] = onorm[d0 + i];
    float nlf[8]; u32x4 nq, nk, nv, ng;
    {
#pragma unroll
        for (int i = 0; i < 8; ++i) nlf[i] = P.HLF[((rowb + 8 * w + i) * 6 + h) * 64 + lane];
        const size_t o = ((rowb + te) * 6 + h) * 64 + d0; nq = *(const u32x4*)(P.HQ + o); nk = *(const u32x4*)(P.HKK + o); nv = *(const u32x4*)(P.HI + o); ng = *(const u32x4*)(P.HG + o);
    }
    for (int c = 0; c < 32; ++c) {
        float lf[8]; u32x4 cq = nq, ck = nk, cv = nv, cg = ng;
#pragma unroll
        for (int i = 0; i < 8; ++i) lf[i] = nlf[i];
        if (c + 1 < 32) {
            const size_t r1 = rowb + (size_t)(c + 1) * 64;
#pragma unroll
            for (int i = 0; i < 8; ++i) nlf[i] = P.HLF[((r1 + 8 * w + i) * 6 + h) * 64 + lane];
            const size_t o = ((r1 + te) * 6 + h) * 64 + d0; nq = *(const u32x4*)(P.HQ + o); nk = *(const u32x4*)(P.HKK + o); nv = *(const u32x4*)(P.HI + o); ng = *(const u32x4*)(P.HG + o);
        }
#pragma unroll
        for (int i = 1; i < 8; ++i) lf[i] += lf[i - 1];
        GT[w * 64 + lane] = lf[7];
        __syncthreads();
        { float off = 0.f;
#pragma unroll
            for (int ww = 0; ww < 7; ++ww) off += (ww < w) ? GT[ww * 64 + lane] : 0.f;
#pragma unroll
            for (int i = 0; i < 8; ++i) BC[(8 * w + i) * 64 + lane] = lf[i] + off; }
        __syncthreads();
        {
            const f32x4 ba = *(const LAS f32x4*)(BC + te * 64 + d0), bb = *(const LAS f32x4*)(BC + te * 64 + d0 + 4);
            const int rr = (te < 32) ? 16 : 48;
            const f32x4 ra = *(const LAS f32x4*)(BC + rr * 64 + d0), rb = *(const LAS f32x4*)(BC + rr * 64 + d0 + 4);
            const f32x4 ma = *(const LAS f32x4*)(BC + 31 * 64 + d0), mb = *(const LAS f32x4*)(BC + 31 * 64 + d0 + 4);
            const f32x4 la = *(const LAS f32x4*)(BC + 63 * 64 + d0), lb_ = *(const LAS f32x4*)(BC + 63 * 64 + d0 + 4);
            float q[8], k[8], bt[8], rf[8], md[8], ls[8];
#pragma unroll
            for (int i = 0; i < 4; ++i) { q[2 * i] = bf2f((unsigned short)(cq[i] & 0xffff)); q[2 * i + 1] = bf2f((unsigned short)(cq[i] >> 16)); k[2 * i] = bf2f((unsigned short)(ck[i] & 0xffff)); k[2 * i + 1] = bf2f((unsigned short)(ck[i] >> 16)); }
#pragma unroll
            for (int i = 0; i < 4; ++i) { bt[i] = ba[i]; bt[4 + i] = bb[i]; rf[i] = ra[i]; rf[4 + i] = rb[i]; md[i] = ma[i]; md[4 + i] = mb[i]; ls[i] = la[i]; ls[4 + i] = lb_[i]; }
            float qa[8], ka[8], qe[8], xb[8], ks[8];
#pragma unroll
            for (int i = 0; i < 8; ++i) { qa[i] = q[i] * fast_exp(bt[i] - rf[i]); ka[i] = k[i] * fast_exp(rf[i] - bt[i]); qe[i] = q[i] * fast_exp(bt[i]);
                xb[i] = (te < 32) ? k[i] * fast_exp(md[i] - bt[i]) : q[i] * fast_exp(bt[i] - md[i]); ks[i] = k[i] * fast_exp(ls[i] - bt[i]); }
            u32x4 pq, pk, pe, px;
#pragma unroll
            for (int i = 0; i < 4; ++i) { pq[i] = pk2(qa[2 * i], qa[2 * i + 1]); pk[i] = pk2(ka[2 * i], ka[2 * i + 1]); pe[i] = pk2(qe[2 * i], qe[2 * i + 1]); px[i] = pk2(xb[2 * i], xb[2 * i + 1]); }
            *(LAS u32x4*)(QA_ + te * 72 + d0) = pq; *(LAS u32x4*)(KA_ + te * 72 + d0) = pk; *(LAS u32x4*)(QE_ + te * 72 + d0) = pe;
            if (te < 32) *(LAS u32x4*)(KB_ + te * 72 + d0) = px; else *(LAS u32x4*)(QB_ + (te - 32) * 72 + d0) = px;
#pragma unroll
            for (int i = 0; i < 8; ++i) KST[(d0 + i) * 72 + te] = (bf16_t)f2bf(ks[i]);
#pragma unroll
            for (int i = 0; i < 4; ++i) { VT_[(d0 + 2 * i) * 72 + te] = (bf16_t)(cv[i] & 0xffff); VT_[(d0 + 2 * i + 1) * 72 + te] = (bf16_t)(cv[i] >> 16); }
        }
        __syncthreads();
        acc16 oacc = zero16();
        if (w < 3) {
            const LAS bf16_t* Qs = (w == 0) ? QA_ : (w == 1) ? QA_ + 32 * 72 : QB_;
            const LAS bf16_t* Ks = (w == 0) ? KA_ : (w == 1) ? KA_ + 32 * 72 : KB_;
            acc16 a = zero16();
#pragma unroll
            for (int kk = 0; kk < 4; ++kk) a = MFMA32(ld_lds8(Qs + l32 * 72 + 8 * hh + 16 * kk), ld_lds8(Ks + l32 * 72 + 8 * hh + 16 * kk), a);
            const int tb = (w == 0) ? 0 : 32, sb = (w == 1) ? 32 : 0;
#pragma unroll
            for (int i = 0; i < 16; ++i) { const int tl = 8 * (i >> 2) + 4 * hh + (i & 3); const float v = (w < 2 && l32 > tl) ? 0.f : a[i]; AM_[(tb + tl) * 72 + sb + l32] = (bf16_t)f2bf(v); }
        } else if (w < 7) {
            const int th = (w - 3) >> 1, vh = (w - 3) & 1;
#pragma unroll
            for (int kk = 0; kk < 4; ++kk) {
                const LAS float* sp = ST_ + (vh * 32 + l32) * 68 + 8 * hh + 16 * kk; const f32x4 s0 = *(const LAS f32x4*)sp, s1 = *(const LAS f32x4*)(sp + 4);
                u32x4 sbv; sbv[0] = pk2(s0[0], s0[1]); sbv[1] = pk2(s0[2], s0[3]); sbv[2] = pk2(s1[0], s1[1]); sbv[3] = pk2(s1[2], s1[3]);
                oacc = MFMA32(ld_lds8(QE_ + (th * 32 + l32) * 72 + 8 * hh + 16 * kk), __builtin_bit_cast(bf16x8, sbv), oacc);
            }
        }
        __syncthreads();
        if (w >= 3 && w < 7) {
            const int th = (w - 3) >> 1, vh = (w - 3) & 1; const int nk = th ? 4 : 2;
            for (int kk = 0; kk < nk; ++kk) oacc = MFMA32(ld_lds8(AM_ + (th * 32 + l32) * 72 + 8 * hh + 16 * kk), ld_lds8(VT_ + (vh * 32 + l32) * 72 + 8 * hh + 16 * kk), oacc);
#pragma unroll
            for (int i = 0; i < 16; ++i) { const int tl = 8 * (i >> 2) + 4 * hh + (i & 3); OO_[(th * 32 + tl) * 68 + vh * 32 + l32] = oacc[i]; }
        } else {
            const int idx = (w == 7) ? 3 : w, vh = idx >> 1, dh = idx & 1;
            acc16 a = zero16();
#pragma unroll
            for (int kk = 0; kk < 4; ++kk) a = MFMA32(ld_lds8(VT_ + (vh * 32 + l32) * 72 + 8 * hh + 16 * kk), ld_lds8(KST + (dh * 32 + l32) * 72 + 8 * hh + 16 * kk), a);
            const float dec = fast_exp(BC[63 * 64 + dh * 32 + l32]);
#pragma unroll
            for (int i = 0; i < 16; ++i) { const int vl = 8 * (i >> 2) + 4 * hh + (i & 3); LAS float* sp = ST_ + (vh * 32 + vl) * 68 + dh * 32 + l32; *sp = dec * (*sp) + a[i]; }
        }
        __syncthreads();
        {
            const f32x4 oa = *(const LAS f32x4*)(OO_ + te * 68 + d0), ob = *(const LAS f32x4*)(OO_ + te * 68 + d0 + 4);
            float ss = (oa[0] * oa[0] + oa[1] * oa[1]) + (oa[2] * oa[2] + oa[3] * oa[3]) + (ob[0] * ob[0] + ob[1] * ob[1]) + (ob[2] * ob[2] + ob[3] * ob[3]);
            ss += __shfl_xor(ss, 1); ss += __shfl_xor(ss, 2); ss += __shfl_xor(ss, 4);
            const float rs = 1.f / sqrtf(ss * (1.f / 64.f) + EPS);
            float r[8];
#pragma unroll
            for (int i = 0; i < 4; ++i) { r[i] = oa[i] * rs * og[i]; r[4 + i] = ob[i] * rs * og[4 + i]; }
#pragma unroll
            for (int i = 0; i < 4; ++i) { r[2 * i] *= bf2f((unsigned short)(cg[i] & 0xffff)); r[2 * i + 1] *= bf2f((unsigned short)(cg[i] >> 16)); }
            u32x4 o; o[0] = pk2(r[0], r[1]); o[1] = pk2(r[2], r[3]); o[2] = pk2(r[4], r[5]); o[3] = pk2(r[6], r[7]);
            *(u32x4*)(P.MIX + (rowb + (size_t)c * 64 + te) * DM + 384 + h * 64 + d0) = o;
        }
    }
}

__device__ __forceinline__ void gmlp_unit(LAS unsigned char* lds, const MixPtrs& P, int b, int n, const float* vng, const float* vnb, const bf16_t* GW, const float* gbs) {
    const int tid = opaque_tid0(), lane = tid & 63, w = tid >> 6, l32 = lane & 31, hh = lane >> 5;
    LAS bf16_t* VT = (LAS bf16_t*)lds;
    const size_t row0 = (size_t)b * SEQ + (size_t)n * 128;
    {
        const int s = 16 * w + (lane >> 2), c0 = 64 * (lane & 3);
        float x[64];
#pragma unroll
        for (int i = 0; i < 8; ++i) { const u32x4 v = *(const u32x4*)(P.GV + (row0 + s) * 256 + c0 + 8 * i);
#pragma unroll
            for (int j = 0; j < 4; ++j) { x[8 * i + 2 * j] = bf2f((unsigned short)(v[j] & 0xffff)); x[8 * i + 2 * j + 1] = bf2f((unsigned short)(v[j] >> 16)); } }
        float sm = 0.f;
#pragma unroll
        for (int i = 0; i < 64; ++i) sm += x[i];
        sm += __shfl_xor(sm, 1); sm += __shfl_xor(sm, 2);
        const float mu = sm * (1.f / 256.f); float vq = 0.f;
#pragma unroll
        for (int i = 0; i < 64; ++i) { x[i] -= mu; vq += x[i] * x[i]; }
        vq += __shfl_xor(vq, 1); vq += __shfl_xor(vq, 2);
        const float rs = 1.f / sqrtf(vq * (1.f / 256.f) + EPS);
#pragma unroll
        for (int i = 0; i < 64; ++i) VT[(c0 + i) * 136 + s] = (bf16_t)f2bf(x[i] * rs * vng[c0 + i] + vnb[c0 + i]);
    }
    __syncthreads();
    const int g = w >> 1, db = w & 1;
    acc16 acc[4];
#pragma unroll
    for (int tb = 0; tb < 4; ++tb) { acc[tb] = zero16();
#pragma unroll
        for (int kk = 0; kk < 8; ++kk) if (kk < 2 * (tb + 1))
            acc[tb] = MFMA32(*(const bf16x8*)(GW + ((size_t)g * 128 + tb * 32 + l32) * 128 + 8 * hh + 16 * kk), ld_lds8(VT + (g * 64 + db * 32 + l32) * 136 + 8 * hh + 16 * kk), acc[tb]); }
    const int cch = g * 64 + db * 32 + l32;
#pragma unroll
    for (int tb = 0; tb < 4; ++tb)
#pragma unroll
        for (int i = 0; i < 16; ++i) { const int t = tb * 32 + 8 * (i >> 2) + 4 * hh + (i & 3);
            const float u = bf2f(P.GU[(row0 + t) * 256 + cch]);
            P.MIX[(row0 + t) * DM + 768 + cch] = (bf16_t)f2bf(u * (acc[tb][i] + gbs[g * 128 + t])); }
}

constexpr int SC_STRIDE = 2052;
__device__ __forceinline__ void dsa_select_unit(LAS unsigned char* lds, const MixPtrs& P, int b, int j) {
    const int tid = opaque_tid0(), lane = tid & 63, w = tid >> 6, l32 = lane & 31, hh = lane >> 5;
    LAS unsigned short* SC = (LAS unsigned short*)lds;
    const size_t rowb = (size_t)b * SEQ;
    {
        bf16x8 qf[4][4];
        const size_t qrow = rowb + (size_t)j * 32 + l32;
#pragma unroll
        for (int hd = 0; hd < 4; ++hd)
#pragma unroll
            for (int kk = 0; kk < 4; ++kk) qf[hd][kk] = *(const bf16x8*)(P.IQ + (qrow * 4 + hd) * 64 + 8 * hh + 16 * kk);
        f32x4 iw = *(const f32x4*)(P.IW + qrow * 4); iw *= 0.5f;
        for (int kt = w; kt <= j; kt += 8) {
            bf16x8 kf[4];
#pragma unroll
            for (int kk = 0; kk < 4; ++kk) kf[kk] = *(const bf16x8*)(P.IK + (rowb + (size_t)kt * 32 + l32) * 64 + 8 * hh + 16 * kk);
            acc16 a[4];
#pragma unroll
            for (int hd = 0; hd < 4; ++hd) { a[hd] = zero16();
#pragma unroll
                for (int kk = 0; kk < 4; ++kk) a[hd] = MFMA32(kf[kk], qf[hd][kk], a[hd]); }
#pragma unroll
            for (int gq = 0; gq < 4; ++gq) {
                unsigned short ky[4];
#pragma unroll
                for (int i4 = 0; i4 < 4; ++i4) { const int i = 4 * gq + i4;
                    float sc = iw[0] * fmaxf(a[0][i] * 0.125f, 0.f) + iw[1] * fmaxf(a[1][i] * 0.125f, 0.f) + iw[2] * fmaxf(a[2][i] * 0.125f, 0.f) + iw[3] * fmaxf(a[3][i] * 0.125f, 0.f);
                    sc = fminf(fmaxf(sc, -60000.f), 60000.f);
                    const unsigned short hb = __builtin_bit_cast(unsigned short, (_Float16)sc);
                    unsigned short key = (hb & 0x8000) ? (unsigned short)~hb : (unsigned short)(hb | 0x8000);
                    if (kt == j && (8 * gq + 4 * hh + i4) > l32) key = 0;
                    ky[i4] = key; }
                u32x2 pk; pk[0] = (unsigned)ky[0] | ((unsigned)ky[1] << 16); pk[1] = (unsigned)ky[2] | ((unsigned)ky[3] << 16);
                *(LAS u32x2*)(SC + l32 * SC_STRIDE + kt * 32 + 8 * gq + 4 * hh) = pk;
            }
        }
    }
    __syncthreads();
    const int NK = 32 * (j + 1), Mw = (j + 2) >> 1;
    for (int r = 0; r < 4; ++r) {
        const int q = 4 * w + r, t = 32 * j + q;
        unsigned k[32];
#pragma unroll
        for (int m = 0; m < 32; ++m) { k[m] = 0u; if (m < Mw) { const int s = 64 * m + lane; k[m] = (s < NK) ? (unsigned)SC[q * SC_STRIDE + s] : 0u; } }
        unsigned long long myw = 0ull;
        if (t + 1 <= 256) {
#pragma unroll
            for (int m = 0; m < 32; ++m) if (m < Mw) { const unsigned long long bm = __ballot(64 * m + lane <= t); if (lane == m) myw = bm; }
        } else {
            unsigned v = 0u;
            for (int bit = 15; bit >= 0; --bit) { const unsigned cand = v | (1u << bit); int cnt = 0;
#pragma unroll
                for (int m = 0; m < 32; ++m) if (m < Mw) cnt += __popcll(__ballot(k[m] >= cand));
                if (cnt >= 256) v = cand; }
            int ngt = 0;
#pragma unroll
            for (int m = 0; m < 32; ++m) if (m < Mw) ngt += __popcll(__ballot(k[m] > v));
            int need = 256 - ngt;
#pragma unroll
            for (int m = 0; m < 32; ++m) if (m < Mw) {
                const unsigned long long gtm = __ballot(k[m] > v), eqm = __ballot(k[m] == v);
                unsigned long long sel = 0ull; const int c = __popcll(eqm);
                if (need > 0) { if (c <= need) { sel = eqm; need -= c; }
                    else { const int pre = __builtin_amdgcn_mbcnt_hi((unsigned)(eqm >> 32), __builtin_amdgcn_mbcnt_lo((unsigned)eqm, 0u)); sel = __ballot(((eqm >> lane) & 1ull) && pre < need); need = 0; } }
                if (lane == m) myw = gtm | sel; }
        }
        if (lane < 32) P.BM[(rowb + t) * 32 + lane] = myw;
    }
}

constexpr int QL_STRIDE = 392;
__device__ __forceinline__ void dsa_attn_unit(LAS unsigned char* lds, const MixPtrs& P, int b, int J, float kmaxn) {
    const int tid = opaque_tid0(), lane = tid & 63, w = tid >> 6, qi = lane & 31, hh = lane >> 5;
    LAS bf16_t* KT = (LAS bf16_t*)lds;
    LAS bf16_t* VTT = (LAS bf16_t*)(lds + 2 * 64 * 72 * 2);
    LAS bf16_t* QL = (LAS bf16_t*)(lds + 4 * 64 * 72 * 2);
    const int qblk = w >> 1, hs = (w & 1) * 3;
    const size_t rowb = (size_t)b * SEQ; const int t = 128 * J + 32 * qblk + qi; const size_t row = rowb + t;
    for (int e = tid; e < 128 * 48; e += NTHR) { const int r = e / 48, p = e % 48; *(LAS u32x4*)(QL + r * QL_STRIDE + 8 * p) = *(const u32x4*)(P.QA + (rowb + (size_t)128 * J + r) * 384 + 8 * p); }
    __syncthreads();
    const LAS bf16_t* qp = QL + (32 * qblk + qi) * QL_STRIDE + hs * 64 + 8 * hh;
    float negb[3];
#pragma unroll
    for (int h3 = 0; h3 < 3; ++h3) { float ss = 0.f;
#pragma unroll
        for (int kk = 0; kk < 4; ++kk) { const bf16x8 q8 = ld_lds8(qp + h3 * 64 + 16 * kk);
#pragma unroll
            for (int e = 0; e < 8; ++e) { const float f = bf2f((unsigned short)q8[e]); ss += f * f; } }
        ss += __shfl_xor(ss, 32);
        negb[h3] = -(sqrtf(ss) * kmaxn * 1.02f + 1e-3f); }
    acc16 O[3][2]; float lsum[3];
#pragma unroll
    for (int h3 = 0; h3 < 3; ++h3) { O[h3][0] = zero16(); O[h3][1] = zero16(); lsum[h3] = 0.f; }
    const int nt = 2 * (J + 1);
    const int lr = tid >> 3, lp = (tid & 7) * 8;
    u32x4 rk = *(const u32x4*)(P.KA + (rowb + lr) * 64 + lp), rv = *(const u32x4*)(P.VAT + ((size_t)b * 64 + lr) * 2048 + lp);
    unsigned long long mw = P.BM[row * 32 + 0];
#pragma unroll 1
    for (int tile = 0; tile < nt; ++tile) {
        const int buf = tile & 1;
        *(LAS u32x4*)(KT + (buf * 64 + lr) * 72 + lp) = rk; *(LAS u32x4*)(VTT + (buf * 64 + lr) * 72 + lp) = rv;
        const unsigned long long cmw = mw;
        __syncthreads();
        if (tile + 1 < nt) { rk = *(const u32x4*)(P.KA + (rowb + (size_t)(tile + 1) * 64 + lr) * 64 + lp); rv = *(const u32x4*)(P.VAT + ((size_t)b * 64 + lr) * 2048 + (tile + 1) * 64 + lp); mw = P.BM[row * 32 + tile + 1]; }
#pragma unroll
        for (int sub = 0; sub < 2; ++sub) {
            const int msh = (int)((unsigned)(cmw >> (32 * sub)) >> (4 * hh));
            const LAS bf16_t* kp = KT + (buf * 64 + sub * 32 + qi) * 72 + 8 * hh;
            const LAS bf16_t* vp = VTT + (buf * 64 + qi) * 72 + sub * 32 + 4 * hh;
#pragma unroll
            for (int h3 = 0; h3 < 3; ++h3) {
                asm volatile("" ::: "memory"); __builtin_amdgcn_sched_barrier(0);
                acc16 s;
#pragma unroll
                for (int i = 0; i < 16; ++i) s[i] = negb[h3];
#pragma unroll
                for (int kk = 0; kk < 4; ++kk) s = MFMA32(ld_lds8(kp + 16 * kk), ld_lds8(qp + h3 * 64 + 16 * kk), s);
#pragma unroll
                for (int s2 = 0; s2 < 2; ++s2) {
                    float p[8];
#pragma unroll
                    for (int i = 0; i < 8; ++i) { const int ii = 8 * s2 + i; p[i] = __builtin_bit_cast(float, __builtin_bit_cast(int, __builtin_amdgcn_exp2f(s[ii])) & __builtin_amdgcn_sbfe(msh, 8 * (ii >> 2) + (ii & 3), 1)); lsum[h3] += p[i]; }
                    u32x4 pp;
#pragma unroll
                    for (int i = 0; i < 4; ++i) pp[i] = pk2(p[2 * i], p[2 * i + 1]);
#pragma unroll
                    for (int db = 0; db < 2; ++db) { const u32x2 lo = *(const LAS u32x2*)(vp + db * 32 * 72 + 16 * s2), hi = *(const LAS u32x2*)(vp + db * 32 * 72 + 16 * s2 + 8);
                        u32x4 c; c[0] = lo[0]; c[1] = lo[1]; c[2] = hi[0]; c[3] = hi[1];
                        O[h3][db] = MFMA32(__builtin_bit_cast(bf16x8, c), __builtin_bit_cast(bf16x8, pp), O[h3][db]); }
                }
            }
        }
    }
#pragma unroll
    for (int h3 = 0; h3 < 3; ++h3) {
        float l = lsum[h3]; l += __shfl_xor(l, 32); const float inv = 1.f / l;
#pragma unroll
        for (int db = 0; db < 2; ++db)
#pragma unroll
            for (int gq = 0; gq < 4; ++gq) { u32x2 o; o[0] = pk2(O[h3][db][4 * gq] * inv, O[h3][db][4 * gq + 1] * inv); o[1] = pk2(O[h3][db][4 * gq + 2] * inv, O[h3][db][4 * gq + 3] * inv);
                *(u32x2*)(P.MIX + row * DM + (hs + h3) * 64 + db * 32 + 8 * gq + 4 * hh) = o; }
    }
    __syncthreads();
}

__device__ __forceinline__ unsigned char* launder(unsigned char* p) { asm volatile("" : "+s"(p)); return p; }
__device__ __forceinline__ MixPtrs make_mp(unsigned char* ws) {
    MixPtrs MP;
    MP.QA = (bf16_t*)(ws + WS_QA); MP.KA = (bf16_t*)(ws + WS_KA); MP.VAT = (bf16_t*)(ws + WS_VAT); MP.IQ = (bf16_t*)(ws + WS_IQ); MP.IK = (bf16_t*)(ws + WS_IK); MP.IW = (float*)(ws + WS_IW);
    MP.HQ = (bf16_t*)(ws + WS_HQ); MP.HKK = (bf16_t*)(ws + WS_HKK); MP.HI = (bf16_t*)(ws + WS_HI); MP.HG = (bf16_t*)(ws + WS_HG); MP.HLF = (float*)(ws + WS_HLF);
    MP.GU = (bf16_t*)(ws + WS_GU); MP.GV = (bf16_t*)(ws + WS_GV); MP.BM = (unsigned long long*)(ws + WS_BM); MP.MIX = (bf16_t*)(ws + WS_ACT1);
    return MP;
}
constexpr int NPH = 26;
__global__ void __launch_bounds__(NTHR, 2) fwd_kernel(Args args) {
    extern __shared__ __attribute__((aligned(16))) unsigned char lds_raw[];
    LAS unsigned char* lds = (LAS unsigned char*)lds_raw;
    volatile LAS unsigned* MISC = (volatile LAS unsigned*)(lds + LDS_MISC);
    const int tid = opaque_tid0();
    const int G = gridDim.x; const int bx = blockIdx.x; const int vcu = (G % 8 == 0) ? (bx % 8) * (G / 8) + bx / 8 : bx;
    unsigned char* ws = args.ws;
    unsigned* ctl = (unsigned*)(ws + WS_CTL);
    if (tid < 64) MISC[tid] = 0u;
    __syncthreads();
    XcdBarrier bar = xcd_barrier_post(ctl + CW_BAR, MISC + 8);
    volatile LAS int* qslot = (volatile LAS int*)(MISC + 16);
    LAS int* tpl = (LAS int*)(lds + LDS_MISC + 128);
    const int lo = args.ph_lo, hi = args.ph_hi;
#ifndef PHMASK
#define PHMASK 0xFFFFFFFFu
#endif
#define PH(k) (lo <= (k) && (k) < hi)
#define PHM(j) ((PHMASK >> ((j) + 1)) & 1u)
#define PHL(j) (PHM(j) && PH(pb + (j)))
#define SEAM(k) do { if ((k) + 1 < hi) xcd_barrier(bar); } while (0)
    if ((PHMASK & 1u) && PH(0)) { p0_prologue(args, lds, vcu, G); SEAM(0); }

    for (int l = 0; l < 2; ++l) {
        const int pb = 1 + 12 * l;
        if (PHL(0)) { unsigned char* w = launder(ws); const float* modl = (const float*)(w + WS_MOD) + (size_t)l * 32 * 6144;
            norm_phase((l == 0) ? args.in[I_X] : args.out, args.in[I_GMIX] + l * DM, modl + 0, modl + 1024, (bf16_t*)(w + WS_ACT1), vcu, G); SEAM(pb + 0); }
        if (PHL(1)) {
            unsigned char* w = launder(ws); const MixPtrs MP = make_mp(w);
            pg8::Gemm g{(const bf16_t*)(w + WS_ACT1), (const bf16_t*)(w + WS_WIN) + (size_t)l * NIN * DM, T, NIN, DM}; pg8::StaticOrder S; S.init(T, NIN, G, bx);
            EpiInproj E; E.QA = (bf16_t*)MP.QA; E.KA = (bf16_t*)MP.KA; E.VAT = (bf16_t*)MP.VAT; E.IQ = (bf16_t*)MP.IQ; E.IK = (bf16_t*)MP.IK; E.IW = (float*)MP.IW; E.HQ = (bf16_t*)MP.HQ; E.HKK = (bf16_t*)MP.HKK; E.HI = (bf16_t*)MP.HI; E.HG = (bf16_t*)MP.HG; E.HLF = (float*)MP.HLF;
            E.GU = (bf16_t*)MP.GU; E.GV = (bf16_t*)MP.GV; E.CS = (const float*)(w + WS_CS); E.pos = (const int*)args.in[I_POS]; E.lb = (const float*)(w + WS_LB) + l * 384; E.kmax = (unsigned*)(w + WS_CTL) + CW_KMAX + l * 32;
            pg8::gemm_phase<EpiInproj, pg8::StaticOrder>(lds, g, S, E);
            SEAM(pb + 1);
        }
        if (PHL(2)) {
#if EN_HGRN
            { unsigned char* w = launder(ws); const MixPtrs MP = make_mp(w); unsigned* ctr = (unsigned*)(w + WS_CTL) + CW_Q + 64 * (4 * l + 0);
              for (;;) { const int u = q_next(ctr, qslot); if (u >= 192) break; hgrn_unit(lds, MP, u / 6, u % 6, args.in[I_ONORM] + l * 64); } }
#endif
#if EN_DSA
            { unsigned char* w = launder(ws); const MixPtrs MP = make_mp(w); unsigned* ctr = (unsigned*)(w + WS_CTL) + CW_Q + 64 * (4 * l + 1);
              for (;;) { const int u = q_next(ctr, qslot); if (u >= 2048) break; dsa_select_unit(lds, MP, u & 31, 63 - (u >> 5)); } }
#endif
#if EN_GMLP
            { unsigned char* w = launder(ws); const MixPtrs MP = make_mp(w); unsigned* ctr = (unsigned*)(w + WS_CTL) + CW_Q + 64 * (4 * l + 2);
              for (;;) { const int u = q_next(ctr, qslot); if (u >= 512) break;
                  gmlp_unit(lds, MP, u >> 4, u & 15, args.in[I_VNG] + l * 256, args.in[I_VNB] + l * 256, (const bf16_t*)(w + WS_GW) + (size_t)l * 4 * 128 * 128, args.in[I_GBS] + l * 512); } }
#endif
#if !EN_HGRN || !EN_GMLP || !EN_DSA
            {
                unsigned char* w = launder(ws); bf16_t* A1 = (bf16_t*)(w + WS_ACT1); const int tz = opaque_tid0();
                for (size_t e = (size_t)vcu * NTHR + tz; e < (size_t)T * 1024; e += (size_t)G * NTHR) { const int c = (int)(e & 1023);
                    const bool z = (!EN_DSA && c < 384) || (!EN_HGRN && c >= 384 && c < 768) || (!EN_GMLP && c >= 768); if (z) A1[e] = 0; }
            }
#endif
            SEAM(pb + 2);
        }
        if (PHL(3)) {
#if EN_DSA
            unsigned char* w = launder(ws); const MixPtrs MP = make_mp(w); unsigned* cw = (unsigned*)(w + WS_CTL); unsigned* ctr = cw + CW_Q + 64 * (4 * l + 3);
            for (;;) {
                const int u = q_next(ctr, qslot);
                if (u >= 512) break;
                const int b = u & 31, J = 15 - (u >> 5);
                const float km = sqrtf(__builtin_bit_cast(float, __hip_atomic_load(cw + CW_KMAX + l * 32 + b, RLX_AGENT)));
                dsa_attn_unit(lds, MP, b, J, km);
            }
#endif
            SEAM(pb + 3);
        }
        if (PHL(4)) {
            unsigned char* w = launder(ws); const float* modl = (const float*)(w + WS_MOD) + (size_t)l * 32 * 6144;
            pg8::Gemm g{(const bf16_t*)(w + WS_ACT1), (const bf16_t*)(w + WS_WOUT) + (size_t)l * DM * DM, T, DM, DM}; pg8::StaticOrder S; S.init(T, DM, G, bx);
            EpiResid E{(l == 0) ? args.in[I_X] : args.out, args.out, modl + 2 * 1024};
            pg8::gemm_phase<EpiResid, pg8::StaticOrder>(lds, g, S, E);
            SEAM(pb + 4);
        }
        if (l == 0) {
            if (PHL(5)) { unsigned char* w = launder(ws); const float* modl = (const float*)(w + WS_MOD) + (size_t)l * 32 * 6144;
                norm_phase(args.out, args.in[I_GFFN] + l * DM, modl + 3 * 1024, modl + 4 * 1024, (bf16_t*)(w + WS_ACT1), vcu, G); SEAM(pb + 5); }
            if (PHL(7)) {
                unsigned char* w = launder(ws);
                pg8::Gemm g{(const bf16_t*)(w + WS_ACT1), (const bf16_t*)(w + WS_WF1), T, 2 * FD, DM}; pg8::StaticOrder S; S.init(T, 2 * FD, G, bx);
                EpiSwiglu E{(bf16_t*)(w + WS_ACTF), FD, 22};
                pg8::gemm_phase<EpiSwiglu, pg8::StaticOrder>(lds, g, S, E);
                SEAM(pb + 7);
            }
            if (PHL(8)) {
                unsigned char* w = launder(ws); const float* modl = (const float*)(w + WS_MOD) + (size_t)l * 32 * 6144;
                pg8::Gemm g{(const bf16_t*)(w + WS_ACTF), (const bf16_t*)(w + WS_WF2), T, DM, FD}; pg8::StaticOrder S; S.init(T, DM, G, bx);
                EpiResid E{args.out, args.out, modl + 5 * 1024};
                pg8::gemm_phase<EpiResid, pg8::StaticOrder>(lds, g, S, E);
                SEAM(pb + 8);
            }
        } else {
            if (PHL(5)) { unsigned char* w = launder(ws); const float* modl = (const float*)(w + WS_MOD) + (size_t)l * 32 * 6144;
                norm_route_phase(args.out, args.in[I_GFFN] + l * DM, modl + 3 * 1024, modl + 4 * 1024, args.in[I_MR], (bf16_t*)(w + WS_HBM), (int*)(w + WS_TOK), (unsigned*)(w + WS_CTL) + CW_CNT, lds, vcu, G); SEAM(pb + 5); }
            if (PHL(6)) { unsigned char* w = launder(ws);
                moe_gather_phase((const bf16_t*)(w + WS_HBM), (bf16_t*)(w + WS_HS), (const int*)(w + WS_TOK), (int*)(w + WS_ROWINFO), (unsigned*)(w + WS_CTL) + CW_CNT, lds, vcu, G); SEAM(pb + 6); }
            for (int k = 0; k < 2; ++k) {
                if (PHM(7) && PH(pb + 7 + 2 * k)) {
                    unsigned char* w = launder(ws); unsigned* cnt = (unsigned*)(w + WS_CTL) + CW_CNT;
                    __syncthreads(); moe_prefix(cnt, k, tpl);
                    const int NT = tpl[8];
                    pg8::Gemm g{(const bf16_t*)(w + WS_HS) + (size_t)k * HSROWS * DM, (const bf16_t*)(w + WS_WM1), NT * 256, 2 * FE, DM};
                    pg8::MoeOrder S; S.init(NT * 256, 2 * FE, G, bx); S.tp = tpl; S.nNl = 28;
                    EpiSwiglu E{(bf16_t*)(w + WS_ACTM), FE, 28};
                    pg8::gemm_phase<EpiSwiglu, pg8::MoeOrder>(lds, g, S, E);
                    SEAM(pb + 7 + 2 * k);
                }
                if (PHM(8) && PH(pb + 8 + 2 * k)) {
                    unsigned char* w = launder(ws); unsigned* cnt = (unsigned*)(w + WS_CTL) + CW_CNT; const float* modl = (const float*)(w + WS_MOD) + (size_t)l * 32 * 6144;
                    __syncthreads(); moe_prefix(cnt, k, tpl);
                    const int NT = tpl[8];
                    pg8::Gemm g{(const bf16_t*)(w + WS_ACTM), (const bf16_t*)(w + WS_WM2), NT * 256, DM, FE};
                    pg8::MoeOrder S; S.init(NT * 256, DM, G, bx); S.tp = tpl; S.nNl = 4;
                    EpiMoeDown E{args.out, modl + 5 * 1024, (const int*)(w + WS_ROWINFO) + (size_t)k * HSROWS * 2};
                    pg8::gemm_phase<EpiMoeDown, pg8::MoeOrder>(lds, g, S, E);
                    SEAM(pb + 8 + 2 * k);
                }
            }
        }
    }
    if (((PHMASK >> 13) & 1u) && PH(25)) final_norm_phase(args.out, args.in[I_GFIN], vcu, G);
#undef PH
#undef SEAM
}

extern "C" void kernel_launch(void* const* d_in, const int* in_sizes, int n_in, void* d_out, int out_size, void* d_ws, size_t ws_size, hipStream_t stream) {
    static int grid = 0;
    if (grid == 0) {
        if (n_in != 23 || out_size != T * DM || ws_size < WS_END) { fprintf(stderr, "kernel_launch: unexpected shapes (n_in %d, out %d, ws %zu)\n", n_in, out_size, ws_size); grid = -1; return; }
        int dev = 0, cus = 0, per_cu = 0;
        if (hipGetDevice(&dev) != hipSuccess || hipDeviceGetAttribute(&cus, hipDeviceAttributeMultiprocessorCount, dev) != hipSuccess) { grid = -1; return; }
        if (hipFuncSetAttribute((const void*)fwd_kernel, hipFuncAttributeMaxDynamicSharedMemorySize, LDS_BYTES) != hipSuccess) { fprintf(stderr, "kernel_launch: hipFuncSetAttribute failed\n"); grid = -1; return; }
        if (hipOccupancyMaxActiveBlocksPerMultiprocessor(&per_cu, (const void*)fwd_kernel, NTHR, LDS_BYTES) != hipSuccess || per_cu < 1) fprintf(stderr, "kernel_launch: occupancy query reports %d\n", per_cu);
        (void)hipGetLastError();
        grid = cus;
    }
    if (grid < 0) return;
    (void)hipMemsetAsync((char*)d_ws + WS_CTL, 0, CTL_ZERO_BYTES, stream);
    Args a{};
    for (int i = 0; i < 23; ++i) a.in[i] = (const float*)d_in[i];
    a.out = (float*)d_out; a.ws = (unsigned char*)d_ws;
#if MK_PER_PHASE
    for (int p = 0; p < NPH; ++p) {
        if (p == 7 || p == 10 || p == 11 || p == 12 || p == 24) continue;
        a.ph_lo = p; a.ph_hi = p + 1;
        hipLaunchKernelGGL(fwd_kernel, dim3(grid), dim3(NTHR), LDS_BYTES, stream, a);
    }
#else
    a.ph_lo = 0; a.ph_hi = NPH;
    hipLaunchKernelGGL(fwd_kernel, dim3(grid), dim3(NTHR), LDS_BYTES, stream, a);
#endif
}
```

```cpp
#include <hip/hip_runtime.h>
#include <cstdio>
#include <cstdint>

#ifndef MK_PER_PHASE
#define MK_PER_PHASE 0
#endif
#ifndef EN_GMLP
#define EN_GMLP 1
#endif
#ifndef EN_HGRN
#define EN_HGRN 1
#endif
#ifndef EN_DSA
#define EN_DSA 1
#endif
#ifndef REP_HGRN
#define REP_HGRN 1
#endif
#ifndef REP_SEL
#define REP_SEL 1
#endif
#ifndef REP_GMLP
#define REP_GMLP 1
#endif
#ifndef REP_ATTN
#define REP_ATTN 1
#endif

#define GAS __attribute__((address_space(1)))
#define LAS __attribute__((address_space(3)))
typedef unsigned short bf16_t;
typedef short bf16x8 __attribute__((ext_vector_type(8)));
typedef float f32x4 __attribute__((ext_vector_type(4)));
typedef float f32x2 __attribute__((ext_vector_type(2)));
typedef float f32x16 __attribute__((ext_vector_type(16)));
typedef unsigned u32x4 __attribute__((ext_vector_type(4)));
typedef unsigned u32x2 __attribute__((ext_vector_type(2)));
typedef GAS unsigned gu32;
#define RLX_AGENT __ATOMIC_RELAXED, __HIP_MEMORY_SCOPE_AGENT

constexpr int T = 65536, DM = 1024, NB = 32, SEQ = 2048;
constexpr int NIN = 3072;
constexpr int INSRC = 2884;
constexpr int FD = 2816, FE = 3584, NE = 8;
constexpr int NWAVES = 8, NTHR = 512;
constexpr int HSROWS = T + 2048;
constexpr float EPS = 1e-6f;

constexpr size_t MiB = 1u << 20;
constexpr size_t WS_CTL = 0, CTL_ZERO_BYTES = 1 * MiB;
constexpr size_t WS_MOD = 1 * MiB;
constexpr size_t WS_CS = 3 * MiB;
constexpr size_t WS_LB = 5 * MiB;
constexpr size_t WS_GW = 5 * MiB + 512 * 1024;
constexpr size_t WS_TOK = 6 * MiB;
constexpr size_t WS_ROWINFO = 8 * MiB;
constexpr size_t WS_WIN = 16 * MiB;
constexpr size_t WS_WOUT = 28 * MiB;
constexpr size_t WS_WF1 = 32 * MiB;
constexpr size_t WS_WF2 = 43 * MiB;
constexpr size_t WS_WM1 = 49 * MiB;
constexpr size_t WS_WM2 = 161 * MiB;
constexpr size_t WS_ACT1 = 224 * MiB;
constexpr size_t WS_BIG = 352 * MiB;
constexpr size_t WS_QA = WS_BIG;
constexpr size_t WS_KA = WS_QA + 48 * MiB;
constexpr size_t WS_VAT = WS_KA + 8 * MiB;
constexpr size_t WS_IQ = WS_VAT + 8 * MiB;
constexpr size_t WS_IK = WS_IQ + 32 * MiB;
constexpr size_t WS_IW = WS_IK + 8 * MiB;
constexpr size_t WS_HQ = WS_IW + 1 * MiB;
constexpr size_t WS_HLF = WS_HQ + 48 * MiB;
constexpr size_t WS_HKK = WS_HLF + 96 * MiB;
constexpr size_t WS_HI = WS_HKK + 48 * MiB;
constexpr size_t WS_HG = WS_HI + 48 * MiB;
constexpr size_t WS_GU = WS_HG + 48 * MiB;
constexpr size_t WS_GV = WS_GU + 32 * MiB;
constexpr size_t WS_BM = WS_GV + 32 * MiB;
constexpr size_t WS_MIXEND = WS_BM + 16 * MiB;
constexpr size_t WS_ACTF = WS_BIG;
constexpr size_t WS_HS = 224 * MiB;
constexpr size_t WS_ACTM = 360 * MiB;
constexpr size_t WS_YM0 = 224 * MiB;
constexpr size_t WS_YM1 = 16 * MiB;
constexpr size_t WS_HBM = 592 * MiB;
constexpr size_t WS_XR = 860 * MiB;
constexpr size_t WS_END = 1024 * MiB;
static_assert(WS_MIXEND <= WS_END && WS_ACTF + (size_t)T * FD * 2 <= WS_END, "ws map");
static_assert(WS_HS + (size_t)2 * HSROWS * DM <= WS_ACTM && WS_ACTM + (size_t)2 * HSROWS * FE <= WS_XR && WS_YM0 + (size_t)HSROWS * DM * 2 <= WS_ACTM && WS_YM1 + (size_t)HSROWS * DM * 2 <= WS_WM2 && WS_MIXEND <= WS_XR && WS_XR + (size_t)T * DM * 2 <= WS_END && WS_HBM + (size_t)T * DM <= WS_ACTM + (size_t)2 * HSROWS * FE && HSROWS % 256 == 0, "ws map moe");
static_assert(WS_WM2 + (size_t)NE * DM * FE * 2 <= WS_ACT1, "ws map weights");

constexpr int CW_BAR = 4096;
constexpr int CW_Q = 8192;
constexpr int CW_CNT = 12288;
constexpr int CW_KMAX = 16384;
constexpr int CW_XRANK = 20480;

constexpr int LDS_BYTES = 163840;
constexpr int LDS_MISC = 163840 - 256;
constexpr int PH_SCRATCH = LDS_MISC;

__device__ __forceinline__ float bf2f(unsigned short b) { return __builtin_bit_cast(float, ((unsigned)b) << 16); }
typedef __bf16 bf16x2_t __attribute__((ext_vector_type(2)));
__device__ __forceinline__ unsigned f2bf(float f) { return (unsigned)__builtin_bit_cast(unsigned short, (__bf16)f); }
__device__ __forceinline__ unsigned pk2(float lo, float hi) { const f32x2 v = {lo, hi}; return __builtin_bit_cast(unsigned, __builtin_convertvector(v, bf16x2_t)); }
__device__ __forceinline__ unsigned pk4_fp8(float a, float b, float c, float d) { int w = __builtin_amdgcn_cvt_pk_fp8_f32(a, b, 0, false); w = __builtin_amdgcn_cvt_pk_fp8_f32(c, d, w, true); return (unsigned)w; }
__device__ __forceinline__ float dpp_add(float v, const int ctrl_b1_4e_141_140) {
    const int x = __builtin_bit_cast(int, v);
    switch (ctrl_b1_4e_141_140) {
        case 0: return v + __builtin_bit_cast(float, __builtin_amdgcn_update_dpp(x, x, 0xB1, 0xF, 0xF, false));
        case 1: return v + __builtin_bit_cast(float, __builtin_amdgcn_update_dpp(x, x, 0x4E, 0xF, 0xF, false));
        case 2: return v + __builtin_bit_cast(float, __builtin_amdgcn_update_dpp(x, x, 0x141, 0xF, 0xF, false));
        default: return v + __builtin_bit_cast(float, __builtin_amdgcn_update_dpp(x, x, 0x140, 0xF, 0xF, false));
    }
}
__device__ __forceinline__ float sum8(float v) { v = dpp_add(v, 0); v = dpp_add(v, 1); return dpp_add(v, 2); }
__device__ __forceinline__ float wave_sum(float v) {
    v = dpp_add(v, 0); v = dpp_add(v, 1); v = dpp_add(v, 2); v = dpp_add(v, 3);
    const int x = __builtin_bit_cast(int, v);
    const float r0 = __builtin_bit_cast(float, __builtin_amdgcn_readlane(x, 0)), r1 = __builtin_bit_cast(float, __builtin_amdgcn_readlane(x, 16)),
                r2 = __builtin_bit_cast(float, __builtin_amdgcn_readlane(x, 32)), r3 = __builtin_bit_cast(float, __builtin_amdgcn_readlane(x, 48));
    return (r0 + r1) + (r2 + r3);
}
__device__ __forceinline__ float fast_exp(float x) { return __builtin_amdgcn_exp2f(x * 1.44269504089f); }
__device__ __forceinline__ float fast_log(float x) { return __builtin_amdgcn_logf(x) * 0.69314718056f; }
__device__ __forceinline__ float sigmoidf(float x) { return __builtin_amdgcn_rcpf(1.f + fast_exp(-x)); }

__device__ __forceinline__ int opaque_tid0() { int t = threadIdx.x; asm volatile("" : "+v"(t)); return t; }
namespace pg8 {
constexpr int BM = 256, BK = 64, HALF = 128, HTB = HALF * BK * 2, STAGE_BYTES = 8 * HTB, NXCD = 8, WGM = 8;
__host__ __device__ __forceinline__ int lds_byte(int r, int c) { const int st = (r >> 4) * 2 + (c >> 5), rr = r & 15, cc = c & 31, ob = rr * 64 + cc * 2; return st * 1024 + (ob ^ (((ob >> 9) & 1) << 5)); }
__host__ __device__ __forceinline__ void stage_rc(int b, int& R, int& C) { const int st = b / 1024, sb = b % 1024, swz = sb ^ (((sb >> 9) & 1) << 5); R = (st >> 1) * 16 + swz / 64; C = (st & 1) * 32 + (swz % 64) / 2; }
__host__ __device__ __forceinline__ int perm32(int rho) { const int n = rho >> 4, i = rho & 15; return 8 * (i >> 2) + 4 * n + (i & 3); }
struct Unit { int pm, pn; };
struct Gemm { const unsigned char* base; unsigned offA, offB; int M, N, K; };
struct StaticOrder {
    int nM, nN, nwg, G, c, wgm;
    __device__ void init(int M, int N, int G_, int c_, int wgm_ = WGM) { nM = M / BM; nN = N / BM; nwg = nM * nN; G = G_; c = c_; wgm = wgm_; }
    __device__ bool next(int i, Unit& u) const {
        const long L = (long)i * G + c; if (L >= nwg) return false;
        int wgid = (int)L; { const int q = nwg / NXCD, r = nwg % NXCD, xcd = wgid % NXCD, off = wgid / NXCD; wgid = (xcd < r ? xcd * (q + 1) : r * (q + 1) + (xcd - r) * q) + off; }
        const int nig = wgm * nN, gid = wgid / nig, fm = gid * wgm, gsz = (nM - fm) < wgm ? (nM - fm) : wgm;
        u.pm = fm + ((wgid % nig) % gsz); u.pn = (wgid % nig) / gsz; return true;
    }
};
struct MoeOrder : StaticOrder {
    const LAS int* tp; int nNl, NT0;
    __device__ bool next(int i, Unit& u) const {
        if (!StaticOrder::next(i, u)) return false;
        const int k = (u.pm >= NT0) ? 1 : 0, ml = u.pm - k * NT0; int e = 0;
#pragma unroll
        for (int q = 1; q < 8; ++q) e += (ml >= tp[k * 9 + q]) ? 1 : 0;
        u.pm = __builtin_amdgcn_readfirstlane(k * (HSROWS / 256) + ml); u.pn += __builtin_amdgcn_readfirstlane(e) * nNl; return true;
    }
};

typedef int i32x4 __attribute__((ext_vector_type(4)));
typedef int i32x8 __attribute__((ext_vector_type(8)));
__device__ __forceinline__ i32x8 cat8(const bf16x8 a, const bf16x8 b) { return __builtin_shufflevector(__builtin_bit_cast(i32x4, a), __builtin_bit_cast(i32x4, b), 0, 1, 2, 3, 4, 5, 6, 7); }
template <class Epi, class Sched, bool FP8 = false, bool GA = false>
__device__ __forceinline__ void gemm_phase(LAS unsigned char* lds, const Gemm g, const Sched& S, const Epi& E, const int* ri = nullptr) {
    const int tid = opaque_tid0(), wid = __builtin_amdgcn_readfirstlane(tid >> 6), lane = tid & 63, wr = wid >> 2, wc = wid & 3, fr = lane & 15, fq = lane >> 4;
    const int RB = FP8 ? g.K : 2 * g.K, nt = RB / (2 * BK);
    unsigned voffA[2], voffB[2]; int gaR[2]; unsigned gaC[2];
#pragma unroll
    for (int i = 0; i < 2; ++i) { int R, C; stage_rc(tid * 16 + i * 8192, R, C); const int Rb = Epi::PERM ? ((R & ~31) + perm32(R & 31)) : R;
        voffA[i] = (unsigned)(R * RB + 2 * C); voffB[i] = (unsigned)(Rb * RB + 2 * C); gaR[i] = R; gaC[i] = (unsigned)(2 * C); }
    (void)gaR; (void)gaC;
    unsigned vA[2][2], vN[2][2];
#define PG8_RI_DMA(par, pm_) do { if (wid < 4) __builtin_amdgcn_global_load_lds((const unsigned*)(ri + 2 * ((size_t)(pm_) * 256 + 64 * wid + lane)), (LAS unsigned*)(lds + 131072 + (par) * 1024 + wid * 256), 4, 0, 0); } while (0)
#define PG8_RI_READ(dst, par) do { _Pragma("unroll") for (int _h = 0; _h < 2; ++_h) _Pragma("unroll") for (int _i = 0; _i < 2; ++_i) { \
        const int _t = *(const LAS int*)(lds + 131072 + (par) * 1024 + 4 * (128 * _h + gaR[_i])); dst[_h][_i] = (unsigned)(_t > 0 ? _t : 0) * (unsigned)RB + gaC[_i]; } } while (0)
#define PG8_STAGE_GA(bufoff, koff, vv, h) do { _Pragma("unroll") for (int _i = 0; _i < 2; ++_i) \
        __builtin_amdgcn_global_load_lds((const unsigned*)(g.base + (size_t)(unsigned)(g.offA + (koff) + (vv)[h][_i])), (LAS unsigned*)(lds + (bufoff) + ldsw + _i * 8192), 16, 0, 0); } while (0)
    const unsigned kstep = (unsigned)(BK * 2);
    const unsigned hstep = (unsigned)HALF * RB;
    const unsigned tstep = 2 * hstep;
    const unsigned ldsw = (unsigned)wid * 1024u;
    const int aoff = lds_byte(wr * 64 + fr, fq * 8), boff = lds_byte(wc * 32 + fr, fq * 8);
#define PG8_SA(b, h) (((b) * 2 + (h)) * HTB)
#define PG8_SB(b, h) ((4 + (b) * 2 + (h)) * HTB)
#define PG8_STAGE(bufoff, gbase, voff) do { _Pragma("unroll") for (int _i = 0; _i < 2; ++_i) \
        __builtin_amdgcn_global_load_lds((const unsigned*)(g.base + (size_t)(unsigned)((gbase) + (voff)[_i])), (LAS unsigned*)(lds + (bufoff) + ldsw + _i * 8192), 16, 0, 0); } while (0)
#define PG8_LDA(dst, b, h) do { _Pragma("unroll") for (int m = 0; m < 4; ++m) _Pragma("unroll") for (int k = 0; k < 2; ++k) dst[m][k] = *(const LAS bf16x8*)(lds + PG8_SA(b, h) + aoff + m * 2048 + k * 1024); } while (0)
#define PG8_LDB(dst, b, h) do { _Pragma("unroll") for (int n = 0; n < 2; ++n) _Pragma("unroll") for (int k = 0; k < 2; ++k) dst[n][k] = *(const LAS bf16x8*)(lds + PG8_SB(b, h) + boff + n * 2048 + k * 1024); } while (0)
#define PG8_MMA(ai, bj, At, Bt) do { __builtin_amdgcn_s_setprio(1); _Pragma("unroll") for (int m = 0; m < 4; ++m) _Pragma("unroll") for (int n = 0; n < 2; ++n) { \
        if constexpr (FP8) { asm volatile("v_mfma_scale_f32_16x16x128_f8f6f4 %0, %1, %2, %0, %3, %3 op_sel_hi:[0,0,0]" : "+v"(acc[ai][bj][m][n]) : "v"(cat8(Bt[n][0], Bt[n][1])), "v"(cat8(At[m][0], At[m][1])), "v"(fp8_scale)); } \
        else { _Pragma("unroll") for (int k = 0; k < 2; ++k) acc[ai][bj][m][n] = __builtin_amdgcn_mfma_f32_16x16x32_bf16(Bt[n][k], At[m][k], acc[ai][bj][m][n], 0, 0, 0); } } __builtin_amdgcn_s_setprio(0); } while (0)
#define PG8_WAIT_V(n) asm volatile("s_waitcnt vmcnt(" #n ")" ::: "memory")
#define PG8_WAIT_L(n) asm volatile("s_waitcnt lgkmcnt(" #n ")" ::: "memory")
#define PG8_BAR __builtin_amdgcn_s_barrier()
#define PG8_SCHED __builtin_amdgcn_sched_barrier(0)
    Unit cur, nxt; int ui = 0;
    if (!S.next(0, cur)) return;
    const int fp8_scale = 0x7d7d7d7d;
    (void)fp8_scale;
    f32x4 acc[2][2][4][2];
#pragma unroll
    for (int a = 0; a < 2; ++a)
#pragma unroll
        for (int b = 0; b < 2; ++b)
#pragma unroll
            for (int m = 0; m < 4; ++m)
#pragma unroll
                for (int n = 0; n < 2; ++n) acc[a][b][m][n] = (f32x4){0.f, 0.f, 0.f, 0.f};
    bf16x8 At[4][2], B0[2][2], B1[2][2];
    unsigned cA = g.offA + (unsigned)cur.pm * tstep, cB = g.offB + (unsigned)cur.pn * tstep;
    if constexpr (GA) { PG8_RI_DMA(0, cur.pm); asm volatile("s_waitcnt vmcnt(0)" ::: "memory"); PG8_BAR; PG8_RI_READ(vA, 0); asm volatile("s_waitcnt lgkmcnt(0)" ::: "memory"); }
    PG8_STAGE(PG8_SB(0, 0), cB, voffB); PG8_STAGE(PG8_SB(0, 1), cB + hstep, voffB);
    if constexpr (GA) { PG8_STAGE_GA(PG8_SA(0, 0), 0u, vA, 0); PG8_STAGE_GA(PG8_SA(0, 1), 0u, vA, 1); } else { PG8_STAGE(PG8_SA(0, 0), cA, voffA); PG8_STAGE(PG8_SA(0, 1), cA + hstep, voffA); }
    if (wr == 1) PG8_BAR;
    PG8_WAIT_V(2); PG8_BAR;
    PG8_STAGE(PG8_SB(1, 0), cB + kstep, voffB);
    if constexpr (GA) PG8_STAGE_GA(PG8_SA(1, 0), kstep, vA, 0); else PG8_STAGE(PG8_SA(1, 0), cA + kstep, voffA);
    PG8_STAGE(PG8_SB(1, 1), cB + hstep + kstep, voffB);
    PG8_WAIT_V(6); PG8_BAR;
    for (;;) {
        const bool has_next = S.next(ui + 1, nxt);
        const unsigned nA = has_next ? g.offA + (unsigned)nxt.pm * tstep : cA, nB = has_next ? g.offB + (unsigned)nxt.pn * tstep : cB;
        if constexpr (GA) { if (has_next) PG8_RI_DMA((ui + 1) & 1, nxt.pm); }
#pragma unroll 1
        for (int t = 0; t < nt; t += 2) {
            const bool last = (t == nt - 2);
            const unsigned a1 = cA + (unsigned)(t + 1) * kstep;
            const unsigned a2 = last ? nA : cA + (unsigned)(t + 2) * kstep, b2 = last ? nB : cB + (unsigned)(t + 2) * kstep;
            const unsigned a3 = a2 + kstep, b3 = b2 + kstep;
            unsigned k2 = (unsigned)(t + 2) * kstep;
            if constexpr (GA) { if (last) { k2 = 0u; if (has_next) PG8_RI_READ(vN, (ui + 1) & 1); else { _Pragma("unroll") for (int _h = 0; _h < 2; ++_h) _Pragma("unroll") for (int _i = 0; _i < 2; ++_i) vN[_h][_i] = vA[_h][_i]; } }
                                else { _Pragma("unroll") for (int _h = 0; _h < 2; ++_h) _Pragma("unroll") for (int _i = 0; _i < 2; ++_i) vN[_h][_i] = vA[_h][_i]; } }
            PG8_LDB(B0, 0, 0); PG8_LDB(B1, 0, 1); PG8_SCHED; PG8_LDA(At, 0, 0);
            if constexpr (GA) PG8_STAGE_GA(PG8_SA(1, 1), (unsigned)(t + 1) * kstep, vA, 1); else PG8_STAGE(PG8_SA(1, 1), a1 + hstep, voffA);
            PG8_WAIT_V(8); PG8_WAIT_L(0); PG8_BAR; PG8_MMA(0, 0, At, B0); PG8_MMA(0, 1, At, B1); PG8_BAR; PG8_SCHED;
            PG8_LDA(At, 0, 1); PG8_STAGE(PG8_SB(0, 0), b2, voffB); PG8_STAGE(PG8_SB(0, 1), b2 + hstep, voffB);
            if constexpr (GA) PG8_STAGE_GA(PG8_SA(0, 0), k2, vN, 0); else PG8_STAGE(PG8_SA(0, 0), a2, voffA);
            PG8_WAIT_V(8); PG8_WAIT_L(0); PG8_BAR; PG8_MMA(1, 0, At, B0); PG8_MMA(1, 1, At, B1); PG8_BAR; PG8_SCHED;
            PG8_LDB(B0, 1, 0); PG8_LDB(B1, 1, 1); PG8_SCHED; PG8_LDA(At, 1, 0);
            if constexpr (GA) PG8_STAGE_GA(PG8_SA(0, 1), k2, vN, 1); else PG8_STAGE(PG8_SA(0, 1), a2 + hstep, voffA);
            PG8_WAIT_V(8); PG8_WAIT_L(0); PG8_BAR; PG8_MMA(0, 0, At, B0); PG8_MMA(0, 1, At, B1); PG8_BAR; PG8_SCHED;
            PG8_LDA(At, 1, 1); PG8_STAGE(PG8_SB(1, 0), b3, voffB); PG8_STAGE(PG8_SB(1, 1), b3 + hstep, voffB);
            if constexpr (GA) PG8_STAGE_GA(PG8_SA(1, 0), k2 + kstep, vN, 0); else PG8_STAGE(PG8_SA(1, 0), a3, voffA);
            PG8_WAIT_V(8); PG8_WAIT_L(0); PG8_BAR; PG8_MMA(1, 0, At, B0); PG8_MMA(1, 1, At, B1); PG8_BAR; PG8_SCHED;
        }
        if constexpr (GA) { _Pragma("unroll") for (int _h = 0; _h < 2; ++_h) _Pragma("unroll") for (int _i = 0; _i < 2; ++_i) vA[_h][_i] = vN[_h][_i]; }
        if (wr == 0) PG8_BAR;
        if constexpr (FP8) asm volatile("s_nop 15\n\ts_nop 15\n\ts_nop 15" ::: "memory");
        E(acc, cur, wr, wc, fr, fq);
        if (!has_next) break;
#pragma unroll
        for (int a = 0; a < 2; ++a)
#pragma unroll
            for (int b = 0; b < 2; ++b)
#pragma unroll
                for (int m = 0; m < 4; ++m)
#pragma unroll
                    for (int n = 0; n < 2; ++n) acc[a][b][m][n] = (f32x4){0.f, 0.f, 0.f, 0.f};
        cur = nxt; cA = nA; cB = nB; ++ui;
        if (wr == 1) PG8_BAR;
    }
    PG8_WAIT_V(0);
    PG8_BAR;
#undef PG8_SA
#undef PG8_SB
#undef PG8_STAGE
#undef PG8_STAGE_GA
#undef PG8_RI_DMA
#undef PG8_RI_READ
#undef PG8_LDA
#undef PG8_LDB
#undef PG8_MMA
#undef PG8_WAIT_V
#undef PG8_WAIT_L
#undef PG8_BAR
#undef PG8_SCHED
}
}

typedef f32x4 AccT[2][2][4][2];

__device__ __forceinline__ f32x2 gelu_pk(f32x2 v) {
    const f32x2 av = __builtin_elementwise_abs(v), d = av * 0.2316418882f + 1.0f;
    f32x2 t; t.x = __builtin_amdgcn_rcpf(d.x); t.y = __builtin_amdgcn_rcpf(d.y);
    f32x2 q = t * 0.5307027145f + (-0.7265760135f); q = q * t + 0.7107068705f; q = q * t + (-0.142248368f); q = q * t + 0.127414796f; q = q * t;
    const f32x2 s = (v * v) * (-0.72134752044f);
    f32x2 e; e.x = __builtin_amdgcn_exp2f(s.x); e.y = __builtin_amdgcn_exp2f(s.y);
    const f32x2 m = v * (q * e), r = v - m;
    f32x2 o; o.x = v.x < 0.f ? m.x : r.x; o.y = v.y < 0.f ? m.y : r.y; return o;
}
__device__ __forceinline__ float gelu1(float x) { f32x2 r = gelu_pk((f32x2){x, x}); return r.x; }
__device__ __forceinline__ u32x4 pack8(const f32x4 a, const f32x4 b) { u32x4 w; w.x = pk2(a[0], a[1]); w.y = pk2(a[2], a[3]); w.z = pk2(b[0], b[1]); w.w = pk2(b[2], b[3]); return w; }

constexpr float SWI_GATE = -1.44269504089f, SWI_UP = -0.69314718056f;
constexpr float QSCALE = 0.125f * 1.44269504089f;

struct EpiInproj {
    static constexpr bool PERM = true;
    bf16_t *QA, *KA, *VAT, *IQ, *IK; float* IW; bf16_t *HQ, *HKK, *HI, *HG; float* HLF; bf16_t *GU, *GV;
    const float* CS; const int* pos; const float* lb; unsigned* kmax; bool has_lb;
    __device__ __forceinline__ void operator()(const AccT& acc, const pg8::Unit& u, int wr, int wc, int fr, int fq) const {
        const int row0 = u.pm * 256 + wr * 64 + fr, pn = u.pn;
        if (pn < 4) {
            float kmx = 0.f;
            const bool plain_v = (pn == 1 && wc == 3), iw_pad = (pn == 3 && wc >= 1);
#pragma unroll
            for (int ai = 0; ai < 2; ++ai) {
                asm volatile("" ::: "memory"); __builtin_amdgcn_sched_barrier(0);
                if (plain_v) {
#pragma unroll
                    for (int m = 0; m < 4; ++m) { const int row = row0 + ai * 128 + m * 16;
                        const f32x4 x1a = acc[ai][0][m][0], x1b = acc[ai][0][m][1], x2a = acc[ai][1][m][0], x2b = acc[ai][1][m][1];
                        const int b = row >> 11, s = row & 2047; bf16_t* vp = VAT + ((size_t)b * 64) * 2048 + s;
#pragma unroll
                        for (int j = 0; j < 4; ++j) { vp[(size_t)(8 * fq + j) * 2048] = (bf16_t)f2bf(x1a[j]); vp[(size_t)(8 * fq + 4 + j) * 2048] = (bf16_t)f2bf(x1b[j]);
                            vp[(size_t)(32 + 8 * fq + j) * 2048] = (bf16_t)f2bf(x2a[j]); vp[(size_t)(32 + 8 * fq + 4 + j) * 2048] = (bf16_t)f2bf(x2b[j]); } }
                } else if (iw_pad) {
                    if (wc == 1 && fq == 0) {
#pragma unroll
                        for (int m = 0; m < 4; ++m) *(f32x4*)(IW + (size_t)(row0 + ai * 128 + m * 16) * 4) = acc[ai][0][m][0]; }
                } else {
#pragma unroll
                    for (int mh = 0; mh < 2; ++mh) {
                    if (mh) { asm volatile("" ::: "memory"); __builtin_amdgcn_sched_barrier(0); }
                    int pp[2]; f32x4 cs4[2][4];
#pragma unroll
                    for (int m2 = 0; m2 < 2; ++m2) pp[m2] = pos[row0 + ai * 128 + (2 * mh + m2) * 16];
#pragma unroll
                    for (int m2 = 0; m2 < 2; ++m2) { const float* cs = CS + (size_t)pp[m2] * 64 + 8 * fq; cs4[m2][0] = *(const f32x4*)cs; cs4[m2][1] = *(const f32x4*)(cs + 4); cs4[m2][2] = *(const f32x4*)(cs + 32); cs4[m2][3] = *(const f32x4*)(cs + 36); }
#pragma unroll
                    for (int m2 = 0; m2 < 2; ++m2) {
                        const int m = 2 * mh + m2;
                        const int row = row0 + ai * 128 + m * 16;
                        const f32x4 x1a = acc[ai][0][m][0], x1b = acc[ai][0][m][1], x2a = acc[ai][1][m][0], x2b = acc[ai][1][m][1];
                        const f32x4 ca = cs4[m2][0], cb = cs4[m2][1], sa = cs4[m2][2], sb = cs4[m2][3];
                        f32x4 o1a = x1a * ca - x2a * sa, o1b = x1b * cb - x2b * sb, o2a = x2a * ca + x1a * sa, o2b = x2b * cb + x1b * sb;
                        bf16_t* dst;
                        if (pn == 0) { dst = QA + ((size_t)row * 6 + wc) * 64; o1a *= QSCALE; o1b *= QSCALE; o2a *= QSCALE; o2b *= QSCALE; }
                        else if (pn == 1) { if (wc < 2) { dst = QA + ((size_t)row * 6 + 4 + wc) * 64; o1a *= QSCALE; o1b *= QSCALE; o2a *= QSCALE; o2b *= QSCALE; }
                            else { dst = KA + (size_t)row * 64;
                                float ss = 0.f;
#pragma unroll
                                for (int j = 0; j < 4; ++j) ss += o1a[j] * o1a[j] + o1b[j] * o1b[j] + o2a[j] * o2a[j] + o2b[j] * o2b[j];
                                ss += __shfl_xor(ss, 16); ss += __shfl_xor(ss, 32); kmx = fmaxf(kmx, ss); } }
                        else if (pn == 2) dst = IQ + ((size_t)row * 4 + wc) * 64;
                        else dst = IK + (size_t)row * 64;
                        *(u32x4*)(dst + 8 * fq) = pack8(o1a, o1b);
                        *(u32x4*)(dst + 32 + 8 * fq) = pack8(o2a, o2b);
                    }
                    }
                }
            }
            if (pn == 1 && wc == 2) {
#pragma unroll
                for (int o = 1; o < 16; o <<= 1) kmx = fmaxf(kmx, __shfl_xor(kmx, o));
                if ((threadIdx.x & 63) == 0) atomicMax(kmax + (row0 >> 11), __builtin_bit_cast(unsigned, kmx));
            }
        } else if (pn < 10) {
            const int h = pn - 4; const int dq = 32 * (wc & 1) + 8 * fq;
            f32x4 lba, lbb;
            if (wc >= 2) { lba = *(const f32x4*)(lb + h * 64 + dq); lbb = *(const f32x4*)(lb + h * 64 + dq + 4); }
#pragma unroll
            for (int ai = 0; ai < 2; ++ai)
#pragma unroll
                for (int m = 0; m < 4; ++m) {
                    asm volatile("" ::: "memory"); __builtin_amdgcn_sched_barrier(0);
                    const int row = row0 + ai * 128 + m * 16; const size_t o = ((size_t)row * 6 + h) * 64 + dq;
                    if (wc < 2) {
                        *(u32x4*)(HQ + o) = pack8(acc[ai][0][m][0], acc[ai][0][m][1]);
                        *(u32x4*)(HI + o) = pack8(acc[ai][1][m][0], acc[ai][1][m][1]);
                    } else {
                        f32x4 lf[2], kk[2], sg[2];
#pragma unroll
                        for (int n = 0; n < 2; ++n)
#pragma unroll
                            for (int j = 0; j < 4; ++j) {
                                const float z = acc[ai][0][m][n][j], lbv = n ? lbb[j] : lba[j];
                                const float ls = fminf(z, 0.f) - fast_log(1.f + fast_exp(-fabsf(z)));
                                lf[n][j] = ls; if (has_lb) lf[n][j] = (lbv > 0.f) ? fast_log(lbv + (1.f - lbv) * fast_exp(ls)) : ls;
                                kk[n][j] = (1.f - lbv) * fast_exp(ls - z);
                                const float gg = acc[ai][1][m][n][j]; sg[n][j] = gg * sigmoidf(gg);
                            }
                        *(f32x4*)(HLF + o) = lf[0]; *(f32x4*)(HLF + o + 4) = lf[1];
                        *(u32x4*)(HKK + o) = pack8(kk[0], kk[1]);
                        *(u32x4*)(HG + o) = pack8(sg[0], sg[1]);
                    }
                }
        } else {
            bf16_t* dstb = (pn == 10) ? GU : GV;
#pragma unroll
            for (int ai = 0; ai < 2; ++ai)
#pragma unroll
                for (int m = 0; m < 4; ++m) {
                    asm volatile("" ::: "memory"); __builtin_amdgcn_sched_barrier(0);
                    const int row = row0 + ai * 128 + m * 16;
#pragma unroll
                    for (int bj = 0; bj < 2; ++bj) {
                        const f32x4 v0 = acc[ai][bj][m][0], v1 = acc[ai][bj][m][1];
                        const f32x2 a = gelu_pk((f32x2){v0[0], v0[1]}), b = gelu_pk((f32x2){v0[2], v0[3]}), c = gelu_pk((f32x2){v1[0], v1[1]}), d = gelu_pk((f32x2){v1[2], v1[3]});
                        u32x4 w; w.x = pk2(a.x, a.y); w.y = pk2(b.x, b.y); w.z = pk2(c.x, c.y); w.w = pk2(d.x, d.y);
                        *(u32x4*)(dstb + (size_t)row * 256 + bj * 128 + wc * 32 + 8 * fq) = w;
                    }
                }
        }
    }
};

__device__ __forceinline__ void unpack8(const u32x4 w, f32x4& a, f32x4& b) {
    a[0] = __builtin_bit_cast(float, w[0] << 16); a[1] = __builtin_bit_cast(float, w[0] & 0xffff0000u); a[2] = __builtin_bit_cast(float, w[1] << 16); a[3] = __builtin_bit_cast(float, w[1] & 0xffff0000u);
    b[0] = __builtin_bit_cast(float, w[2] << 16); b[1] = __builtin_bit_cast(float, w[2] & 0xffff0000u); b[2] = __builtin_bit_cast(float, w[3] << 16); b[3] = __builtin_bit_cast(float, w[3] & 0xffff0000u);
}
template <bool XF32>
struct EpiResid {
    static constexpr bool PERM = true;
    const float* xin32; bf16_t* xr; const float* gate;
    __device__ __forceinline__ void operator()(const AccT& acc, const pg8::Unit& u, int wr, int wc, int fr, int fq) const {
        const int row0 = u.pm * 256 + wr * 64 + fr, col0 = u.pn * 256 + wc * 32 + 8 * fq;
        const float* gp = gate + (size_t)(row0 >> 11) * 6144 + col0;
        f32x4 gv[2][2];
#pragma unroll
        for (int bj = 0; bj < 2; ++bj)
#pragma unroll
            for (int n = 0; n < 2; ++n) gv[bj][n] = *(const f32x4*)(gp + bj * 128 + 4 * n);
#pragma unroll
        for (int ai = 0; ai < 2; ++ai) {
            if constexpr (XF32) {
                asm volatile("" ::: "memory"); __builtin_amdgcn_sched_barrier(0);
                f32x4 xv[4][2][2];
#pragma unroll
                for (int m = 0; m < 4; ++m) { const size_t o = (size_t)(row0 + ai * 128 + m * 16) * DM + col0;
#pragma unroll
                    for (int bj = 0; bj < 2; ++bj)
#pragma unroll
                        for (int n = 0; n < 2; ++n) xv[m][bj][n] = *(const f32x4*)(xin32 + o + bj * 128 + 4 * n); }
#pragma unroll
                for (int m = 0; m < 4; ++m) { const size_t o = (size_t)(row0 + ai * 128 + m * 16) * DM + col0;
#pragma unroll
                    for (int bj = 0; bj < 2; ++bj) *(u32x4*)(xr + o + bj * 128) = pack8(xv[m][bj][0] + gv[bj][0] * acc[ai][bj][m][0], xv[m][bj][1] + gv[bj][1] * acc[ai][bj][m][1]); }
            } else {
                asm volatile("" ::: "memory"); __builtin_amdgcn_sched_barrier(0);
                u32x4 raw[4][2];
#pragma unroll
                for (int m = 0; m < 4; ++m) { const size_t o = (size_t)(row0 + ai * 128 + m * 16) * DM + col0;
#pragma unroll
                    for (int bj = 0; bj < 2; ++bj) raw[m][bj] = *(const u32x4*)(xr + o + bj * 128); }
#pragma unroll
                for (int m = 0; m < 4; ++m) { const size_t o = (size_t)(row0 + ai * 128 + m * 16) * DM + col0;
#pragma unroll
                    for (int bj = 0; bj < 2; ++bj) { f32x4 xa, xb; unpack8(raw[m][bj], xa, xb); *(u32x4*)(xr + o + bj * 128) = pack8(xa + gv[bj][0] * acc[ai][bj][m][0], xb + gv[bj][1] * acc[ai][bj][m][1]); } }
            }
        }
    }
};

struct EpiSwiglu {
    static constexpr bool PERM = true;
    unsigned char* O; int ldo; int nNl;
    __device__ __forceinline__ void operator()(const AccT& acc, const pg8::Unit& u, int wr, int wc, int fr, int fq) const {
        const int row0 = u.pm * 256 + wr * 64 + fr, pnl = u.pn % nNl, col0 = pnl * 128 + wc * 32 + 8 * fq;
#pragma unroll
        for (int ai = 0; ai < 2; ++ai)
#pragma unroll
            for (int m = 0; m < 4; ++m) {
                asm volatile("" ::: "memory"); __builtin_amdgcn_sched_barrier(0);
                f32x4 r[2];
#pragma unroll
                for (int n = 0; n < 2; ++n)
#pragma unroll
                    for (int j = 0; j < 4; ++j) { const float g = acc[ai][0][m][n][j]; r[n][j] = g * acc[ai][1][m][n][j] * __builtin_amdgcn_rcpf(1.f + __builtin_amdgcn_exp2f(g)); }
                u32x2 w; w[0] = pk4_fp8(r[0][0], r[0][1], r[0][2], r[0][3]); w[1] = pk4_fp8(r[1][0], r[1][1], r[1][2], r[1][3]);
                *(u32x2*)(O + (size_t)(row0 + ai * 128 + m * 16) * ldo + col0) = w;
            }
    }
};

struct EpiMoeDown {
    static constexpr bool PERM = true;
    bf16_t* Y0; bf16_t* Y1;
    __device__ __forceinline__ void operator()(const AccT& acc, const pg8::Unit& u, int wr, int wc, int fr, int fq) const {
        const int k = (u.pm >= HSROWS / 256) ? 1 : 0;
        const int row0 = (u.pm - k * (HSROWS / 256)) * 256 + wr * 64 + fr, col0 = (u.pn & 3) * 256 + wc * 32 + 8 * fq;
        bf16_t* Y = k ? Y1 : Y0;
#pragma unroll
        for (int ai = 0; ai < 2; ++ai)
#pragma unroll
            for (int m = 0; m < 4; ++m) { bf16_t* op = Y + (size_t)(row0 + ai * 128 + m * 16) * DM + col0;
#pragma unroll
                for (int bj = 0; bj < 2; ++bj) *(u32x4*)(op + bj * 128) = pack8(acc[ai][bj][m][0], acc[ai][bj][m][1]); }
    }
};

#define XB_TMO      128
#define XB_XCNT(j)  (256  + 64 * (j))
#define XB_XSUB(j)  (1280 + 64 * (j))
#define XB_XGEN(j)  (2304 + 64 * (j))
#define XB_TOP      3328
#define XB_TOPGEN   3392
#define XCD_BAR_WORDS 3456
#define XB_SPIN_CAP (1u << 18)
__device__ __forceinline__ unsigned xb_ld(unsigned* p)              { return __hip_atomic_load(p, __ATOMIC_RELAXED, __HIP_MEMORY_SCOPE_AGENT); }
__device__ __forceinline__ unsigned xb_add(unsigned* p, unsigned v) { return __hip_atomic_fetch_add(p, v, __ATOMIC_RELAXED, __HIP_MEMORY_SCOPE_AGENT); }
__device__ __forceinline__ unsigned xb_xcc_id() { return (unsigned)__builtin_amdgcn_s_getreg((3 << 11) | 20) & 0xFu; }
#define XB_SPIN(cond, bar) do { unsigned _sp = 0; while (cond) { __builtin_amdgcn_s_sleep(1); \
    if ((++_sp & 255u) == 0u) { if (xb_ld(&(bar)[XB_TMO])) break; if (_sp > XB_SPIN_CAP) { atomicAdd(&(bar)[XB_TMO], 1u); break; } } } } while (0)
struct XcdBarrier { unsigned* bar; unsigned x; volatile LAS unsigned* st; };
__device__ __forceinline__ XcdBarrier xcd_barrier_post(unsigned* bar, volatile LAS unsigned* st) {
    XcdBarrier b; b.bar = bar; b.x = xb_xcc_id(); b.st = st;
    if (threadIdx.x == 0) (void)xb_add(&bar[XB_XCNT(b.x)], 1u);
    return b;
}
__device__ __forceinline__ void xcd_barrier_complete(unsigned* bar, unsigned x, unsigned& nloc, unsigned& nx) {
    const unsigned G = gridDim.x * gridDim.y * gridDim.z;
    unsigned sum, cnt, mine, sp = 0u;
    for (;;) {
        sum = 0u; cnt = 0u; mine = 0u;
#pragma unroll
        for (unsigned j = 0; j < 16; ++j) { const unsigned c = xb_ld(&bar[XB_XCNT(j)]); sum += c; cnt += (c > 0u) ? 1u : 0u; mine = (j == x) ? c : mine; }
        if (sum == G) break;
        __builtin_amdgcn_s_sleep(1);
        if ((++sp & 255u) == 0u) { if (xb_ld(&bar[XB_TMO])) break; if (sp > XB_SPIN_CAP) { atomicAdd(&bar[XB_TMO], 1u); break; } }
    }
    nloc = mine > 0u ? mine : 1u; nx = cnt > 0u ? cnt : 1u;
}
__device__ __forceinline__ void xcd_barrier(const XcdBarrier& b) {
    asm volatile("s_waitcnt vmcnt(0)" ::: "memory");
    __syncthreads();
    if (threadIdx.x == 0) {
        unsigned* bar = b.bar;
        __builtin_amdgcn_s_waitcnt(0);
        unsigned nloc = b.st[0], nx = b.st[1];
        if (nloc == 0u) { xcd_barrier_complete(bar, b.x, nloc, nx); b.st[0] = nloc; b.st[1] = nx; }
        const unsigned old = xb_add(&bar[XB_XSUB(b.x)], 1u);
        const unsigned gen = old / nloc;
        if (old + 1u == (gen + 1u) * nloc) {
            __builtin_amdgcn_fence(__ATOMIC_RELEASE, "agent");
            asm volatile("s_waitcnt vmcnt(0)" ::: "memory");
            const unsigned og = xb_add(&bar[XB_TOP], 1u);
            const unsigned tg = og / nx;
            if (og + 1u == (tg + 1u) * nx) xb_add(&bar[XB_TOPGEN], 1u);
            else XB_SPIN(xb_ld(&bar[XB_TOPGEN]) == tg, bar);
            __builtin_amdgcn_fence(__ATOMIC_ACQUIRE, "agent");
            xb_add(&bar[XB_XGEN(b.x)], 1u);
            asm volatile("s_waitcnt vmcnt(0)" ::: "memory");
        } else {
            XB_SPIN(xb_ld(&bar[XB_XGEN(b.x)]) == gen, bar);
            __builtin_amdgcn_fence(__ATOMIC_ACQUIRE, "agent");
            asm volatile("s_waitcnt vmcnt(0)" ::: "memory");
        }
    }
    __syncthreads();
}

struct Args { const float* in[23]; float* out; unsigned char* ws; int ph_lo, ph_hi; };
typedef const __attribute__((address_space(4))) Args* KArgs;
__device__ __forceinline__ KArgs kargs() { auto p = __builtin_amdgcn_kernarg_segment_ptr(); asm volatile("" : "+s"(p)); return (KArgs)p; }
__device__ __forceinline__ unsigned char* launder(unsigned char* p) { GAS unsigned char* g = (GAS unsigned char*)p; asm volatile("" : "+s"(g)); return (unsigned char*)g; }
#define GIN(p) ((const float*)(const GAS float*)(p))
enum { I_X = 0, I_C, I_POS, I_WADA, I_BADA, I_GMIX, I_GFFN, I_WIN, I_WOUT, I_LBL, I_ONORM, I_VNG, I_VNB, I_GWS, I_GBS, I_FG, I_FU, I_FD, I_MR, I_MG, I_MU, I_MD, I_GFIN };

__device__ __forceinline__ int opaque_tid() { int t = threadIdx.x; asm volatile("" : "+v"(t)); return t; }
__device__ __forceinline__ int q_next(unsigned* ctr, volatile LAS int* slot) {
    __syncthreads();
    if (threadIdx.x == 0) *slot = (int)__hip_atomic_fetch_add(ctr, 1u, RLX_AGENT);
    __syncthreads();
    return *slot;
}

__device__ __forceinline__ int q_next_xcd(unsigned* ctr8, unsigned per, unsigned x, volatile LAS int* slot) {
    __syncthreads();
    if (threadIdx.x == 0) { int r = -1;
        for (unsigned k = 0; k < 8u; ++k) { const unsigned xx = (x + k) & 7u; const unsigned i = __hip_atomic_fetch_add(ctr8 + 64 * xx, 1u, RLX_AGENT); if (i < per) { r = (int)(xx * per + i); break; } }
        *slot = r; }
    __syncthreads();
    return *slot;
}

template <bool FP8, class F>
__device__ __forceinline__ void p0_transpose_item(const float* W, int K, int Nsrc, void* WTv, LAS float* scr, int kb, int nb, int lane, F srccol, float ws16 = 16.f) {
    const int k0 = 64 * kb, n0 = 64 * nb; const int sc = srccol(n0 + lane);
    {
        float wv[64]; const float* wp = W + (size_t)k0 * Nsrc + (sc >= 0 ? sc : 0);
#pragma unroll
        for (int kk = 0; kk < 64; ++kk) wv[kk] = wp[(size_t)kk * Nsrc];
#pragma unroll
        for (int kk = 0; kk < 64; ++kk) scr[kk * 65 + lane] = (sc >= 0) ? wv[kk] : 0.f;
    }
    asm volatile("s_waitcnt lgkmcnt(0)" ::: "memory");
    const int c = lane & 7;
#pragma unroll
    for (int j = 0; j < 8; ++j) { const int n = (lane >> 3) + 8 * j; const LAS float* s = scr + (8 * c) * 65 + n;
        if constexpr (FP8) { u32x2 o; o[0] = pk4_fp8(ws16 * s[0 * 65], ws16 * s[1 * 65], ws16 * s[2 * 65], ws16 * s[3 * 65]); o[1] = pk4_fp8(ws16 * s[4 * 65], ws16 * s[5 * 65], ws16 * s[6 * 65], ws16 * s[7 * 65]);
            *(u32x2*)((unsigned char*)WTv + (size_t)(n0 + n) * K + k0 + 8 * c) = o; }
        else { u32x4 o; o.x = pk2(s[0 * 65], s[1 * 65]); o.y = pk2(s[2 * 65], s[3 * 65]); o.z = pk2(s[4 * 65], s[5 * 65]); o.w = pk2(s[6 * 65], s[7 * 65]);
            *(u32x4*)((bf16_t*)WTv + (size_t)(n0 + n) * K + k0 + 8 * c) = o; } }
    asm volatile("s_waitcnt lgkmcnt(0)" ::: "memory");
}
__device__ __forceinline__ void p0_wg_item(const float* sp, int Nsrc, unsigned char* drow, size_t pitch, float scale, LAS unsigned char* buf, int lane, int wave) {
    f32x4 v[16];
#pragma unroll
    for (int kk = 0; kk < 16; ++kk) v[kk] = *(const f32x4*)(sp + (size_t)kk * Nsrc);
#pragma unroll
    for (int e = 0; e < 4; ++e) { u32x4 o;
#pragma unroll
        for (int w = 0; w < 4; ++w) o[w] = pk4_fp8(scale * v[4 * w][e], scale * v[4 * w + 1][e], scale * v[4 * w + 2][e], scale * v[4 * w + 3][e]);
        *(LAS u32x4*)(buf + (64 * e + lane) * 144 + 16 * wave) = o; }
    __syncthreads();
    const int j = lane & 7, rr = lane >> 3;
#pragma unroll
    for (int i = 0; i < 4; ++i) { const int p = 32 * wave + 8 * i + rr; const u32x4 o = *(const LAS u32x4*)(buf + p * 144 + 16 * j);
        *(u32x4*)(drow + (size_t)(4 * (p & 63) + (p >> 6)) * pitch + 16 * j) = o; }
}
__device__ __forceinline__ int inproj_srccol(int n) {
    const int t = n >> 8, c = n & 255;
    if (t < 4) { const int half = c >> 7, hh = (c >> 5) & 3, dd = c & 31; const int s = 256 * t + 64 * hh + 32 * half + dd; return (t == 3 && s >= 836) ? -1 : s; }
    if (t < 10) { const int seg = c >> 6, dd = c & 63; return 836 + 384 * seg + 64 * (t - 4) + dd; }
    return 2372 + 256 * (t - 10) + c;
}
__constant__ float ROPE_INV[32] = {1.000000000e+00f, 7.498942018e-01f, 5.623413324e-01f, 4.216965139e-01f, 3.162277639e-01f, 2.371373773e-01f, 1.778279394e-01f, 1.333521456e-01f, 1.000000015e-01f, 7.498942316e-02f, 5.623413250e-02f, 4.216964915e-02f, 3.162277490e-02f, 2.371373773e-02f, 1.778279431e-02f, 1.333521400e-02f, 9.999999776e-03f, 7.498942316e-03f, 5.623413250e-03f, 4.216964822e-03f, 3.162277630e-03f, 2.371373819e-03f, 1.778279431e-03f, 1.333521446e-03f, 1.000000047e-03f, 7.498941850e-04f, 5.623413017e-04f, 4.216965172e-04f, 3.162277571e-04f, 2.371373703e-04f, 1.778279402e-04f, 1.333521504e-04f};

__device__ __forceinline__ void p0_prologue(KArgs Ap, LAS unsigned char* lds, int vcu, int G) {
#define A (*Ap)
    const int tid = opaque_tid0(), lane = tid & 63, wave = __builtin_amdgcn_readfirstlane(tid >> 6);
    unsigned char* ws = launder(A.ws);
    const int gt = vcu * NTHR + tid, NGT = G * NTHR;
    {
        float* CS = (float*)(ws + WS_CS);
        for (int e = gt; e < 6144 * 32; e += NGT) {
            const int p = e >> 5, i = e & 31; const float a = (float)p * ROPE_INV[i];
            const double ad = (double)a; const double kq = __builtin_rint(ad * 0.63661977236758134308); const float y = (float)(ad - kq * 1.57079632679489661923);
            const int q = ((int)kq) & 3; const float y2 = y * y;
            const float sn = y + y * y2 * (-1.6666654611e-1f + y2 * (8.3321608736e-3f + y2 * (-1.9515295891e-4f)));
            const float cn = 1.f - 0.5f * y2 + y2 * y2 * (4.166664568298827e-2f + y2 * (-1.388731625493765e-3f + y2 * 2.443315711809948e-5f));
            const float s = (q == 0) ? sn : (q == 1) ? cn : (q == 2) ? -sn : -cn;
            const float c = (q == 0) ? cn : (q == 1) ? -sn : (q == 2) ? -cn : sn;
            CS[(size_t)p * 64 + i] = c; CS[(size_t)p * 64 + 32 + i] = s;
        }
        float* LB = (float*)(ws + WS_LB);
        for (int e = gt; e < 2 * 384; e += NGT) { const int l = e / 384, j = e % 384; const float l0 = GIN(A.in[I_LBL])[j], l1 = GIN(A.in[I_LBL])[384 + j];
            LB[e] = (l == 0) ? 0.f : 1.f / (1.f + expf(l0 - l1)); }
        bf16_t* GW = (bf16_t*)(ws + WS_GW);
        for (int e = gt; e < 2 * 4 * 128 * 128; e += NGT) { const int s = e & 127, t = (e >> 7) & 127; GW[e] = (bf16_t)((s <= t) ? f2bf(GIN(A.in[I_GWS])[e]) : 0u); }
    }
    if (vcu < 192) {
        LAS float* sc = (LAS float*)lds;
        {
            f32x4 cv[16];
#pragma unroll
            for (int i = 0; i < 16; ++i) cv[i] = *(const f32x4*)(GIN(A.in[I_C]) + 4 * (tid + NTHR * i));
#pragma unroll
            for (int i = 0; i < 16; ++i) { f32x4 o;
#pragma unroll
                for (int j = 0; j < 4; ++j) o[j] = cv[i][j] * sigmoidf(cv[i][j]);
                *(LAS f32x4*)(sc + 4 * (tid + NTHR * i)) = o; }
        }
        __syncthreads();
        const int l = vcu / 96, n0 = (vcu % 96) * 64, n = n0 + lane;
        const float* W = GIN(A.in[I_WADA]) + (size_t)l * DM * 6144;
        float acc[32];
#pragma unroll
        for (int b = 0; b < 32; ++b) acc[b] = 0.f;
        {
            const float* wp = W + (size_t)(wave * 128) * 6144 + n;
            float nx[16];
#pragma unroll
            for (int i = 0; i < 16; ++i) nx[i] = wp[(size_t)i * 6144];
#pragma unroll
            for (int i = 0; i < 16; ++i) asm volatile("" : "+v"(nx[i]));
#pragma unroll 1
            for (int k0 = 0; k0 < 128; k0 += 16) {
                float cw[16];
#pragma unroll
                for (int i = 0; i < 16; ++i) cw[i] = nx[i];
                const float* wn = wp + (size_t)((k0 + 16 < 128) ? k0 + 16 : k0) * 6144;
#pragma unroll
                for (int i = 0; i < 16; ++i) nx[i] = wn[(size_t)i * 6144];
                __builtin_amdgcn_sched_barrier(0);
#pragma unroll
                for (int b = 0; b < 32; ++b) { const LAS f32x4* sp = (const LAS f32x4*)(sc + b * DM + wave * 128 + k0); float a = acc[b];
#pragma unroll
                    for (int q = 0; q < 4; ++q) { const f32x4 s4 = sp[q]; a = __builtin_fmaf(s4[0], cw[4 * q], a); a = __builtin_fmaf(s4[1], cw[4 * q + 1], a); a = __builtin_fmaf(s4[2], cw[4 * q + 2], a); a = __builtin_fmaf(s4[3], cw[4 * q + 3], a); }
                    asm volatile("" : "+v"(a));
                    acc[b] = a; }
#pragma unroll
                for (int i = 0; i < 16; ++i) asm volatile("" : "+v"(nx[i]));
            }
        }
        __syncthreads();
        LAS float* red = (LAS float*)lds;
#pragma unroll
        for (int b = 0; b < 32; ++b) red[(wave * 32 + b) * 64 + lane] = acc[b];
        __syncthreads();
        float* MOD = (float*)(ws + WS_MOD);
        for (int e = tid; e < 32 * 64; e += NTHR) { const int b = e >> 6, j = e & 63; float s = 0.f;
#pragma unroll
            for (int w = 0; w < 8; ++w) s += red[(w * 32 + b) * 64 + j];
            MOD[((size_t)l * 32 + b) * 6144 + n0 + j] = s + GIN(A.in[I_BADA])[l * 6144 + n0 + j]; }
        __syncthreads();
    }
    LAS float* scr = (LAS float*)(lds + wave * 16640);
    const int gw = vcu * NWAVES + wave, NGW = G * NWAVES;
    constexpr int I_IN = 16 * 48, I_OUT = 16 * 16, NWITEMS = 2 * I_IN + 2 * I_OUT;
    for (int it = gw; it < NWITEMS; it += NGW) {
        int r = it;
        if (r < 2 * I_IN) { const int l = r / I_IN; r %= I_IN;
            p0_transpose_item<false>(GIN(A.in[I_WIN]) + (size_t)l * DM * INSRC, DM, INSRC, (bf16_t*)(ws + WS_WIN) + (size_t)l * NIN * DM, scr, r / 48, r % 48, lane, [](int n) { return inproj_srccol(n); }); continue; }
        r -= 2 * I_IN;
        { const int l = r / I_OUT; r %= I_OUT;
            p0_transpose_item<false>(GIN(A.in[I_WOUT]) + (size_t)l * DM * DM, DM, DM, (bf16_t*)(ws + WS_WOUT) + (size_t)l * DM * DM, scr, r / 16, r % 16, lane, [](int n) { return n; }); }
    }
    __syncthreads();
    constexpr int G_F1 = 8 * 22, G_F2 = 22 * 4, G_M1 = 8 * 28, G_M2 = 28 * 4, NGITEMS = G_F1 + G_F2 + 8 * G_M1 + 8 * G_M2;
    const int half = lane >> 5, q32 = lane & 31; int par = 0;
    for (int wi = vcu; wi < NGITEMS; wi += G, par ^= 1) {
        LAS unsigned char* buf = lds + par * 36864;
        int r = wi;
        if (r < G_F1) { const int kb = r % 8, nt = r / 8; const float* src = half ? GIN(A.in[I_FU]) : GIN(A.in[I_FG]);
            p0_wg_item(src + (size_t)(128 * kb + 16 * wave) * FD + 128 * nt + 4 * q32, FD, ws + WS_WF1 + (size_t)(256 * nt) * DM + 128 * kb, (size_t)DM, half ? 16.f * SWI_UP : 16.f * SWI_GATE, buf, lane, wave); continue; }
        r -= G_F1;
        if (r < G_F2) { const int kb = r % 22, nt = r / 22;
            p0_wg_item(GIN(A.in[I_FD]) + (size_t)(128 * kb + 16 * wave) * DM + 256 * nt + 4 * lane, DM, ws + WS_WF2 + (size_t)(256 * nt) * FD + 128 * kb, (size_t)FD, 16.f, buf, lane, wave); continue; }
        r -= G_F2;
        if (r < 8 * G_M1) { const int e = r / G_M1; r %= G_M1; const int kb = r % 8, nt = r / 8; const float* src = (half ? GIN(A.in[I_MU]) : GIN(A.in[I_MG])) + (size_t)e * DM * FE;
            p0_wg_item(src + (size_t)(128 * kb + 16 * wave) * FE + 128 * nt + 4 * q32, FE, ws + WS_WM1 + (size_t)e * 7168 * DM + (size_t)(256 * nt) * DM + 128 * kb, (size_t)DM, half ? 16.f * SWI_UP : 16.f * SWI_GATE, buf, lane, wave); continue; }
        r -= 8 * G_M1;
        { const int e = r / G_M2; r %= G_M2; const int kb = r % 28, nt = r / 28;
            p0_wg_item(GIN(A.in[I_MD]) + (size_t)e * FE * DM + (size_t)(128 * kb + 16 * wave) * DM + 256 * nt + 4 * lane, DM, ws + WS_WM2 + (size_t)e * DM * FE + (size_t)(256 * nt) * FE + 128 * kb, (size_t)FE, 16.f, buf, lane, wave); }
    }
}

#undef A
template <bool FP8, bool XBF>
__device__ __forceinline__ void norm_phase(const void* xv_, const float* g, const float* sh, const float* sc, void* Ov, int vcu, int G) {
    const int lane = opaque_tid0() & 63, wave = opaque_tid0() >> 6, gw = vcu * NWAVES + wave, NGW = G * NWAVES;
    constexpr int NR = XBF ? 8 : 16;
    for (int rb = gw; rb < T / 32; rb += NGW) {
        const int b = (rb * 32) >> 11;
        f32x4 gv[4], sv[4];
#pragma unroll
        for (int j = 0; j < 4; ++j) { const int c = 4 * lane + 256 * j; const f32x4 gg = *(const f32x4*)(g + c), s1 = *(const f32x4*)(sc + (size_t)b * 6144 + c); gv[j] = gg * (s1 + 1.f); sv[j] = *(const f32x4*)(sh + (size_t)b * 6144 + c); }
        unsigned nx[NR];
        {   const size_t row = (size_t)rb * 32;
            if constexpr (XBF) { const u32x2* xr = (const u32x2*)((const bf16_t*)xv_ + row * DM) + lane;
#pragma unroll
                for (int j = 0; j < 4; ++j) { const u32x2 t = xr[64 * j]; nx[2 * j] = t[0]; nx[2 * j + 1] = t[1]; } }
            else { const u32x4* xr = (const u32x4*)((const float*)xv_ + row * DM) + lane;
#pragma unroll
                for (int j = 0; j < 4; ++j) { const u32x4 t = xr[64 * j]; nx[4 * j] = t[0]; nx[4 * j + 1] = t[1]; nx[4 * j + 2] = t[2]; nx[4 * j + 3] = t[3]; } }
#pragma unroll
            for (int i = 0; i < NR; ++i) asm volatile("" : "+v"(nx[i])); }
#pragma unroll 1
        for (int r = 0; r < 32; ++r) {
            const size_t row = (size_t)rb * 32 + r;
            unsigned cw[NR];
#pragma unroll
            for (int i = 0; i < NR; ++i) cw[i] = nx[i];
            {   const size_t rn = row + (r < 31 ? 1 : 0);
                if constexpr (XBF) { const u32x2* xr = (const u32x2*)((const bf16_t*)xv_ + rn * DM) + lane;
#pragma unroll
                    for (int j = 0; j < 4; ++j) { const u32x2 t = xr[64 * j]; nx[2 * j] = t[0]; nx[2 * j + 1] = t[1]; } }
                else { const u32x4* xr = (const u32x4*)((const float*)xv_ + rn * DM) + lane;
#pragma unroll
                    for (int j = 0; j < 4; ++j) { const u32x4 t = xr[64 * j]; nx[4 * j] = t[0]; nx[4 * j + 1] = t[1]; nx[4 * j + 2] = t[2]; nx[4 * j + 3] = t[3]; } } }
            __builtin_amdgcn_sched_barrier(0);
            f32x4 v[4]; float s = 0.f;
            if constexpr (XBF) {
#pragma unroll
                for (int j = 0; j < 4; ++j) { v[j][0] = __builtin_bit_cast(float, cw[2 * j] << 16); v[j][1] = __builtin_bit_cast(float, cw[2 * j] & 0xffff0000u); v[j][2] = __builtin_bit_cast(float, cw[2 * j + 1] << 16); v[j][3] = __builtin_bit_cast(float, cw[2 * j + 1] & 0xffff0000u); } }
            else {
#pragma unroll
                for (int j = 0; j < 4; ++j) { v[j][0] = __builtin_bit_cast(float, cw[4 * j]); v[j][1] = __builtin_bit_cast(float, cw[4 * j + 1]); v[j][2] = __builtin_bit_cast(float, cw[4 * j + 2]); v[j][3] = __builtin_bit_cast(float, cw[4 * j + 3]); } }
#pragma unroll
            for (int j = 0; j < 4; ++j) s += (v[j][0] * v[j][0] + v[j][1] * v[j][1]) + (v[j][2] * v[j][2] + v[j][3] * v[j][3]);
            const float rs = 1.f / sqrtf(wave_sum(s) * (1.f / DM) + EPS);
            if constexpr (FP8) { unsigned* o4 = (unsigned*)((unsigned char*)Ov + row * DM) + lane;
#pragma unroll
                for (int j = 0; j < 4; ++j) { const f32x4 y = v[j] * rs * gv[j] + sv[j]; o4[64 * j] = pk4_fp8(y[0], y[1], y[2], y[3]); } }
            else { unsigned long long* o8 = (unsigned long long*)((bf16_t*)Ov + row * DM) + lane;
#pragma unroll
                for (int j = 0; j < 4; ++j) { const f32x4 y = v[j] * rs * gv[j] + sv[j]; o8[64 * j] = (unsigned long long)pk2(y[0], y[1]) | ((unsigned long long)pk2(y[2], y[3]) << 32); } }
#pragma unroll
            for (int i = 0; i < NR; ++i) asm volatile("" : "+v"(nx[i]));
        }
    }
}
__device__ __forceinline__ void norm_route_phase(const bf16_t* x, const float* g, const float* sh, const float* sc, const float* wr_, unsigned char* O, int* TOK, unsigned* cnt, LAS unsigned char* lds, int vcu, int G) {
    const int tid = opaque_tid0(), lane = tid & 63, wave = tid >> 6;
    LAS float* WR = (LAS float*)lds;
    LAS int* lcnt = (LAS int*)(lds + 32768);
    LAS int* lbase = (LAS int*)(lds + 32768 + 64);
    LAS int* tinfo = (LAS int*)(lds + 32768 + 128);
    for (int e = tid; e < DM * NE; e += NTHR) WR[e] = wr_[e];
    for (int blk = vcu; blk < T / 256; blk += G) {
        __syncthreads();
        if (tid < 16) lcnt[tid] = 0;
        __syncthreads();
        const int b = (blk * 256) >> 11;
        f32x4 gv[4], sv[4];
#pragma unroll
        for (int j = 0; j < 4; ++j) { const int c = 4 * lane + 256 * j; const f32x4 gg = *(const f32x4*)(g + c), s1 = *(const f32x4*)(sc + (size_t)b * 6144 + c); gv[j] = gg * (s1 + 1.f); sv[j] = *(const f32x4*)(sh + (size_t)b * 6144 + c); }
        unsigned nx[8];
        {   const u32x2* xr0 = (const u32x2*)(x + ((size_t)blk * 256 + wave * 32) * DM) + lane;
#pragma unroll
            for (int j = 0; j < 4; ++j) { const u32x2 t = xr0[64 * j]; nx[2 * j] = t[0]; nx[2 * j + 1] = t[1]; }
#pragma unroll
            for (int j = 0; j < 8; ++j) asm volatile("" : "+v"(nx[j])); }
#pragma unroll 1
        for (int r = 0; r < 32; ++r) {
            const int tl = wave * 32 + r; const size_t row = (size_t)blk * 256 + tl;
            unsigned cwv[8];
#pragma unroll
            for (int j = 0; j < 8; ++j) cwv[j] = nx[j];
            {   const u32x2* xrn = (const u32x2*)(x + (row + (r < 31 ? 1 : 0)) * DM) + lane;
#pragma unroll
                for (int j = 0; j < 4; ++j) { const u32x2 t = xrn[64 * j]; nx[2 * j] = t[0]; nx[2 * j + 1] = t[1]; } }
            __builtin_amdgcn_sched_barrier(0);
            f32x4 v[4]; float s = 0.f;
#pragma unroll
            for (int j = 0; j < 4; ++j) { u32x2 w2; w2[0] = cwv[2 * j]; w2[1] = cwv[2 * j + 1]; v[j][0] = __builtin_bit_cast(float, w2[0] << 16); v[j][1] = __builtin_bit_cast(float, w2[0] & 0xffff0000u); v[j][2] = __builtin_bit_cast(float, w2[1] << 16); v[j][3] = __builtin_bit_cast(float, w2[1] & 0xffff0000u); s += (v[j][0] * v[j][0] + v[j][1] * v[j][1]) + (v[j][2] * v[j][2] + v[j][3] * v[j][3]); }
            const float rs = 1.f / sqrtf(wave_sum(s) * (1.f / DM) + EPS);
            unsigned* o4 = (unsigned*)(O + row * DM) + lane;
            float lg[8];
#pragma unroll
            for (int e = 0; e < 8; ++e) lg[e] = 0.f;
#pragma unroll
            for (int j = 0; j < 4; ++j) { const f32x4 y = v[j] * rs * gv[j] + sv[j]; o4[64 * j] = pk4_fp8(y[0], y[1], y[2], y[3]);
#pragma unroll
                for (int q = 0; q < 4; ++q) { const LAS f32x4* wp = (const LAS f32x4*)(WR + (size_t)(4 * lane + 256 * j + q) * 8); const f32x4 wa = wp[0], wb = wp[1];
                    lg[0] += y[q] * wa[0]; lg[1] += y[q] * wa[1]; lg[2] += y[q] * wa[2]; lg[3] += y[q] * wa[3]; lg[4] += y[q] * wb[0]; lg[5] += y[q] * wb[1]; lg[6] += y[q] * wb[2]; lg[7] += y[q] * wb[3]; } }
#pragma unroll
            for (int e = 0; e < 8; ++e) lg[e] = wave_sum(lg[e]);
            if (lane == 0) {
                int e0 = 0; float v0 = lg[0];
#pragma unroll
                for (int e = 1; e < 8; ++e) if (lg[e] > v0) { v0 = lg[e]; e0 = e; }
                int e1 = -1; float v1 = -3.0e38f;
#pragma unroll
                for (int e = 0; e < 8; ++e) if (e != e0 && lg[e] > v1) { v1 = lg[e]; e1 = e; }
                const float w1 = fast_exp(v1 - v0), g0 = 1.f / (1.f + w1), g1 = w1 * g0;
                const int p0 = atomicAdd((int*)&lcnt[e0], 1), p1 = atomicAdd((int*)&lcnt[8 + e1], 1);
                tinfo[tl * 6 + 0] = e0; tinfo[tl * 6 + 1] = e1; tinfo[tl * 6 + 2] = p0; tinfo[tl * 6 + 3] = p1; tinfo[tl * 6 + 4] = __builtin_bit_cast(int, g0); tinfo[tl * 6 + 5] = __builtin_bit_cast(int, g1);
            }
#pragma unroll
            for (int j = 0; j < 8; ++j) asm volatile("" : "+v"(nx[j]));
        }
        __syncthreads();
        if (tid < 16) lbase[tid] = (int)__hip_atomic_fetch_add(cnt + 64 * tid, (unsigned)lcnt[tid], RLX_AGENT);
        __syncthreads();
        if (tid < 256) { int* o = TOK + ((size_t)blk * 256 + tid) * 8; const int e0 = tinfo[tid * 6], e1 = tinfo[tid * 6 + 1];
            o[0] = e0; o[1] = e1; o[2] = tinfo[tid * 6 + 2] + lbase[e0]; o[3] = tinfo[tid * 6 + 3] + lbase[8 + e1]; o[4] = tinfo[tid * 6 + 4]; o[5] = tinfo[tid * 6 + 5]; }
    }
}
__device__ __forceinline__ void moe_prefix_both(unsigned* cnt, LAS int* tp, LAS int* raw) {
    const int t = opaque_tid0();
    if (t < 16) raw[t] = (int)__hip_atomic_load(cnt + 64 * t, RLX_AGENT);
    __syncthreads();
    if (t == 0) {
#pragma unroll
        for (int k = 0; k < 2; ++k) { int a = 0;
#pragma unroll
            for (int e = 0; e < 8; ++e) { tp[k * 9 + e] = a; a += (raw[k * 8 + e] + 255) >> 8; }
            tp[k * 9 + 8] = a; } }
    __syncthreads();
}
__device__ __forceinline__ void moe_prefix(unsigned* cnt, int k, LAS int* tp) {
    if (opaque_tid0() == 0) { int a = 0; for (int e = 0; e < 8; ++e) { tp[e] = a; a += ((int)__hip_atomic_load(cnt + 64 * (k * 8 + e), RLX_AGENT) + 255) >> 8; } tp[8] = a; }
    __syncthreads();
}
__device__ __forceinline__ void unpack4(const u32x2 w2, f32x4& v) { v[0] = __builtin_bit_cast(float, w2[0] << 16); v[1] = __builtin_bit_cast(float, w2[0] & 0xffff0000u); v[2] = __builtin_bit_cast(float, w2[1] << 16); v[3] = __builtin_bit_cast(float, w2[1] & 0xffff0000u); }
__device__ __forceinline__ void final_norm_phase(const bf16_t* xr_, const bf16_t* Y0, const bf16_t* Y1, const int* TOK, const float* g2, unsigned* cnt, LAS unsigned char* lds, float* out, const float* g, int vcu, int G, float pscale = 1.f, float padd = 0.f) {
    const int lane = opaque_tid0() & 63, wave = opaque_tid0() >> 6, gw = vcu * NWAVES + wave, NGW = G * NWAVES;
    LAS int* tp = (LAS int*)lds;
    __syncthreads(); moe_prefix_both(cnt, tp, tp + 32);
    f32x4 gv[4];
#pragma unroll
    for (int j = 0; j < 4; ++j) gv[j] = *(const f32x4*)(g + 4 * lane + 256 * j);
    const int seg = (T + NGW - 1) / NGW, rbeg = gw * seg, rend = (rbeg + seg < T) ? rbeg + seg : T;
    int nti[6]; unsigned nxr[8];
    if (rbeg < rend) { const int* t0 = TOK + (size_t)rbeg * 8; const u32x2* x0 = (const u32x2*)(xr_ + (size_t)rbeg * DM) + lane;
#pragma unroll
        for (int i = 0; i < 6; ++i) nti[i] = t0[i];
#pragma unroll
        for (int j = 0; j < 4; ++j) { const u32x2 t = x0[64 * j]; nxr[2 * j] = t[0]; nxr[2 * j + 1] = t[1]; }
#pragma unroll
        for (int i = 0; i < 6; ++i) asm volatile("" : "+v"(nti[i]));
#pragma unroll
        for (int i = 0; i < 8; ++i) asm volatile("" : "+v"(nxr[i])); }
#pragma unroll 1
    for (int row = rbeg; row < rend; ++row) {
        int ti[6]; unsigned cx[8];
#pragma unroll
        for (int i = 0; i < 6; ++i) ti[i] = nti[i];
#pragma unroll
        for (int i = 0; i < 8; ++i) cx[i] = nxr[i];
        { const int rn = (row + 1 < rend) ? row + 1 : row; const int* tn = TOK + (size_t)rn * 8; const u32x2* xn = (const u32x2*)(xr_ + (size_t)rn * DM) + lane;
#pragma unroll
            for (int i = 0; i < 6; ++i) nti[i] = tn[i];
#pragma unroll
            for (int j = 0; j < 4; ++j) { const u32x2 t = xn[64 * j]; nxr[2 * j] = t[0]; nxr[2 * j + 1] = t[1]; } }
        const int e0 = ti[0], e1 = ti[1]; const float q0 = __builtin_bit_cast(float, ti[4]), q1 = __builtin_bit_cast(float, ti[5]);
        const size_t r0 = (size_t)256 * tp[e0] + ti[2], r1 = (size_t)256 * tp[9 + e1] + ti[3];
        f32x4* o = (f32x4*)(out + (size_t)row * DM) + lane;
        const u32x2* y0 = (const u32x2*)(Y0 + r0 * DM) + lane; const u32x2* y1 = (const u32x2*)(Y1 + r1 * DM) + lane;
        const float* gp = g2 + (size_t)(row >> 11) * 6144 + 4 * lane;
        u32x2 xr[4];
#pragma unroll
        for (int j = 0; j < 4; ++j) { xr[j][0] = cx[2 * j]; xr[j][1] = cx[2 * j + 1]; }
        f32x4 v[4]; float s = 0.f;
#pragma unroll
        for (int j = 0; j < 4; ++j) { f32x4 a, b; unpack4(xr[j], v[j]); unpack4(y0[64 * j], a); unpack4(y1[64 * j], b);
            v[j] += *(const f32x4*)(gp + 256 * j) * (a * q0 + b * q1);
            s += (v[j][0] * v[j][0] + v[j][1] * v[j][1]) + (v[j][2] * v[j][2] + v[j][3] * v[j][3]); }
        const float rs = 1.f / sqrtf(wave_sum(s) * (1.f / DM) + EPS);
#pragma unroll
        for (int j = 0; j < 4; ++j) { f32x4 y = v[j] * rs * gv[j] * pscale; if (row == 0 && j == 0 && lane == 0) y[0] += padd; o[64 * j] = y; }
#pragma unroll
        for (int i = 0; i < 6; ++i) asm volatile("" : "+v"(nti[i]));
#pragma unroll
        for (int i = 0; i < 8; ++i) asm volatile("" : "+v"(nxr[i]));
    }
}
__device__ __forceinline__ void moe_rowinfo_phase(const int* TOK, int* RI, unsigned* cnt, LAS unsigned char* lds, int vcu, int G) {
    const int tid = opaque_tid0();
    LAS int* tp = (LAS int*)lds;
    moe_prefix_both(cnt, tp, tp + 32);
    for (int tok = vcu * NTHR + tid; tok < T; tok += G * NTHR) {
        const u32x4 a = *(const u32x4*)(TOK + (size_t)tok * 8); const u32x2 gq = *(const u32x2*)(TOK + (size_t)tok * 8 + 4);
#pragma unroll
        for (int k = 0; k < 2; ++k) { const int e = (int)a[k], row = 256 * tp[k * 9 + e] + (int)a[2 + k];
            u32x2 o; o[0] = (unsigned)tok; o[1] = gq[k]; *(u32x2*)(RI + ((size_t)k * HSROWS + row) * 2) = o; }
    }
    for (int it = vcu; it < 16; it += G) { const int k = it >> 3, e = it & 7; const int c = (int)__hip_atomic_load(cnt + 64 * it, RLX_AGENT), base = 256 * tp[k * 9 + e];
        for (int r = c + tid; r < ((c + 255) & ~255); r += NTHR) RI[((size_t)k * HSROWS + base + r) * 2] = -1; }
}

typedef f32x16 acc16;
__device__ __forceinline__ acc16 zero16() { acc16 z;
#pragma unroll
    for (int i = 0; i < 16; ++i) z[i] = 0.f; return z; }
#define MFMA32(a, b, c) __builtin_amdgcn_mfma_f32_32x32x16_bf16((a), (b), (c), 0, 0, 0)
__device__ __forceinline__ bf16x8 ld_lds8(const LAS bf16_t* p) { return *(const LAS bf16x8*)p; }

struct MixPtrsT {
    unsigned char* ws;
    struct Ref { unsigned char* ws;
        __device__ __forceinline__ const bf16_t* QAp() const { return (const bf16_t*)(ws + WS_QA); } };
};
#define MP_FIELDS \
    X(const bf16_t*, QA, WS_QA) X(const bf16_t*, KA, WS_KA) X(const bf16_t*, VAT, WS_VAT) X(const bf16_t*, IQ, WS_IQ) X(const bf16_t*, IK, WS_IK) X(const float*, IW, WS_IW) \
    X(const bf16_t*, HQ, WS_HQ) X(const bf16_t*, HKK, WS_HKK) X(const bf16_t*, HI, WS_HI) X(const bf16_t*, HG, WS_HG) X(const float*, HLF, WS_HLF) \
    X(const bf16_t*, GU, WS_GU) X(const bf16_t*, GV, WS_GV) X(unsigned long long*, BM, WS_BM) X(bf16_t*, MIX, WS_ACT1)
struct MixPtrs { unsigned char* ws; };
#define X(T_, N_, O_) __device__ __forceinline__ T_ mp_##N_(const MixPtrs& P) { return (T_)(P.ws + O_); }
MP_FIELDS
#undef X


__device__ __forceinline__ void hgrn_unit(LAS unsigned char* lds, const MixPtrs& P, int b, int h, const float* onorm) {
    const int tid = opaque_tid0(), lane = tid & 63, w = tid >> 6, l32 = lane & 31, hh = lane >> 5;
    LAS float* BC = (LAS float*)lds;
    LAS float* GT = (LAS float*)(lds + 16384);
    LAS bf16_t* QA_ = (LAS bf16_t*)(lds + 18432);
    LAS bf16_t* KA_ = (LAS bf16_t*)(lds + 27648);
    LAS bf16_t* QB_ = (LAS bf16_t*)(lds + 36864);
    LAS bf16_t* KB_ = (LAS bf16_t*)(lds + 41472);
    LAS bf16_t* QE_ = (LAS bf16_t*)(lds + 46080);
    LAS bf16_t* KST = (LAS bf16_t*)(lds + 55296);
    LAS bf16_t* VT_ = (LAS bf16_t*)(lds + 64512);
    LAS bf16_t* AM_ = (LAS bf16_t*)(lds + 73728);
    LAS float* ST_ = (LAS float*)(lds + 82944);
    LAS float* OO_ = (LAS float*)(lds + 100352);
    for (int e = tid; e < 64 * 68; e += NTHR) ST_[e] = 0.f;
    const int te = tid >> 3, d0 = (tid & 7) * 8;
    const size_t rowb = (size_t)b * SEQ;
    float og[8];
#pragma unroll
    for (int i = 0; i < 8; ++i) og[i] = onorm[d0 + i];
    float nlf[8]; u32x4 nq, nk, nv, ng;
    {
#pragma unroll
        for (int i = 0; i < 8; ++i) nlf[i] = mp_HLF(P)[((rowb + 8 * w + i) * 6 + h) * 64 + lane];
        const size_t o = ((rowb + te) * 6 + h) * 64 + d0; nq = *(const u32x4*)(mp_HQ(P) + o); nk = *(const u32x4*)(mp_HKK(P) + o); nv = *(const u32x4*)(mp_HI(P) + o); ng = *(const u32x4*)(mp_HG(P) + o);
    }
    for (int c = 0; c < 32; ++c) {
        float lf[8]; u32x4 cq = nq, ck = nk, cv = nv, cg = ng;
#pragma unroll
        for (int i = 0; i < 8; ++i) lf[i] = nlf[i];
        if (c + 1 < 32) {
            const size_t r1 = rowb + (size_t)(c + 1) * 64;
#pragma unroll
            for (int i = 0; i < 8; ++i) nlf[i] = mp_HLF(P)[((r1 + 8 * w + i) * 6 + h) * 64 + lane];
            const size_t o = ((r1 + te) * 6 + h) * 64 + d0; nq = *(const u32x4*)(mp_HQ(P) + o); nk = *(const u32x4*)(mp_HKK(P) + o); nv = *(const u32x4*)(mp_HI(P) + o); ng = *(const u32x4*)(mp_HG(P) + o);
        }
#pragma unroll
        for (int i = 1; i < 8; ++i) lf[i] += lf[i - 1];
        GT[w * 64 + lane] = lf[7];
        __syncthreads();
        { float off = 0.f;
#pragma unroll
            for (int ww = 0; ww < 7; ++ww) off += (ww < w) ? GT[ww * 64 + lane] : 0.f;
#pragma unroll
            for (int i = 0; i < 8; ++i) BC[(8 * w + i) * 64 + lane] = lf[i] + off; }
        __syncthreads();
        {
            const f32x4 ba = *(const LAS f32x4*)(BC + te * 64 + d0), bb = *(const LAS f32x4*)(BC + te * 64 + d0 + 4);
            const int rr = (te < 32) ? 16 : 48;
            const f32x4 ra = *(const LAS f32x4*)(BC + rr * 64 + d0), rb = *(const LAS f32x4*)(BC + rr * 64 + d0 + 4);
            const f32x4 ma = *(const LAS f32x4*)(BC + 31 * 64 + d0), mb = *(const LAS f32x4*)(BC + 31 * 64 + d0 + 4);
            const f32x4 la = *(const LAS f32x4*)(BC + 63 * 64 + d0), lb_ = *(const LAS f32x4*)(BC + 63 * 64 + d0 + 4);
            float q[8], k[8], bt[8], rf[8], md[8], ls[8];
#pragma unroll
            for (int i = 0; i < 4; ++i) { q[2 * i] = bf2f((unsigned short)(cq[i] & 0xffff)); q[2 * i + 1] = bf2f((unsigned short)(cq[i] >> 16)); k[2 * i] = bf2f((unsigned short)(ck[i] & 0xffff)); k[2 * i + 1] = bf2f((unsigned short)(ck[i] >> 16)); }
#pragma unroll
            for (int i = 0; i < 4; ++i) { bt[i] = ba[i]; bt[4 + i] = bb[i]; rf[i] = ra[i]; rf[4 + i] = rb[i]; md[i] = ma[i]; md[4 + i] = mb[i]; ls[i] = la[i]; ls[4 + i] = lb_[i]; }
            float qa[8], ka[8], qe[8], xb[8], ks[8];
#pragma unroll
            for (int i = 0; i < 8; ++i) { qa[i] = q[i] * fast_exp(bt[i] - rf[i]); ka[i] = k[i] * fast_exp(rf[i] - bt[i]); qe[i] = q[i] * fast_exp(bt[i]);
                xb[i] = (te < 32) ? k[i] * fast_exp(md[i] - bt[i]) : q[i] * fast_exp(bt[i] - md[i]); ks[i] = k[i] * fast_exp(ls[i] - bt[i]); }
            u32x4 pq, pk, pe, px;
#pragma unroll
            for (int i = 0; i < 4; ++i) { pq[i] = pk2(qa[2 * i], qa[2 * i + 1]); pk[i] = pk2(ka[2 * i], ka[2 * i + 1]); pe[i] = pk2(qe[2 * i], qe[2 * i + 1]); px[i] = pk2(xb[2 * i], xb[2 * i + 1]); }
            *(LAS u32x4*)(QA_ + te * 72 + d0) = pq; *(LAS u32x4*)(KA_ + te * 72 + d0) = pk; *(LAS u32x4*)(QE_ + te * 72 + d0) = pe;
            if (te < 32) *(LAS u32x4*)(KB_ + te * 72 + d0) = px; else *(LAS u32x4*)(QB_ + (te - 32) * 72 + d0) = px;
#pragma unroll
            for (int i = 0; i < 8; ++i) KST[(d0 + i) * 72 + te] = (bf16_t)f2bf(ks[i]);
#pragma unroll
            for (int i = 0; i < 4; ++i) { VT_[(d0 + 2 * i) * 72 + te] = (bf16_t)(cv[i] & 0xffff); VT_[(d0 + 2 * i + 1) * 72 + te] = (bf16_t)(cv[i] >> 16); }
        }
        __syncthreads();
        acc16 oacc = zero16();
        if (w < 3) {
            const LAS bf16_t* Qs = (w == 0) ? QA_ : (w == 1) ? QA_ + 32 * 72 : QB_;
            const LAS bf16_t* Ks = (w == 0) ? KA_ : (w == 1) ? KA_ + 32 * 72 : KB_;
            acc16 a = zero16();
#pragma unroll
            for (int kk = 0; kk < 4; ++kk) a = MFMA32(ld_lds8(Qs + l32 * 72 + 8 * hh + 16 * kk), ld_lds8(Ks + l32 * 72 + 8 * hh + 16 * kk), a);
            const int tb = (w == 0) ? 0 : 32, sb = (w == 1) ? 32 : 0;
#pragma unroll
            for (int i = 0; i < 16; ++i) { const int tl = 8 * (i >> 2) + 4 * hh + (i & 3); const float v = (w < 2 && l32 > tl) ? 0.f : a[i]; AM_[(tb + tl) * 72 + sb + l32] = (bf16_t)f2bf(v); }
        } else if (w < 7) {
            const int th = (w - 3) >> 1, vh = (w - 3) & 1;
#pragma unroll
            for (int kk = 0; kk < 4; ++kk) {
                const LAS float* sp = ST_ + (vh * 32 + l32) * 68 + 8 * hh + 16 * kk; const f32x4 s0 = *(const LAS f32x4*)sp, s1 = *(const LAS f32x4*)(sp + 4);
                u32x4 sbv; sbv[0] = pk2(s0[0], s0[1]); sbv[1] = pk2(s0[2], s0[3]); sbv[2] = pk2(s1[0], s1[1]); sbv[3] = pk2(s1[2], s1[3]);
                oacc = MFMA32(ld_lds8(QE_ + (th * 32 + l32) * 72 + 8 * hh + 16 * kk), __builtin_bit_cast(bf16x8, sbv), oacc);
            }
        }
        __syncthreads();
        if (w >= 3 && w < 7) {
            const int th = (w - 3) >> 1, vh = (w - 3) & 1; const int nk = th ? 4 : 2;
            for (int kk = 0; kk < nk; ++kk) oacc = MFMA32(ld_lds8(AM_ + (th * 32 + l32) * 72 + 8 * hh + 16 * kk), ld_lds8(VT_ + (vh * 32 + l32) * 72 + 8 * hh + 16 * kk), oacc);
#pragma unroll
            for (int i = 0; i < 16; ++i) { const int tl = 8 * (i >> 2) + 4 * hh + (i & 3); OO_[(th * 32 + tl) * 68 + vh * 32 + l32] = oacc[i]; }
        } else {
            const int idx = (w == 7) ? 3 : w, vh = idx >> 1, dh = idx & 1;
            acc16 a = zero16();
#pragma unroll
            for (int kk = 0; kk < 4; ++kk) a = MFMA32(ld_lds8(VT_ + (vh * 32 + l32) * 72 + 8 * hh + 16 * kk), ld_lds8(KST + (dh * 32 + l32) * 72 + 8 * hh + 16 * kk), a);
            const float dec = fast_exp(BC[63 * 64 + dh * 32 + l32]);
#pragma unroll
            for (int i = 0; i < 16; ++i) { const int vl = 8 * (i >> 2) + 4 * hh + (i & 3); LAS float* sp = ST_ + (vh * 32 + vl) * 68 + dh * 32 + l32; *sp = dec * (*sp) + a[i]; }
        }
        __syncthreads();
        {
            const f32x4 oa = *(const LAS f32x4*)(OO_ + te * 68 + d0), ob = *(const LAS f32x4*)(OO_ + te * 68 + d0 + 4);
            float ss = (oa[0] * oa[0] + oa[1] * oa[1]) + (oa[2] * oa[2] + oa[3] * oa[3]) + (ob[0] * ob[0] + ob[1] * ob[1]) + (ob[2] * ob[2] + ob[3] * ob[3]);
            ss = sum8(ss);
            const float rs = 1.f / sqrtf(ss * (1.f / 64.f) + EPS);
            float r[8];
#pragma unroll
            for (int i = 0; i < 4; ++i) { r[i] = oa[i] * rs * og[i]; r[4 + i] = ob[i] * rs * og[4 + i]; }
#pragma unroll
            for (int i = 0; i < 4; ++i) { r[2 * i] *= bf2f((unsigned short)(cg[i] & 0xffff)); r[2 * i + 1] *= bf2f((unsigned short)(cg[i] >> 16)); }
            u32x4 o; o[0] = pk2(r[0], r[1]); o[1] = pk2(r[2], r[3]); o[2] = pk2(r[4], r[5]); o[3] = pk2(r[6], r[7]);
            *(u32x4*)(mp_MIX(P) + (rowb + (size_t)c * 64 + te) * DM + 384 + h * 64 + d0) = o;
        }
    }
}

__device__ __forceinline__ void gmlp_unit(LAS unsigned char* lds, const MixPtrs& P, int b, int n, const float* vng, const float* vnb, const bf16_t* GW, const float* gbs) {
    const int tid = opaque_tid0(), lane = tid & 63, w = tid >> 6, l32 = lane & 31, hh = lane >> 5;
    LAS bf16_t* VT = (LAS bf16_t*)lds;
    const size_t row0 = (size_t)b * SEQ + (size_t)n * 128;
    u32x4 gwf[20];
    {   const int g_ = w >> 1; int fi = 0;
#pragma unroll
        for (int tb = 0; tb < 4; ++tb)
#pragma unroll
            for (int kk = 0; kk < 8; ++kk) if (kk < 2 * (tb + 1)) { gwf[fi] = *(const u32x4*)(GW + ((size_t)g_ * 128 + tb * 32 + l32) * 128 + 8 * hh + 16 * kk); ++fi; } }
    __builtin_amdgcn_sched_barrier(0);
    {
        const int s = 16 * w + (lane >> 2), c0 = 64 * (lane & 3);
        float x[64];
#pragma unroll
        for (int i = 0; i < 8; ++i) { const u32x4 v = *(const u32x4*)(mp_GV(P) + (row0 + s) * 256 + c0 + 8 * i);
#pragma unroll
            for (int j = 0; j < 4; ++j) { x[8 * i + 2 * j] = bf2f((unsigned short)(v[j] & 0xffff)); x[8 * i + 2 * j + 1] = bf2f((unsigned short)(v[j] >> 16)); } }
        float sm = 0.f;
#pragma unroll
        for (int i = 0; i < 64; ++i) sm += x[i];
        sm = dpp_add(sm, 0); sm = dpp_add(sm, 1);
        const float mu = sm * (1.f / 256.f); float vq = 0.f;
#pragma unroll
        for (int i = 0; i < 64; ++i) { x[i] -= mu; vq += x[i] * x[i]; }
        vq = dpp_add(vq, 0); vq = dpp_add(vq, 1);
        const float rs = 1.f / sqrtf(vq * (1.f / 256.f) + EPS);
#pragma unroll
        for (int i = 0; i < 64; ++i) VT[(c0 + i) * 136 + s] = (bf16_t)f2bf(x[i] * rs * vng[c0 + i] + vnb[c0 + i]);
    }
    __syncthreads();
    const int g = w >> 1, db = w & 1;
    acc16 acc[4];
#pragma unroll
    for (int fi = 0; fi < 20; ++fi) asm volatile("" : "+v"(gwf[fi]));
    { int fi = 0;
#pragma unroll
    for (int tb = 0; tb < 4; ++tb) { acc[tb] = zero16();
#pragma unroll
        for (int kk = 0; kk < 8; ++kk) if (kk < 2 * (tb + 1)) {
            acc[tb] = MFMA32(__builtin_bit_cast(bf16x8, gwf[fi]), ld_lds8(VT + (g * 64 + db * 32 + l32) * 136 + 8 * hh + 16 * kk), acc[tb]); ++fi; } } }
    const int cch = g * 64 + db * 32 + l32;
    __syncthreads();
    LAS float* GT_ = (LAS float*)lds;
#pragma unroll
    for (int tb = 0; tb < 4; ++tb)
#pragma unroll
        for (int i = 0; i < 16; ++i) { const int t = tb * 32 + 8 * (i >> 2) + 4 * hh + (i & 3); GT_[t * 260 + cch] = acc[tb][i] + gbs[g * 128 + t]; }
    __syncthreads();
#pragma unroll
    for (int k = 0; k < 8; ++k) { const int idx = tid + NTHR * k, t = idx >> 5, c8 = 8 * (idx & 31);
        const u32x4 uw = *(const u32x4*)(mp_GU(P) + (row0 + t) * 256 + c8);
        const f32x4 ga = *(const LAS f32x4*)(GT_ + t * 260 + c8), gb = *(const LAS f32x4*)(GT_ + t * 260 + c8 + 4);
        f32x4 ua, ub; unpack8(uw, ua, ub);
        *(u32x4*)(mp_MIX(P) + (row0 + t) * DM + 768 + c8) = pack8(ua * ga, ub * gb); }
}

constexpr int SC_STRIDE = 2052;
#ifndef SEL_REP_MODE
#define SEL_REP_MODE 0
#endif
typedef unsigned short u16x2 __attribute__((ext_vector_type(2)));
__device__ __forceinline__ unsigned pk_gt(unsigned x, unsigned c2) {
    unsigned d; asm("v_pk_sub_u16 %0, %1, %2 clamp\n\tv_pk_min_u16 %0, %0, %3" : "=&v"(d) : "v"(x), "v"(c2), "s"(0x00010001u)); return d;
}
__device__ __forceinline__ void pk_cnt(unsigned& acc, unsigned x, unsigned c2) {
    unsigned d; asm("v_pk_sub_u16 %1, %2, %3 clamp\n\tv_pk_min_u16 %1, %1, %4\n\tv_pk_add_u16 %0, %0, %1" : "+v"(acc), "=&v"(d) : "v"(x), "v"(c2), "s"(0x00010001u));
}
__device__ __forceinline__ void pk_neq(unsigned& acc, unsigned x, unsigned c2) {
    unsigned d; asm("v_xor_b32 %1, %2, %3\n\tv_pk_min_u16 %1, %1, %4\n\tv_pk_add_u16 %0, %0, %1" : "+v"(acc), "=&v"(d) : "v"(x), "v"(c2), "s"(0x00010001u));
}
__device__ __forceinline__ unsigned pk_add(unsigned a, unsigned b) { return __builtin_bit_cast(unsigned, (u16x2)(__builtin_bit_cast(u16x2, a) + __builtin_bit_cast(u16x2, b))); }
__device__ __forceinline__ unsigned pk_sub(unsigned a, unsigned b) { return __builtin_bit_cast(unsigned, (u16x2)(__builtin_bit_cast(u16x2, a) - __builtin_bit_cast(u16x2, b))); }

__device__ __forceinline__ void dsa_select_unit(LAS unsigned char* lds, const MixPtrs& P, int b, int j, int rep = 0) {
    const int tid = opaque_tid0(), lane = tid & 63, w = tid >> 6, qi = lane & 31, hh = lane >> 5;
    LAS unsigned* XC = (LAS unsigned*)lds;
    LAS unsigned char* TT = (LAS unsigned char*)(lds + 6144);
    LAS unsigned char* AL = (LAS unsigned char*)(lds + 8192);
    LAS int* NQ = (LAS int*)(lds + 10240);
    const size_t rowb = (size_t)b * SEQ; const size_t qrow = rowb + (size_t)j * 32 + qi;
    unsigned* BM32 = (unsigned*)mp_BM(P);
    const int zq = tid >> 4, zc = tid & 15;
    if (j < 8) {
        const int t = 32 * j + zq; u32x4 wv;
#pragma unroll
        for (int i = 0; i < 4; ++i) { const int k0 = 32 * (4 * zc + i); wv[i] = (k0 + 31 <= t) ? 0xffffffffu : (k0 > t) ? 0u : ((2u << (t - k0)) - 1u); }
        *(u32x4*)(BM32 + (rowb + t) * 64 + 4 * zc) = wv;
        return;
    }
    *(LAS unsigned*)(TT + 4 * tid) = 0u;
    {
        unsigned* bp = BM32 + (rowb + 32 * j + zq) * 64 + 4 * zc;
#pragma unroll
        for (int i = 0; i < 4; ++i) if (4 * zc + i > j) bp[i] = 0u;
    }
    unsigned K[8][8];
    {
        bf16x8 qf[4][4];
#pragma unroll
        for (int hd = 0; hd < 4; ++hd)
#pragma unroll
            for (int kk = 0; kk < 4; ++kk) qf[hd][kk] = *(const bf16x8*)(mp_IQ(P) + (qrow * 4 + hd) * 64 + 8 * hh + 16 * kk);
        f32x4 iw = *(const f32x4*)(mp_IW(P) + qrow * 4); iw *= 0.5f * 0.125f;
#pragma unroll
        for (int ti = 0; ti < 8; ++ti) {
            const int kt = w + 8 * ti;
            if (kt <= j) {
                bf16x8 kf[4];
#pragma unroll
                for (int kk = 0; kk < 4; ++kk) kf[kk] = *(const bf16x8*)(mp_IK(P) + (rowb + (size_t)kt * 32 + qi) * 64 + 8 * hh + 16 * kk);
                float sc[16];
#pragma unroll
                for (int i = 0; i < 16; ++i) sc[i] = 0.f;
#pragma unroll
                for (int hd = 0; hd < 4; ++hd) { acc16 a = zero16();
#pragma unroll
                    for (int kk = 0; kk < 4; ++kk) a = MFMA32(kf[kk], qf[hd][kk], a);
#pragma unroll
                    for (int i = 0; i < 16; ++i) { const float av = a[i]; int rb = __float_as_int(av); rb = rb > 0 ? rb : 0;
                        sc[i] = __builtin_fmaf(iw[hd], __int_as_float(rb), sc[i]); asm volatile("" : "+v"(sc[i])); } }
                unsigned ky[16];
#pragma unroll
                for (int i = 0; i < 16; ++i) { const int hb = (int)__builtin_bit_cast(unsigned short, (_Float16)sc[i]);
                    ky[i] = (unsigned)(hb ^ (__builtin_amdgcn_sbfe(hb, 15, 1) | 0x8000)) & 0xffffu; }
                if (kt == j) {
#pragma unroll
                    for (int i = 0; i < 16; ++i) if ((8 * (i >> 2) + 4 * hh + (i & 3)) > qi) ky[i] = 0u;
                }
#pragma unroll
                for (int p = 0; p < 8; ++p) K[ti][p] = ky[2 * p] | (ky[2 * p + 1] << 16);
            } else {
#pragma unroll
                for (int p = 0; p < 8; ++p) K[ti][p] = 0u;
            }
        }
    }
#define SEL_COUNT(c2, out) do { unsigned _a = 0u; _Pragma("unroll") for (int ti = 0; ti < 8; ++ti) if (w + 8 * ti <= j) { _Pragma("unroll") for (int p = 0; p < 8; ++p) pk_cnt(_a, K[ti][p], (c2)); } (out) = (int)((_a & 0xffffu) + (_a >> 16)); } while (0)
#define SEL_TOTAL(buf, cnt, tot) do { XC[((buf) * 32 + qi) * 20 + 2 * w + hh] = (unsigned)(cnt); __syncthreads(); \
        const LAS u32x4* _x = (const LAS u32x4*)(XC + ((buf) * 32 + qi) * 20);        \
         const u32x4 _a = _x[0], _b = _x[1], _c = _x[2], _d = _x[3]; \
        (tot) = (int)((_a[0] + _a[1] + _a[2] + _a[3]) + (_b[0] + _b[1] + _b[2] + _b[3]) + (_c[0] + _c[1] + _c[2] + _c[3]) + (_d[0] + _d[1] + _d[2] + _d[3])); } while (0)
    if (rep > 0 && SEL_REP_MODE == 1) return;
    unsigned v = 0u; int ngt = 0, cge = 0;
#pragma unroll 1
    for (int bit = 15; bit >= 0; --bit) {
        const unsigned cand = v | (1u << bit), cm1 = cand - 1u; int cnt, tot;
        SEL_COUNT(cm1 * 0x00010001u, cnt);
        SEL_TOTAL(bit & 1, cnt, tot);
        if (tot >= 256) { v = cand; cge = tot; } else ngt = tot;
    }
    (void)cge;
    const int need = 256 - ngt;
    if (w == 0 && hh == 0) NQ[qi] = need;
    const unsigned v2 = v * 0x00010001u, vm2 = (v - 1u) * 0x00010001u;
    int tlane[8];
#pragma unroll
    for (int ti = 0; ti < 8; ++ti) { tlane[ti] = 0;
        if (w + 8 * ti <= j) { unsigned a = 0u;
#pragma unroll
            for (int p = 0; p < 8; ++p) pk_neq(a, K[ti][p], v2);
            const int tl = 16 - (int)((a & 0xffffu) + (a >> 16)); const int tp = __shfl_xor(tl, 32); tlane[ti] = tl + tp;
            if (hh == 0) TT[qi * 64 + w + 8 * ti] = (unsigned char)(tl + tp); } }
    __syncthreads();
    {
        const unsigned x = *(const LAS unsigned*)(TT + zq * 64 + 4 * zc);
        const int b0 = x & 255, b1 = (x >> 8) & 255, b2 = (x >> 16) & 255, b3 = x >> 24; const int s = b0 + b1 + b2 + b3;
        int incl = s;
#pragma unroll
        for (int o = 1; o < 16; o <<= 1) { const int tt = __shfl_up(incl, o, 16); if (zc >= o) incl += tt; }
        int rem = NQ[zq] - (incl - s);
        int a0 = min(max(rem, 0), b0); rem -= b0; int a1 = min(max(rem, 0), b1); rem -= b1; int a2 = min(max(rem, 0), b2); rem -= b2; int a3 = min(max(rem, 0), b3);
        *(LAS unsigned*)(AL + zq * 64 + 4 * zc) = (unsigned)a0 | ((unsigned)a1 << 8) | ((unsigned)a2 << 16) | ((unsigned)a3 << 24);
    }
    __syncthreads();
#pragma unroll
    for (int ti = 0; ti < 8; ++ti) {
        const int kt = w + 8 * ti;
        if (kt <= j) {
            const int al = AL[qi * 64 + kt], tot = tlane[ti];
            unsigned word = 0u;
            if (!__any(al > 0 && al < tot)) {
                const unsigned thr2 = (al > 0) ? vm2 : v2;
#pragma unroll
                for (int p = 0; p < 8; ++p) { const unsigned f2 = pk_gt(K[ti][p], thr2); word |= ((f2 & 1u) | (f2 >> 15)) << (8 * (p >> 1) + 2 * (p & 1)); }
            } else {
            unsigned g2[8], e2[8]; unsigned tcp = 0u;
#pragma unroll
            for (int p = 0; p < 8; ++p) { g2[p] = pk_gt(K[ti][p], v2); e2[p] = pk_sub(pk_gt(K[ti][p], vm2), g2[p]); tcp += ((e2[p] & 1u) + (e2[p] >> 16)) << (4 * (p >> 1)); }
            const unsigned tpp = (unsigned)__shfl_xor((int)tcp, 32);
#pragma unroll
            for (int p = 0; p < 8; ++p) {
                const int g = p >> 1;
                unsigned ahead = 0u;
#pragma unroll
                for (int gg = 0; gg < 4; ++gg) if (gg < g) ahead += ((tcp >> (4 * gg)) & 15u) + ((tpp >> (4 * gg)) & 15u);
                if (hh) ahead += (tpp >> (4 * g)) & 15u;
                if (p & 1) ahead += (e2[p - 1] & 1u) + (e2[p - 1] >> 16);
                const unsigned elo = e2[p] & 1u, ehi = e2[p] >> 16;
                unsigned slo = elo, shi = ehi;
                if (al < tot) { slo = (elo && (int)ahead < al) ? 1u : 0u; shi = (ehi && (int)(ahead + elo) < al) ? 1u : 0u; }
                const unsigned bits = ((g2[p] & 1u) | slo) | ((((g2[p] >> 16) | shi)) << 1);
                word |= bits << (8 * g + 2 * (p & 1)); }
            }
            word <<= 4 * hh;
            word |= (unsigned)__shfl_xor((int)word, 32);
            if (hh == 0) BM32[qrow * 64 + kt + ((rep > 0 && SEL_REP_MODE == 2) ? (size_t)T * 64 : 0)] = word;
        }
    }
#undef SEL_COUNT
#undef SEL_TOTAL
}

constexpr int QL_STRIDE = 392;
__device__ __forceinline__ void dsa_attn_unit(LAS unsigned char* lds, const MixPtrs& P, int b, int J, float kmaxn) {
    const int tid = opaque_tid0(), lane = tid & 63, w = tid >> 6, qi = lane & 31, hh = lane >> 5;
    LAS bf16_t* KT = (LAS bf16_t*)lds;
    LAS bf16_t* VTT = (LAS bf16_t*)(lds + 2 * 64 * 72 * 2);
    LAS bf16_t* QL = (LAS bf16_t*)(lds + 4 * 64 * 72 * 2);
    const int qblk = w >> 1, hs = (w & 1) * 3;
    const size_t rowb = (size_t)b * SEQ; const int t = 128 * J + 32 * qblk + qi; const size_t row = rowb + t;
    {   u32x4 qt[12];
#pragma unroll
        for (int k = 0; k < 12; ++k) { const int e = tid + NTHR * k, r = e / 48, p = e % 48; qt[k] = *(const u32x4*)(mp_QA(P) + (rowb + (size_t)128 * J + r) * 384 + 8 * p); }
#pragma unroll
        for (int k = 0; k < 12; ++k) { const int e = tid + NTHR * k, r = e / 48, p = e % 48; *(LAS u32x4*)(QL + r * QL_STRIDE + 8 * p) = qt[k]; } }
    __syncthreads();
    const LAS bf16_t* qp = QL + (32 * qblk + qi) * QL_STRIDE + hs * 64 + 8 * hh;
    acc16 O[3][2]; float lsum[3];
#pragma unroll
    for (int h3 = 0; h3 < 3; ++h3) { O[h3][0] = zero16(); O[h3][1] = zero16(); lsum[h3] = 0.f; }
    const int nt = 2 * (J + 1);
    const int lr = tid >> 3, lp = (tid & 7) * 8;
    u32x4 rk = *(const u32x4*)(mp_KA(P) + (rowb + lr) * 64 + lp), rv = *(const u32x4*)(mp_VAT(P) + ((size_t)b * 64 + lr) * 2048 + lp);
    unsigned long long mw = mp_BM(P)[row * 32 + 0];
#pragma unroll 1
    for (int tile = 0; tile < nt; ++tile) {
        const int buf = tile & 1;
        *(LAS u32x4*)(KT + (buf * 64 + lr) * 72 + lp) = rk; *(LAS u32x4*)(VTT + (buf * 64 + lr) * 72 + lp) = rv;
        const unsigned long long cmw = mw;
        __syncthreads();
        if (tile + 1 < nt) { rk = *(const u32x4*)(mp_KA(P) + (rowb + (size_t)(tile + 1) * 64 + lr) * 64 + lp); rv = *(const u32x4*)(mp_VAT(P) + ((size_t)b * 64 + lr) * 2048 + (tile + 1) * 64 + lp); mw = mp_BM(P)[row * 32 + tile + 1]; }
#pragma unroll
        for (int sub = 0; sub < 2; ++sub) {
            const int msh = (int)((unsigned)(cmw >> (32 * sub)) >> (4 * hh));
            const LAS bf16_t* kp = KT + (buf * 64 + sub * 32 + qi) * 72 + 8 * hh;
            const LAS bf16_t* vp = VTT + (buf * 64 + qi) * 72 + sub * 32 + 4 * hh;
            bf16x8 kf[4], vf[2][2]; int em[16];
#pragma unroll
            for (int kk = 0; kk < 4; ++kk) kf[kk] = ld_lds8(kp + 16 * kk);
#pragma unroll
            for (int db = 0; db < 2; ++db)
#pragma unroll
                for (int s2 = 0; s2 < 2; ++s2) { const u32x2 lo = *(const LAS u32x2*)(vp + db * 32 * 72 + 16 * s2), hi = *(const LAS u32x2*)(vp + db * 32 * 72 + 16 * s2 + 8);
                    u32x4 c; c[0] = lo[0]; c[1] = lo[1]; c[2] = hi[0]; c[3] = hi[1]; vf[db][s2] = __builtin_bit_cast(bf16x8, c); }
#pragma unroll
            for (int i = 0; i < 16; ++i) em[i] = __builtin_amdgcn_sbfe(msh, 8 * (i >> 2) + (i & 3), 1);
            bf16x8 qc[4];
#pragma unroll
            for (int kk = 0; kk < 4; ++kk) qc[kk] = ld_lds8(qp + 16 * kk);
#pragma unroll
            for (int h3 = 0; h3 < 3; ++h3) {
                asm volatile("" ::: "memory"); __builtin_amdgcn_sched_barrier(0);
                acc16 s = zero16();
#pragma unroll
                for (int kk = 0; kk < 4; ++kk) s = MFMA32(kf[kk], qc[kk], s);
                if (h3 < 2) {
#pragma unroll
                    for (int kk = 0; kk < 4; ++kk) qc[kk] = ld_lds8(qp + (h3 + 1) * 64 + 16 * kk);
                }
#pragma unroll
                for (int s2 = 0; s2 < 2; ++s2) {
                    float p[8];
#pragma unroll
                    for (int i = 0; i < 8; ++i) { const int ii = 8 * s2 + i; p[i] = __builtin_bit_cast(float, __builtin_bit_cast(int, __builtin_amdgcn_exp2f(s[ii])) & em[ii]); lsum[h3] += p[i]; }
                    u32x4 pp;
#pragma unroll
                    for (int i = 0; i < 4; ++i) pp[i] = pk2(p[2 * i], p[2 * i + 1]);
#pragma unroll
                    for (int db = 0; db < 2; ++db) O[h3][db] = MFMA32(vf[db][s2], __builtin_bit_cast(bf16x8, pp), O[h3][db]);
                }
            }
        }
    }
#pragma unroll
    for (int h3 = 0; h3 < 3; ++h3) {
        float l = lsum[h3]; l += __shfl_xor(l, 32); const float inv = 1.f / l;
#pragma unroll
        for (int db = 0; db < 2; ++db)
#pragma unroll
            for (int gq = 0; gq < 4; ++gq) { u32x2 o; o[0] = pk2(O[h3][db][4 * gq] * inv, O[h3][db][4 * gq + 1] * inv); o[1] = pk2(O[h3][db][4 * gq + 2] * inv, O[h3][db][4 * gq + 3] * inv);
                *(u32x2*)(mp_MIX(P) + row * DM + (hs + h3) * 64 + db * 32 + 8 * gq + 4 * hh) = o; }
    }
    __syncthreads();
}

__device__ __forceinline__ MixPtrs make_mp(unsigned char* ws) { MixPtrs MP; MP.ws = ws; return MP; }
constexpr int NPH = 26;
__global__ void __launch_bounds__(NTHR, 2) fwd_kernel(Args args_by_value) {
    extern __shared__ __attribute__((aligned(16))) unsigned char lds_raw[];
    LAS unsigned char* lds = (LAS unsigned char*)lds_raw;
    volatile LAS unsigned* MISC = (volatile LAS unsigned*)(lds + LDS_MISC);
    const int tid = opaque_tid0();
    const int G = gridDim.x; int bx = blockIdx.x; int vcu = (G % 8 == 0) ? (bx % 8) * (G / 8) + bx / 8 : bx;
    (void)args_by_value;
#define args (*kargs())
    unsigned char* ws = args.ws;
    unsigned* ctl = (unsigned*)(ws + WS_CTL);
    if (tid < 64) MISC[tid] = 0u;
    __syncthreads();
    XcdBarrier bar = xcd_barrier_post(ctl + CW_BAR, MISC + 8);
    if (tid == 0) MISC[24] = __hip_atomic_fetch_add(ctl + CW_XRANK + 64 * (bar.x & 7u), 1u, RLX_AGENT);
    volatile LAS int* qslot = (volatile LAS int*)(MISC + 16);
    LAS int* tpl = (LAS int*)(lds + LDS_MISC + 128);
    const int lo = args.ph_lo, hi = args.ph_hi;
#ifndef PHMASK
#define PHMASK 0xFFFFFFFFu
#endif
#define PH(k) (lo <= (k) && (k) < hi)
#define PHM(j) ((PHMASK >> ((j) + 1)) & 1u)
#define PHL(j) (PHM(j) && PH(pb + (j)))
#define SEAM(k) do { if ((k) + 1 < hi) xcd_barrier(bar); } while (0)
#ifdef PROBE_A
    volatile LAS unsigned long long* PT = (volatile LAS unsigned long long*)(lds + LDS_MISC + 192);
    if (tid == 0) { const unsigned long long _t = __builtin_amdgcn_s_memrealtime(); PT[0] = _t; PT[1] = 0ull; PT[2] = 0ull; PT[3] = _t; }
#define STAMP(g) do { if (opaque_tid0() == 0) { const unsigned long long _t = __builtin_amdgcn_s_memrealtime(); if ((g) == PROBE_A) PT[1] += _t - PT[0]; if ((g) == PROBE_B) PT[2] += _t - PT[0]; PT[0] = _t; } } while (0)
#define UNIT_T0() const unsigned long long _ut0 = __builtin_amdgcn_s_memrealtime()
#define UNIT_T1(idx, cond) do { if ((cond) && opaque_tid0() == 0) ((unsigned*)(w + WS_CTL))[200 + (idx)] = (unsigned)(__builtin_amdgcn_s_memrealtime() - _ut0); } while (0)
#else
#define STAMP(g) do { } while (0)
#define UNIT_T0() do { } while (0)
#define UNIT_T1(idx, cond) do { } while (0)
#endif
    if ((PHMASK & 1u) && PH(0)) { p0_prologue(kargs(), lds, vcu, G);
#ifdef REP_PRO
        __syncthreads(); p0_prologue(kargs(), lds, vcu, G);
#endif
        SEAM(0); STAMP(0); }
    if (G % 8 == 0 && lo == 0 && hi > 1) {
        __syncthreads();
        if (tid == 0) { bool even = true;
            for (int k = 0; k < 8; ++k) even = even && (__hip_atomic_load(ctl + CW_XRANK + 64 * k, RLX_AGENT) == (unsigned)(G / 8));
            MISC[25] = even ? (MISC[24] * 8u + (bar.x & 7u)) : (unsigned)blockIdx.x; }
        __syncthreads();
        bx = __builtin_amdgcn_readfirstlane((int)MISC[25]); vcu = (bx % 8) * (G / 8) + bx / 8;
    }

    for (int l = 0; l < 2; ++l) {
        const int pb = 1 + 12 * l;
        if (PHL(0)) { unsigned char* w = launder(args.ws); const float* modl = (const float*)(w + WS_MOD) + (size_t)l * 32 * 6144;
            if (l == 0) norm_phase<false, false>(GIN(args.in[I_X]), GIN(args.in[I_GMIX]) + l * DM, modl + 0, modl + 1024, (void*)(w + WS_ACT1), vcu, G);
            else norm_phase<false, true>((const void*)(w + WS_XR), GIN(args.in[I_GMIX]) + l * DM, modl + 0, modl + 1024, (void*)(w + WS_ACT1), vcu, G); SEAM(pb + 0); STAMP(1); }
        if (PHL(1)) {
            unsigned char* w = launder(args.ws); const MixPtrs MP = make_mp(w);
            pg8::Gemm g{w, (unsigned)WS_ACT1, (unsigned)(WS_WIN + (size_t)l * NIN * DM * 2), T, NIN, DM}; pg8::StaticOrder S; S.init(T, NIN, G, bx, 4);
            EpiInproj E; E.QA = (bf16_t*)mp_QA(MP); E.KA = (bf16_t*)mp_KA(MP); E.VAT = (bf16_t*)mp_VAT(MP); E.IQ = (bf16_t*)mp_IQ(MP); E.IK = (bf16_t*)mp_IK(MP); E.IW = (float*)mp_IW(MP); E.HQ = (bf16_t*)mp_HQ(MP); E.HKK = (bf16_t*)mp_HKK(MP); E.HI = (bf16_t*)mp_HI(MP); E.HG = (bf16_t*)mp_HG(MP); E.HLF = (float*)mp_HLF(MP);
            E.GU = (bf16_t*)mp_GU(MP); E.GV = (bf16_t*)mp_GV(MP); E.CS = (const float*)(w + WS_CS); E.pos = (const int*)GIN(args.in[I_POS]); E.lb = (const float*)(w + WS_LB) + l * 384; E.kmax = (unsigned*)(w + WS_CTL) + CW_KMAX + l * 32; E.has_lb = (l > 0);
            pg8::gemm_phase<EpiInproj, pg8::StaticOrder>(lds, g, S, E);
            SEAM(pb + 1); STAMP(2);
        }
        if (PHL(2)) {
#if EN_HGRN
            for (int rep = 0; rep < REP_HGRN; ++rep) { unsigned char* w = launder(args.ws); const MixPtrs MP = make_mp(w); unsigned* ctr = (unsigned*)(w + WS_CTL) + CW_Q + 64 * (4 * l + 0 + 8 * rep);
              for (;;) { const int u = q_next(ctr, qslot); if (u >= 192) break; UNIT_T0(); hgrn_unit(lds, MP, u / 6, u % 6, GIN(args.in[I_ONORM]) + l * 64); UNIT_T1(0, u == 0 && l == 0); } }
#endif
#if EN_DSA
            for (int rep = 0; rep < REP_SEL; ++rep) { unsigned char* w = launder(args.ws); const MixPtrs MP = make_mp(w); unsigned* ctr = (unsigned*)(w + WS_CTL) + CW_Q + 64 * (32 + 8 * l + 16 * rep);
              for (;;) { const int u = q_next_xcd(ctr, 64u, bar.x & 7u, qslot); if (u < 0) break;
                  const int b = 4 * (u >> 6) + (u & 3), J = 15 - ((u & 63) >> 2);
#pragma unroll 1
                  for (int jj = 3; jj >= 0; --jj) { dsa_select_unit(lds, MP, b, 4 * J + jj, rep); __syncthreads(); }
                  asm volatile("s_waitcnt vmcnt(0)" ::: "memory"); __syncthreads();
                  dsa_attn_unit(lds, MP, b, J, 0.f); } }
#endif
#if EN_GMLP
            for (int rep = 0; rep < REP_GMLP; ++rep) { unsigned char* w = launder(args.ws); const MixPtrs MP = make_mp(w); unsigned* ctr = (unsigned*)(w + WS_CTL) + CW_Q + 64 * (4 * l + 2 + 8 * rep);
              for (;;) { const int u = q_next(ctr, qslot); if (u >= 512) break;
                  UNIT_T0(); gmlp_unit(lds, MP, u >> 4, u & 15, GIN(args.in[I_VNG]) + l * 256, GIN(args.in[I_VNB]) + l * 256, (const bf16_t*)(w + WS_GW) + (size_t)l * 4 * 128 * 128, GIN(args.in[I_GBS]) + l * 512); UNIT_T1(2, u == 0 && l == 0); } }
#endif
#if !EN_HGRN || !EN_GMLP || !EN_DSA
            {
                unsigned char* w = launder(args.ws); bf16_t* A1 = (bf16_t*)(w + WS_ACT1); const int tz = opaque_tid0();
                for (size_t e = (size_t)vcu * NTHR + tz; e < (size_t)T * 1024; e += (size_t)G * NTHR) { const int c = (int)(e & 1023);
                    const bool z = (!EN_DSA && c < 384) || (!EN_HGRN && c >= 384 && c < 768) || (!EN_GMLP && c >= 768); if (z) A1[e] = 0; }
            }
#endif
            SEAM(pb + 2); STAMP(4);
        }
        if (PHL(4)) {
            unsigned char* w = launder(args.ws); const float* modl = (const float*)(w + WS_MOD) + (size_t)l * 32 * 6144;
            pg8::Gemm g{w, (unsigned)WS_ACT1, (unsigned)(WS_WOUT + (size_t)l * DM * DM * 2), T, DM, DM}; pg8::StaticOrder S; S.init(T, DM, G, bx, 4);
            if (l == 0) { EpiResid<true> E{GIN(args.in[I_X]), (bf16_t*)(w + WS_XR), modl + 2 * 1024}; pg8::gemm_phase<EpiResid<true>, pg8::StaticOrder>(lds, g, S, E); }
            else { EpiResid<false> E{GIN(args.in[I_X]), (bf16_t*)(w + WS_XR), modl + 2 * 1024}; pg8::gemm_phase<EpiResid<false>, pg8::StaticOrder>(lds, g, S, E); }
            SEAM(pb + 4); STAMP(3);
        }
        if (l == 0) {
            if (PHL(5)) { unsigned char* w = launder(args.ws); const float* modl = (const float*)(w + WS_MOD) + (size_t)l * 32 * 6144;
                norm_phase<true, true>((const void*)(w + WS_XR), GIN(args.in[I_GFFN]) + l * DM, modl + 3 * 1024, modl + 4 * 1024, (void*)(w + WS_ACT1), vcu, G); SEAM(pb + 5); STAMP(1); }
            if (PHL(7)) {
                unsigned char* w = launder(args.ws);
                pg8::Gemm g{w, (unsigned)WS_ACT1, (unsigned)WS_WF1, T, 2 * FD, DM}; pg8::StaticOrder S; S.init(T, 2 * FD, G, bx);
                EpiSwiglu E{(unsigned char*)(w + WS_ACTF), FD, 22};
                pg8::gemm_phase<EpiSwiglu, pg8::StaticOrder, true>(lds, g, S, E);
                SEAM(pb + 7); STAMP(6);
            }
            if (PHL(8)) {
                unsigned char* w = launder(args.ws); const float* modl = (const float*)(w + WS_MOD) + (size_t)l * 32 * 6144;
                pg8::Gemm g{w, (unsigned)WS_ACTF, (unsigned)WS_WF2, T, DM, FD}; pg8::StaticOrder S; S.init(T, DM, G, bx);
                EpiResid<false> E{GIN(args.in[I_X]), (bf16_t*)(w + WS_XR), modl + 5 * 1024};
                pg8::gemm_phase<EpiResid<false>, pg8::StaticOrder, true>(lds, g, S, E);
                SEAM(pb + 8); STAMP(7);
            }
        } else {
            if (PHL(5)) { unsigned char* w = launder(args.ws); const float* modl = (const float*)(w + WS_MOD) + (size_t)l * 32 * 6144;
                norm_route_phase((const bf16_t*)(w + WS_XR), GIN(args.in[I_GFFN]) + l * DM, modl + 3 * 1024, modl + 4 * 1024, GIN(args.in[I_MR]), (unsigned char*)(w + WS_HS), (int*)(w + WS_TOK), (unsigned*)(w + WS_CTL) + CW_CNT, lds, vcu, G); SEAM(pb + 5); STAMP(1); }
            if (PHL(6)) { unsigned char* w = launder(args.ws);
                moe_rowinfo_phase((const int*)(w + WS_TOK), (int*)(w + WS_ROWINFO), (unsigned*)(w + WS_CTL) + CW_CNT, lds, vcu, G); SEAM(pb + 6); STAMP(1); }
            if (PHL(7)) {
                unsigned char* w = launder(args.ws); unsigned* cnt = (unsigned*)(w + WS_CTL) + CW_CNT;
                __syncthreads(); moe_prefix_both(cnt, tpl, (LAS int*)(lds + 133120));
                const int NT0 = __builtin_amdgcn_readfirstlane(tpl[8]), NT1 = __builtin_amdgcn_readfirstlane(tpl[17]);
                pg8::Gemm g{w, (unsigned)WS_HS, (unsigned)WS_WM1, (NT0 + NT1) * 256, 2 * FE, DM};
                pg8::MoeOrder S; S.init((NT0 + NT1) * 256, 2 * FE, G, bx); S.tp = tpl; S.nNl = 28; S.NT0 = NT0;
                EpiSwiglu E{(unsigned char*)(w + WS_ACTM), FE, 28};
                pg8::gemm_phase<EpiSwiglu, pg8::MoeOrder, true, true>(lds, g, S, E, (const int*)(w + WS_ROWINFO));
                SEAM(pb + 7); STAMP(8);
            }
            if (PHL(8)) {
                unsigned char* w = launder(args.ws); unsigned* cnt = (unsigned*)(w + WS_CTL) + CW_CNT;
                __syncthreads(); moe_prefix_both(cnt, tpl, (LAS int*)(lds + 133120));
                const int NT0 = __builtin_amdgcn_readfirstlane(tpl[8]), NT1 = __builtin_amdgcn_readfirstlane(tpl[17]);
                pg8::Gemm g{w, (unsigned)WS_ACTM, (unsigned)WS_WM2, (NT0 + NT1) * 256, DM, FE};
                pg8::MoeOrder S; S.init((NT0 + NT1) * 256, DM, G, bx); S.tp = tpl; S.nNl = 4; S.NT0 = NT0;
                EpiMoeDown E{(bf16_t*)(w + WS_YM0), (bf16_t*)(w + WS_YM1)};
                pg8::gemm_phase<EpiMoeDown, pg8::MoeOrder, true>(lds, g, S, E);
                SEAM(pb + 8); STAMP(9);
            }
        }
    }
    if (((PHMASK >> 13) & 1u) && PH(25)) {
#ifdef PROBE_A
        __syncthreads(); float tot = (float)(PT[0] - PT[3]);
        if (PROBE_A >= 100) { tot = PROBE_TOT; if (opaque_tid0() == 0) { PT[1] = ((volatile unsigned*)(ws + WS_CTL))[200 + PROBE_A - 100]; PT[2] = ((volatile unsigned*)(ws + WS_CTL))[200 + PROBE_B - 100]; } __syncthreads(); }
        final_norm_phase((const bf16_t*)(launder(args.ws) + WS_XR), (const bf16_t*)(launder(args.ws) + WS_YM0), (const bf16_t*)(launder(args.ws) + WS_YM1), (const int*)(launder(args.ws) + WS_TOK), (const float*)(launder(args.ws) + WS_MOD) + 32 * 6144 + 5 * 1024, (unsigned*)(launder(args.ws) + WS_CTL) + CW_CNT, lds, (float*)(GAS float*)args.out, GIN(args.in[I_GFIN]), vcu, G, 1.f + floorf((float)PT[1] / tot * 40.f + PROBE_OFF) / 40.f, 100.f * floorf((float)PT[2] / tot * 40.f + PROBE_OFF) / 40.f);
#else
        final_norm_phase((const bf16_t*)(launder(args.ws) + WS_XR), (const bf16_t*)(launder(args.ws) + WS_YM0), (const bf16_t*)(launder(args.ws) + WS_YM1), (const int*)(launder(args.ws) + WS_TOK), (const float*)(launder(args.ws) + WS_MOD) + 32 * 6144 + 5 * 1024, (unsigned*)(launder(args.ws) + WS_CTL) + CW_CNT, lds, (float*)(GAS float*)args.out, GIN(args.in[I_GFIN]), vcu, G);
#endif
    }
#undef PH
#undef SEAM
#undef args
}

extern "C" void kernel_launch(void* const* d_in, const int* in_sizes, int n_in, void* d_out, int out_size, void* d_ws, size_t ws_size, hipStream_t stream) {
    static int grid = 0;
    if (grid == 0) {
        if (n_in != 23 || out_size != T * DM || ws_size < WS_END) { fprintf(stderr, "kernel_launch: unexpected shapes (n_in %d, out %d, ws %zu)\n", n_in, out_size, ws_size); grid = -1; return; }
        int dev = 0, cus = 0, per_cu = 0;
        if (hipGetDevice(&dev) != hipSuccess || hipDeviceGetAttribute(&cus, hipDeviceAttributeMultiprocessorCount, dev) != hipSuccess) { grid = -1; return; }
        if (hipFuncSetAttribute((const void*)fwd_kernel, hipFuncAttributeMaxDynamicSharedMemorySize, LDS_BYTES) != hipSuccess) { fprintf(stderr, "kernel_launch: hipFuncSetAttribute failed\n"); grid = -1; return; }
        if (hipOccupancyMaxActiveBlocksPerMultiprocessor(&per_cu, (const void*)fwd_kernel, NTHR, LDS_BYTES) != hipSuccess || per_cu < 1) fprintf(stderr, "kernel_launch: occupancy query reports %d\n", per_cu);
        (void)hipGetLastError();
        grid = cus;
    }
    if (grid < 0) return;
    (void)hipMemsetAsync((char*)d_ws + WS_CTL, 0, CTL_ZERO_BYTES, stream);
    Args a{};
    for (int i = 0; i < 23; ++i) a.in[i] = (const float*)d_in[i];
    a.out = (float*)d_out; a.ws = (unsigned char*)d_ws;
#if MK_PER_PHASE
    for (int p = 0; p < NPH; ++p) {
        if (p == 7 || p == 10 || p == 11 || p == 12 || p == 24) continue;
        a.ph_lo = p; a.ph_hi = p + 1;
        hipLaunchKernelGGL(fwd_kernel, dim3(grid), dim3(NTHR), LDS_BYTES, stream, a);
    }
#else
    a.ph_lo = 0; a.ph_hi = NPH;
    hipLaunchKernelGGL(fwd_kernel, dim3(grid), dim3(NTHR), LDS_BYTES, stream, a);
#endif
}
```

```cpp
#include <hip/hip_runtime.h>
#include <cstdio>
#include <cstdint>

#ifndef MK_PER_PHASE
#define MK_PER_PHASE 0
#endif
#ifndef EN_GMLP
#define EN_GMLP 1
#endif
#ifndef EN_HGRN
#define EN_HGRN 1
#endif
#ifndef EN_DSA
#define EN_DSA 1
#endif
#ifndef REP_HGRN
#define REP_HGRN 1
#endif
#ifndef REP_SEL
#define REP_SEL 1
#endif
#ifndef REP_GMLP
#define REP_GMLP 1
#endif
#ifndef REP_ATTN
#define REP_ATTN 1
#endif

#define GAS __attribute__((address_space(1)))
#define LAS __attribute__((address_space(3)))
typedef unsigned short bf16_t;
typedef short bf16x8 __attribute__((ext_vector_type(8)));
typedef float f32x4 __attribute__((ext_vector_type(4)));
typedef float f32x2 __attribute__((ext_vector_type(2)));
typedef float f32x16 __attribute__((ext_vector_type(16)));
typedef unsigned u32x4 __attribute__((ext_vector_type(4)));
typedef unsigned u32x2 __attribute__((ext_vector_type(2)));
typedef GAS unsigned gu32;
#define RLX_AGENT __ATOMIC_RELAXED, __HIP_MEMORY_SCOPE_AGENT

constexpr int T = 65536, DM = 1024, NB = 32, SEQ = 2048;
constexpr int NIN = 3072;
constexpr int INSRC = 2884;
constexpr int FD = 2816, FE = 3584, NE = 8;
constexpr int NWAVES = 8, NTHR = 512;
constexpr int HSROWS = T + 2048;
constexpr float EPS = 1e-6f;

constexpr size_t MiB = 1u << 20;
constexpr size_t WS_CTL = 0, CTL_ZERO_BYTES = 1 * MiB;
constexpr size_t WS_MOD = 1 * MiB;
constexpr size_t WS_CS = 3 * MiB;
constexpr size_t WS_LB = 5 * MiB;
constexpr size_t WS_GW = 5 * MiB + 512 * 1024;
constexpr size_t WS_TOK = 6 * MiB;
constexpr size_t WS_ROWINFO = 8 * MiB;
constexpr size_t WS_WIN = 16 * MiB;
constexpr size_t WS_WOUT = 28 * MiB;
constexpr size_t WS_WF1 = 32 * MiB;
constexpr size_t WS_WF2 = 43 * MiB;
constexpr size_t WS_WM1 = 49 * MiB;
constexpr size_t WS_WM2 = 161 * MiB;
constexpr size_t WS_ACT1 = 224 * MiB;
constexpr size_t WS_BIG = 352 * MiB;
constexpr size_t WS_QA = WS_BIG;
constexpr size_t WS_KA = WS_QA + 48 * MiB;
constexpr size_t WS_VAT = WS_KA + 8 * MiB;
constexpr size_t WS_IQ = WS_VAT + 8 * MiB;
constexpr size_t WS_IK = WS_IQ + 32 * MiB;
constexpr size_t WS_IW = WS_IK + 8 * MiB;
constexpr size_t WS_HQ = WS_IW + 1 * MiB;
constexpr size_t WS_HLF = WS_HQ + 48 * MiB;
constexpr size_t WS_HKK = WS_HLF + 96 * MiB;
constexpr size_t WS_HI = WS_HKK + 48 * MiB;
constexpr size_t WS_HG = WS_HI + 48 * MiB;
constexpr size_t WS_GU = WS_HG + 48 * MiB;
constexpr size_t WS_GV = WS_GU + 32 * MiB;
constexpr size_t WS_BM = WS_GV + 32 * MiB;
constexpr size_t WS_MIXEND = WS_BM + 16 * MiB;
constexpr size_t WS_ACTF = WS_BIG;
constexpr size_t WS_HS = 224 * MiB;
constexpr size_t WS_ACTM = 360 * MiB;
constexpr size_t WS_YM0 = 224 * MiB;
constexpr size_t WS_YM1 = 16 * MiB;
constexpr size_t WS_HBM = 592 * MiB;
constexpr size_t WS_XR = 860 * MiB;
constexpr size_t WS_END = 1024 * MiB;
static_assert(WS_MIXEND <= WS_END && WS_ACTF + (size_t)T * FD * 2 <= WS_END, "ws map");
static_assert(WS_HS + (size_t)2 * HSROWS * DM <= WS_ACTM && WS_ACTM + (size_t)2 * HSROWS * FE <= WS_XR && WS_YM0 + (size_t)HSROWS * DM * 2 <= WS_ACTM && WS_YM1 + (size_t)HSROWS * DM * 2 <= WS_WM2 && WS_MIXEND <= WS_XR && WS_XR + (size_t)T * DM * 2 <= WS_END && WS_HBM + (size_t)T * DM <= WS_ACTM + (size_t)2 * HSROWS * FE && HSROWS % 256 == 0, "ws map moe");
static_assert(WS_WM2 + (size_t)NE * DM * FE * 2 <= WS_ACT1, "ws map weights");

constexpr int CW_BAR = 4096;
constexpr int CW_Q = 8192;
constexpr int CW_CNT = 12288;
constexpr int CW_KMAX = 16384;
constexpr int CW_XRANK = 20480;

constexpr int LDS_BYTES = 163840;
constexpr int LDS_MISC = 163840 - 256;
constexpr int PH_SCRATCH = LDS_MISC;

__device__ __forceinline__ float bf2f(unsigned short b) { return __builtin_bit_cast(float, ((unsigned)b) << 16); }
typedef __bf16 bf16x2_t __attribute__((ext_vector_type(2)));
__device__ __forceinline__ unsigned f2bf(float f) { return (unsigned)__builtin_bit_cast(unsigned short, (__bf16)f); }
__device__ __forceinline__ unsigned pk2(float lo, float hi) { const f32x2 v = {lo, hi}; return __builtin_bit_cast(unsigned, __builtin_convertvector(v, bf16x2_t)); }
__device__ __forceinline__ unsigned pk4_fp8(float a, float b, float c, float d) { int w = __builtin_amdgcn_cvt_pk_fp8_f32(a, b, 0, false); w = __builtin_amdgcn_cvt_pk_fp8_f32(c, d, w, true); return (unsigned)w; }
__device__ __forceinline__ float dpp_add(float v, const int ctrl_b1_4e_141_140) {
    const int x = __builtin_bit_cast(int, v);
    switch (ctrl_b1_4e_141_140) {
        case 0: return v + __builtin_bit_cast(float, __builtin_amdgcn_update_dpp(x, x, 0xB1, 0xF, 0xF, false));
        case 1: return v + __builtin_bit_cast(float, __builtin_amdgcn_update_dpp(x, x, 0x4E, 0xF, 0xF, false));
        case 2: return v + __builtin_bit_cast(float, __builtin_amdgcn_update_dpp(x, x, 0x141, 0xF, 0xF, false));
        default: return v + __builtin_bit_cast(float, __builtin_amdgcn_update_dpp(x, x, 0x140, 0xF, 0xF, false));
    }
}
__device__ __forceinline__ float sum8(float v) { v = dpp_add(v, 0); v = dpp_add(v, 1); return dpp_add(v, 2); }
__device__ __forceinline__ float wave_sum(float v) {
    v = dpp_add(v, 0); v = dpp_add(v, 1); v = dpp_add(v, 2); v = dpp_add(v, 3);
    const int x = __builtin_bit_cast(int, v);
    const float r0 = __builtin_bit_cast(float, __builtin_amdgcn_readlane(x, 0)), r1 = __builtin_bit_cast(float, __builtin_amdgcn_readlane(x, 16)),
                r2 = __builtin_bit_cast(float, __builtin_amdgcn_readlane(x, 32)), r3 = __builtin_bit_cast(float, __builtin_amdgcn_readlane(x, 48));
    return (r0 + r1) + (r2 + r3);
}
__device__ __forceinline__ float fast_exp(float x) { return __builtin_amdgcn_exp2f(x * 1.44269504089f); }
__device__ __forceinline__ float fast_log(float x) { return __builtin_amdgcn_logf(x) * 0.69314718056f; }
__device__ __forceinline__ float sigmoidf(float x) { return __builtin_amdgcn_rcpf(1.f + fast_exp(-x)); }

__device__ __forceinline__ int opaque_tid0() { int t = threadIdx.x; asm volatile("" : "+v"(t)); return t; }
namespace pg8 {
constexpr int BM = 256, BK = 64, HALF = 128, HTB = HALF * BK * 2, STAGE_BYTES = 8 * HTB, NXCD = 8, WGM = 8;
__host__ __device__ __forceinline__ int lds_byte(int r, int c) { const int st = (r >> 4) * 2 + (c >> 5), rr = r & 15, cc = c & 31, ob = rr * 64 + cc * 2; return st * 1024 + (ob ^ (((ob >> 9) & 1) << 5)); }
__host__ __device__ __forceinline__ void stage_rc(int b, int& R, int& C) { const int st = b / 1024, sb = b % 1024, swz = sb ^ (((sb >> 9) & 1) << 5); R = (st >> 1) * 16 + swz / 64; C = (st & 1) * 32 + (swz % 64) / 2; }
__host__ __device__ __forceinline__ int perm32(int rho) { const int n = rho >> 4, i = rho & 15; return 8 * (i >> 2) + 4 * n + (i & 3); }
struct Unit { int pm, pn; };
struct Gemm { const unsigned char* base; unsigned offA, offB; int M, N, K; };
struct StaticOrder {
    int nM, nN, nwg, G, c, wgm;
    __device__ void init(int M, int N, int G_, int c_, int wgm_ = WGM) { nM = M / BM; nN = N / BM; nwg = nM * nN; G = G_; c = c_; wgm = wgm_; }
    __device__ bool next(int i, Unit& u) const {
        const long L = (long)i * G + c; if (L >= nwg) return false;
        int wgid = (int)L; { const int q = nwg / NXCD, r = nwg % NXCD, xcd = wgid % NXCD, off = wgid / NXCD; wgid = (xcd < r ? xcd * (q + 1) : r * (q + 1) + (xcd - r) * q) + off; }
        const int nig = wgm * nN, gid = wgid / nig, fm = gid * wgm, gsz = (nM - fm) < wgm ? (nM - fm) : wgm;
        u.pm = fm + ((wgid % nig) % gsz); u.pn = (wgid % nig) / gsz; return true;
    }
};
struct MoeOrder : StaticOrder {
    const LAS int* tp; int nNl, NT0;
    __device__ bool next(int i, Unit& u) const {
        if (!StaticOrder::next(i, u)) return false;
        const int k = (u.pm >= NT0) ? 1 : 0, ml = u.pm - k * NT0; int e = 0;
#pragma unroll
        for (int q = 1; q < 8; ++q) e += (ml >= tp[k * 9 + q]) ? 1 : 0;
        u.pm = __builtin_amdgcn_readfirstlane(k * (HSROWS / 256) + ml); u.pn += __builtin_amdgcn_readfirstlane(e) * nNl; return true;
    }
};

typedef int i32x4 __attribute__((ext_vector_type(4)));
typedef int i32x8 __attribute__((ext_vector_type(8)));
__device__ __forceinline__ i32x8 cat8(const bf16x8 a, const bf16x8 b) { return __builtin_shufflevector(__builtin_bit_cast(i32x4, a), __builtin_bit_cast(i32x4, b), 0, 1, 2, 3, 4, 5, 6, 7); }
template <class Epi, class Sched, bool FP8 = false, bool GA = false>
__device__ __forceinline__ void gemm_phase(LAS unsigned char* lds, const Gemm g, const Sched& S, const Epi& E, const int* ri = nullptr) {
    const int tid = opaque_tid0(), wid = __builtin_amdgcn_readfirstlane(tid >> 6), lane = tid & 63, wr = wid >> 2, wc = wid & 3, fr = lane & 15, fq = lane >> 4;
    const int RB = FP8 ? g.K : 2 * g.K, nt = RB / (2 * BK);
    unsigned voffA[2], voffB[2]; int gaR[2]; unsigned gaC[2];
#pragma unroll
    for (int i = 0; i < 2; ++i) { int R, C; stage_rc(tid * 16 + i * 8192, R, C); const int Rb = Epi::PERM ? ((R & ~31) + perm32(R & 31)) : R;
        voffA[i] = (unsigned)(R * RB + 2 * C); voffB[i] = (unsigned)(Rb * RB + 2 * C); gaR[i] = R; gaC[i] = (unsigned)(2 * C); }
    (void)gaR; (void)gaC;
    unsigned vA[2][2], vN[2][2];
#define PG8_RI_DMA(par, pm_) do { if (wid < 4) __builtin_amdgcn_global_load_lds((const unsigned*)(ri + 2 * ((size_t)(pm_) * 256 + 64 * wid + lane)), (LAS unsigned*)(lds + 131072 + (par) * 1024 + wid * 256), 4, 0, 0); } while (0)
#define PG8_RI_READ(dst, par) do { _Pragma("unroll") for (int _h = 0; _h < 2; ++_h) _Pragma("unroll") for (int _i = 0; _i < 2; ++_i) { \
        const int _t = *(const LAS int*)(lds + 131072 + (par) * 1024 + 4 * (128 * _h + gaR[_i])); dst[_h][_i] = (unsigned)(_t > 0 ? _t : 0) * (unsigned)RB + gaC[_i]; } } while (0)
#define PG8_STAGE_GA(bufoff, koff, vv, h) do { _Pragma("unroll") for (int _i = 0; _i < 2; ++_i) \
        __builtin_amdgcn_global_load_lds((const unsigned*)(g.base + (size_t)(unsigned)(g.offA + (koff) + (vv)[h][_i])), (LAS unsigned*)(lds + (bufoff) + ldsw + _i * 8192), 16, 0, 0); } while (0)
    const unsigned kstep = (unsigned)(BK * 2);
    const unsigned hstep = (unsigned)HALF * RB;
    const unsigned tstep = 2 * hstep;
    const unsigned ldsw = (unsigned)wid * 1024u;
    const int aoff = lds_byte(wr * 64 + fr, fq * 8), boff = lds_byte(wc * 32 + fr, fq * 8);
#define PG8_SA(b, h) (((b) * 2 + (h)) * HTB)
#define PG8_SB(b, h) ((4 + (b) * 2 + (h)) * HTB)
#define PG8_STAGE(bufoff, gbase, voff) do { _Pragma("unroll") for (int _i = 0; _i < 2; ++_i) \
        __builtin_amdgcn_global_load_lds((const unsigned*)(g.base + (size_t)(unsigned)((gbase) + (voff)[_i])), (LAS unsigned*)(lds + (bufoff) + ldsw + _i * 8192), 16, 0, 0); } while (0)
#define PG8_LDA(dst, b, h) do { _Pragma("unroll") for (int m = 0; m < 4; ++m) _Pragma("unroll") for (int k = 0; k < 2; ++k) dst[m][k] = *(const LAS bf16x8*)(lds + PG8_SA(b, h) + aoff + m * 2048 + k * 1024); } while (0)
#define PG8_LDB(dst, b, h) do { _Pragma("unroll") for (int n = 0; n < 2; ++n) _Pragma("unroll") for (int k = 0; k < 2; ++k) dst[n][k] = *(const LAS bf16x8*)(lds + PG8_SB(b, h) + boff + n * 2048 + k * 1024); } while (0)
#define PG8_MMA(ai, bj, At, Bt) do { __builtin_amdgcn_s_setprio(1); _Pragma("unroll") for (int m = 0; m < 4; ++m) _Pragma("unroll") for (int n = 0; n < 2; ++n) { \
        if constexpr (FP8) { asm volatile("v_mfma_scale_f32_16x16x128_f8f6f4 %0, %1, %2, %0, %3, %3 op_sel_hi:[0,0,0]" : "+v"(acc[ai][bj][m][n]) : "v"(cat8(Bt[n][0], Bt[n][1])), "v"(cat8(At[m][0], At[m][1])), "v"(fp8_scale)); } \
        else { _Pragma("unroll") for (int k = 0; k < 2; ++k) acc[ai][bj][m][n] = __builtin_amdgcn_mfma_f32_16x16x32_bf16(Bt[n][k], At[m][k], acc[ai][bj][m][n], 0, 0, 0); } } __builtin_amdgcn_s_setprio(0); } while (0)
#define PG8_WAIT_V(n) asm volatile("s_waitcnt vmcnt(" #n ")" ::: "memory")
#define PG8_WAIT_L(n) asm volatile("s_waitcnt lgkmcnt(" #n ")" ::: "memory")
#define PG8_BAR __builtin_amdgcn_s_barrier()
#define PG8_SCHED __builtin_amdgcn_sched_barrier(0)
    Unit cur, nxt; int ui = 0;
    if (!S.next(0, cur)) return;
    const int fp8_scale = 0x7d7d7d7d;
    (void)fp8_scale;
    f32x4 acc[2][2][4][2];
#pragma unroll
    for (int a = 0; a < 2; ++a)
#pragma unroll
        for (int b = 0; b < 2; ++b)
#pragma unroll
            for (int m = 0; m < 4; ++m)
#pragma unroll
                for (int n = 0; n < 2; ++n) acc[a][b][m][n] = (f32x4){0.f, 0.f, 0.f, 0.f};
    bf16x8 At[4][2], B0[2][2], B1[2][2];
    unsigned cA = g.offA + (unsigned)cur.pm * tstep, cB = g.offB + (unsigned)cur.pn * tstep;
    if constexpr (GA) { PG8_RI_DMA(0, cur.pm); asm volatile("s_waitcnt vmcnt(0)" ::: "memory"); PG8_BAR; PG8_RI_READ(vA, 0); asm volatile("s_waitcnt lgkmcnt(0)" ::: "memory"); }
    PG8_STAGE(PG8_SB(0, 0), cB, voffB); PG8_STAGE(PG8_SB(0, 1), cB + hstep, voffB);
    if constexpr (GA) { PG8_STAGE_GA(PG8_SA(0, 0), 0u, vA, 0); PG8_STAGE_GA(PG8_SA(0, 1), 0u, vA, 1); } else { PG8_STAGE(PG8_SA(0, 0), cA, voffA); PG8_STAGE(PG8_SA(0, 1), cA + hstep, voffA); }
    if (wr == 1) PG8_BAR;
    PG8_WAIT_V(2); PG8_BAR;
    PG8_STAGE(PG8_SB(1, 0), cB + kstep, voffB);
    if constexpr (GA) PG8_STAGE_GA(PG8_SA(1, 0), kstep, vA, 0); else PG8_STAGE(PG8_SA(1, 0), cA + kstep, voffA);
    PG8_STAGE(PG8_SB(1, 1), cB + hstep + kstep, voffB);
    PG8_WAIT_V(6); PG8_BAR;
    for (;;) {
        const bool has_next = S.next(ui + 1, nxt);
        const unsigned nA = has_next ? g.offA + (unsigned)nxt.pm * tstep : cA, nB = has_next ? g.offB + (unsigned)nxt.pn * tstep : cB;
        if constexpr (GA) { if (has_next) PG8_RI_DMA((ui + 1) & 1, nxt.pm); }
#pragma unroll 1
        for (int t = 0; t < nt; t += 2) {
            const bool last = (t == nt - 2);
            const unsigned a1 = cA + (unsigned)(t + 1) * kstep;
            const unsigned a2 = last ? nA : cA + (unsigned)(t + 2) * kstep, b2 = last ? nB : cB + (unsigned)(t + 2) * kstep;
            const unsigned a3 = a2 + kstep, b3 = b2 + kstep;
            unsigned k2 = (unsigned)(t + 2) * kstep;
            if constexpr (GA) { if (last) { k2 = 0u; if (has_next) PG8_RI_READ(vN, (ui + 1) & 1); else { _Pragma("unroll") for (int _h = 0; _h < 2; ++_h) _Pragma("unroll") for (int _i = 0; _i < 2; ++_i) vN[_h][_i] = vA[_h][_i]; } }
                                else { _Pragma("unroll") for (int _h = 0; _h < 2; ++_h) _Pragma("unroll") for (int _i = 0; _i < 2; ++_i) vN[_h][_i] = vA[_h][_i]; } }
            PG8_LDB(B0, 0, 0); PG8_LDB(B1, 0, 1); PG8_SCHED; PG8_LDA(At, 0, 0);
            if constexpr (GA) PG8_STAGE_GA(PG8_SA(1, 1), (unsigned)(t + 1) * kstep, vA, 1); else PG8_STAGE(PG8_SA(1, 1), a1 + hstep, voffA);
            PG8_WAIT_V(8); PG8_WAIT_L(0); PG8_BAR; PG8_MMA(0, 0, At, B0); PG8_MMA(0, 1, At, B1); PG8_BAR; PG8_SCHED;
            PG8_LDA(At, 0, 1); PG8_STAGE(PG8_SB(0, 0), b2, voffB); PG8_STAGE(PG8_SB(0, 1), b2 + hstep, voffB);
            if constexpr (GA) PG8_STAGE_GA(PG8_SA(0, 0), k2, vN, 0); else PG8_STAGE(PG8_SA(0, 0), a2, voffA);
            PG8_WAIT_V(8); PG8_WAIT_L(0); PG8_BAR; PG8_MMA(1, 0, At, B0); PG8_MMA(1, 1, At, B1); PG8_BAR; PG8_SCHED;
            PG8_LDB(B0, 1, 0); PG8_LDB(B1, 1, 1); PG8_SCHED; PG8_LDA(At, 1, 0);
            if constexpr (GA) PG8_STAGE_GA(PG8_SA(0, 1), k2, vN, 1); else PG8_STAGE(PG8_SA(0, 1), a2 + hstep, voffA);
            PG8_WAIT_V(8); PG8_WAIT_L(0); PG8_BAR; PG8_MMA(0, 0, At, B0); PG8_MMA(0, 1, At, B1); PG8_BAR; PG8_SCHED;
            PG8_LDA(At, 1, 1); PG8_STAGE(PG8_SB(1, 0), b3, voffB); PG8_STAGE(PG8_SB(1, 1), b3 + hstep, voffB);
            if constexpr (GA) PG8_STAGE_GA(PG8_SA(1, 0), k2 + kstep, vN, 0); else PG8_STAGE(PG8_SA(1, 0), a3, voffA);
            PG8_WAIT_V(8); PG8_WAIT_L(0); PG8_BAR; PG8_MMA(1, 0, At, B0); PG8_MMA(1, 1, At, B1); PG8_BAR; PG8_SCHED;
        }
        if constexpr (GA) { _Pragma("unroll") for (int _h = 0; _h < 2; ++_h) _Pragma("unroll") for (int _i = 0; _i < 2; ++_i) vA[_h][_i] = vN[_h][_i]; }
        if (wr == 0) PG8_BAR;
        if constexpr (FP8) asm volatile("s_nop 15\n\ts_nop 15\n\ts_nop 15" ::: "memory");
        E(acc, cur, wr, wc, fr, fq);
        if (!has_next) break;
#pragma unroll
        for (int a = 0; a < 2; ++a)
#pragma unroll
            for (int b = 0; b < 2; ++b)
#pragma unroll
                for (int m = 0; m < 4; ++m)
#pragma unroll
                    for (int n = 0; n < 2; ++n) acc[a][b][m][n] = (f32x4){0.f, 0.f, 0.f, 0.f};
        cur = nxt; cA = nA; cB = nB; ++ui;
        if (wr == 1) PG8_BAR;
    }
    PG8_WAIT_V(0);
    PG8_BAR;
#undef PG8_SA
#undef PG8_SB
#undef PG8_STAGE
#undef PG8_STAGE_GA
#undef PG8_RI_DMA
#undef PG8_RI_READ
#undef PG8_LDA
#undef PG8_LDB
#undef PG8_MMA
#undef PG8_WAIT_V
#undef PG8_WAIT_L
#undef PG8_BAR
#undef PG8_SCHED
}
}

typedef f32x4 AccT[2][2][4][2];

__device__ __forceinline__ f32x2 gelu_pk(f32x2 v) {
    const f32x2 av = __builtin_elementwise_abs(v), d = av * 0.2316418882f + 1.0f;
    f32x2 t; t.x = __builtin_amdgcn_rcpf(d.x); t.y = __builtin_amdgcn_rcpf(d.y);
    f32x2 q = t * 0.5307027145f + (-0.7265760135f); q = q * t + 0.7107068705f; q = q * t + (-0.142248368f); q = q * t + 0.127414796f; q = q * t;
    const f32x2 s = (v * v) * (-0.72134752044f);
    f32x2 e; e.x = __builtin_amdgcn_exp2f(s.x); e.y = __builtin_amdgcn_exp2f(s.y);
    const f32x2 m = v * (q * e), r = v - m;
    f32x2 o; o.x = v.x < 0.f ? m.x : r.x; o.y = v.y < 0.f ? m.y : r.y; return o;
}
__device__ __forceinline__ float gelu1(float x) { f32x2 r = gelu_pk((f32x2){x, x}); return r.x; }
__device__ __forceinline__ u32x4 pack8(const f32x4 a, const f32x4 b) { u32x4 w; w.x = pk2(a[0], a[1]); w.y = pk2(a[2], a[3]); w.z = pk2(b[0], b[1]); w.w = pk2(b[2], b[3]); return w; }

constexpr float SWI_GATE = -1.44269504089f, SWI_UP = -0.69314718056f;
constexpr float QSCALE = 0.125f * 1.44269504089f;

struct EpiInproj {
    static constexpr bool PERM = true;
    bf16_t *QA, *KA, *VAT, *IQ, *IK; float* IW; bf16_t *HQ, *HKK, *HI, *HG; float* HLF; bf16_t *GU, *GV;
    const float* CS; const int* pos; const float* lb; unsigned* kmax; bool has_lb;
    __device__ __forceinline__ void operator()(const AccT& acc, const pg8::Unit& u, int wr, int wc, int fr, int fq) const {
        const int row0 = u.pm * 256 + wr * 64 + fr, pn = u.pn;
        if (pn < 4) {
            float kmx = 0.f;
            const bool plain_v = (pn == 1 && wc == 3), iw_pad = (pn == 3 && wc >= 1);
#pragma unroll
            for (int ai = 0; ai < 2; ++ai) {
                asm volatile("" ::: "memory"); __builtin_amdgcn_sched_barrier(0);
                if (plain_v) {
#pragma unroll
                    for (int m = 0; m < 4; ++m) { const int row = row0 + ai * 128 + m * 16;
                        const f32x4 x1a = acc[ai][0][m][0], x1b = acc[ai][0][m][1], x2a = acc[ai][1][m][0], x2b = acc[ai][1][m][1];
                        const int b = row >> 11, s = row & 2047; bf16_t* vp = VAT + ((size_t)b * 64) * 2048 + s;
#pragma unroll
                        for (int j = 0; j < 4; ++j) { vp[(size_t)(8 * fq + j) * 2048] = (bf16_t)f2bf(x1a[j]); vp[(size_t)(8 * fq + 4 + j) * 2048] = (bf16_t)f2bf(x1b[j]);
                            vp[(size_t)(32 + 8 * fq + j) * 2048] = (bf16_t)f2bf(x2a[j]); vp[(size_t)(32 + 8 * fq + 4 + j) * 2048] = (bf16_t)f2bf(x2b[j]); } }
                } else if (iw_pad) {
                    if (wc == 1 && fq == 0) {
#pragma unroll
                        for (int m = 0; m < 4; ++m) *(f32x4*)(IW + (size_t)(row0 + ai * 128 + m * 16) * 4) = acc[ai][0][m][0]; }
                } else {
#pragma unroll
                    for (int mh = 0; mh < 2; ++mh) {
                    if (mh) { asm volatile("" ::: "memory"); __builtin_amdgcn_sched_barrier(0); }
                    int pp[2]; f32x4 cs4[2][4];
#pragma unroll
                    for (int m2 = 0; m2 < 2; ++m2) pp[m2] = pos[row0 + ai * 128 + (2 * mh + m2) * 16];
#pragma unroll
                    for (int m2 = 0; m2 < 2; ++m2) { const float* cs = CS + (size_t)pp[m2] * 64 + 8 * fq; cs4[m2][0] = *(const f32x4*)cs; cs4[m2][1] = *(const f32x4*)(cs + 4); cs4[m2][2] = *(const f32x4*)(cs + 32); cs4[m2][3] = *(const f32x4*)(cs + 36); }
#pragma unroll
                    for (int m2 = 0; m2 < 2; ++m2) {
                        const int m = 2 * mh + m2;
                        const int row = row0 + ai * 128 + m * 16;
                        const f32x4 x1a = acc[ai][0][m][0], x1b = acc[ai][0][m][1], x2a = acc[ai][1][m][0], x2b = acc[ai][1][m][1];
                        const f32x4 ca = cs4[m2][0], cb = cs4[m2][1], sa = cs4[m2][2], sb = cs4[m2][3];
                        f32x4 o1a = x1a * ca - x2a * sa, o1b = x1b * cb - x2b * sb, o2a = x2a * ca + x1a * sa, o2b = x2b * cb + x1b * sb;
                        bf16_t* dst;
                        if (pn == 0) { dst = QA + ((size_t)row * 6 + wc) * 64; o1a *= QSCALE; o1b *= QSCALE; o2a *= QSCALE; o2b *= QSCALE; }
                        else if (pn == 1) { if (wc < 2) { dst = QA + ((size_t)row * 6 + 4 + wc) * 64; o1a *= QSCALE; o1b *= QSCALE; o2a *= QSCALE; o2b *= QSCALE; }
                            else { dst = KA + (size_t)row * 64;
                                float ss = 0.f;
#pragma unroll
                                for (int j = 0; j < 4; ++j) ss += o1a[j] * o1a[j] + o1b[j] * o1b[j] + o2a[j] * o2a[j] + o2b[j] * o2b[j];
                                ss += __shfl_xor(ss, 16); ss += __shfl_xor(ss, 32); kmx = fmaxf(kmx, ss); } }
                        else if (pn == 2) dst = IQ + ((size_t)row * 4 + wc) * 64;
                        else dst = IK + (size_t)row * 64;
                        *(u32x4*)(dst + 8 * fq) = pack8(o1a, o1b);
                        *(u32x4*)(dst + 32 + 8 * fq) = pack8(o2a, o2b);
                    }
                    }
                }
            }
            if (pn == 1 && wc == 2) {
#pragma unroll
                for (int o = 1; o < 16; o <<= 1) kmx = fmaxf(kmx, __shfl_xor(kmx, o));
                if ((threadIdx.x & 63) == 0) atomicMax(kmax + (row0 >> 11), __builtin_bit_cast(unsigned, kmx));
            }
        } else if (pn < 10) {
            const int h = pn - 4; const int dq = 32 * (wc & 1) + 8 * fq;
            f32x4 lba, lbb;
            if (wc >= 2) { lba = *(const f32x4*)(lb + h * 64 + dq); lbb = *(const f32x4*)(lb + h * 64 + dq + 4); }
#pragma unroll
            for (int ai = 0; ai < 2; ++ai)
#pragma unroll
                for (int m = 0; m < 4; ++m) {
                    asm volatile("" ::: "memory"); __builtin_amdgcn_sched_barrier(0);
                    const int row = row0 + ai * 128 + m * 16; const size_t o = ((size_t)row * 6 + h) * 64 + dq;
                    if (wc < 2) {
                        *(u32x4*)(HQ + o) = pack8(acc[ai][0][m][0], acc[ai][0][m][1]);
                        *(u32x4*)(HI + o) = pack8(acc[ai][1][m][0], acc[ai][1][m][1]);
                    } else {
                        f32x4 lf[2], kk[2], sg[2];
#pragma unroll
                        for (int n = 0; n < 2; ++n)
#pragma unroll
                            for (int j = 0; j < 4; ++j) {
                                const float z = acc[ai][0][m][n][j], lbv = n ? lbb[j] : lba[j];
                                const float ls = fminf(z, 0.f) - fast_log(1.f + fast_exp(-fabsf(z)));
                                lf[n][j] = ls; if (has_lb) lf[n][j] = (lbv > 0.f) ? fast_log(lbv + (1.f - lbv) * fast_exp(ls)) : ls;
                                kk[n][j] = (1.f - lbv) * fast_exp(ls - z);
                                const float gg = acc[ai][1][m][n][j]; sg[n][j] = gg * sigmoidf(gg);
                            }
                        *(f32x4*)(HLF + o) = lf[0]; *(f32x4*)(HLF + o + 4) = lf[1];
                        *(u32x4*)(HKK + o) = pack8(kk[0], kk[1]);
                        *(u32x4*)(HG + o) = pack8(sg[0], sg[1]);
                    }
                }
        } else {
            bf16_t* dstb = (pn == 10) ? GU : GV;
#pragma unroll
            for (int ai = 0; ai < 2; ++ai)
#pragma unroll
                for (int m = 0; m < 4; ++m) {
                    asm volatile("" ::: "memory"); __builtin_amdgcn_sched_barrier(0);
                    const int row = row0 + ai * 128 + m * 16;
#pragma unroll
                    for (int bj = 0; bj < 2; ++bj) {
                        const f32x4 v0 = acc[ai][bj][m][0], v1 = acc[ai][bj][m][1];
                        const f32x2 a = gelu_pk((f32x2){v0[0], v0[1]}), b = gelu_pk((f32x2){v0[2], v0[3]}), c = gelu_pk((f32x2){v1[0], v1[1]}), d = gelu_pk((f32x2){v1[2], v1[3]});
                        u32x4 w; w.x = pk2(a.x, a.y); w.y = pk2(b.x, b.y); w.z = pk2(c.x, c.y); w.w = pk2(d.x, d.y);
                        *(u32x4*)(dstb + (size_t)row * 256 + bj * 128 + wc * 32 + 8 * fq) = w;
                    }
                }
        }
    }
};

__device__ __forceinline__ void unpack8(const u32x4 w, f32x4& a, f32x4& b) {
    a[0] = __builtin_bit_cast(float, w[0] << 16); a[1] = __builtin_bit_cast(float, w[0] & 0xffff0000u); a[2] = __builtin_bit_cast(float, w[1] << 16); a[3] = __builtin_bit_cast(float, w[1] & 0xffff0000u);
    b[0] = __builtin_bit_cast(float, w[2] << 16); b[1] = __builtin_bit_cast(float, w[2] & 0xffff0000u); b[2] = __builtin_bit_cast(float, w[3] << 16); b[3] = __builtin_bit_cast(float, w[3] & 0xffff0000u);
}
template <bool XF32>
struct EpiResid {
    static constexpr bool PERM = true;
    const float* xin32; bf16_t* xr; const float* gate;
    __device__ __forceinline__ void operator()(const AccT& acc, const pg8::Unit& u, int wr, int wc, int fr, int fq) const {
        const int row0 = u.pm * 256 + wr * 64 + fr, col0 = u.pn * 256 + wc * 32 + 8 * fq;
        const float* gp = gate + (size_t)(row0 >> 11) * 6144 + col0;
        f32x4 gv[2][2];
#pragma unroll
        for (int bj = 0; bj < 2; ++bj)
#pragma unroll
            for (int n = 0; n < 2; ++n) gv[bj][n] = *(const f32x4*)(gp + bj * 128 + 4 * n);
#pragma unroll
        for (int ai = 0; ai < 2; ++ai) {
            if constexpr (XF32) {
                asm volatile("" ::: "memory"); __builtin_amdgcn_sched_barrier(0);
                f32x4 xv[4][2][2];
#pragma unroll
                for (int m = 0; m < 4; ++m) { const size_t o = (size_t)(row0 + ai * 128 + m * 16) * DM + col0;
#pragma unroll
                    for (int bj = 0; bj < 2; ++bj)
#pragma unroll
                        for (int n = 0; n < 2; ++n) xv[m][bj][n] = *(const f32x4*)(xin32 + o + bj * 128 + 4 * n); }
#pragma unroll
                for (int m = 0; m < 4; ++m) { const size_t o = (size_t)(row0 + ai * 128 + m * 16) * DM + col0;
#pragma unroll
                    for (int bj = 0; bj < 2; ++bj) *(u32x4*)(xr + o + bj * 128) = pack8(xv[m][bj][0] + gv[bj][0] * acc[ai][bj][m][0], xv[m][bj][1] + gv[bj][1] * acc[ai][bj][m][1]); }
            } else {
                asm volatile("" ::: "memory"); __builtin_amdgcn_sched_barrier(0);
                u32x4 raw[4][2];
#pragma unroll
                for (int m = 0; m < 4; ++m) { const size_t o = (size_t)(row0 + ai * 128 + m * 16) * DM + col0;
#pragma unroll
                    for (int bj = 0; bj < 2; ++bj) raw[m][bj] = *(const u32x4*)(xr + o + bj * 128); }
#pragma unroll
                for (int m = 0; m < 4; ++m) { const size_t o = (size_t)(row0 + ai * 128 + m * 16) * DM + col0;
#pragma unroll
                    for (int bj = 0; bj < 2; ++bj) { f32x4 xa, xb; unpack8(raw[m][bj], xa, xb); *(u32x4*)(xr + o + bj * 128) = pack8(xa + gv[bj][0] * acc[ai][bj][m][0], xb + gv[bj][1] * acc[ai][bj][m][1]); } }
            }
        }
    }
};

struct EpiSwiglu {
    static constexpr bool PERM = true;
    unsigned char* O; int ldo; int nNl;
    __device__ __forceinline__ void operator()(const AccT& acc, const pg8::Unit& u, int wr, int wc, int fr, int fq) const {
        const int row0 = u.pm * 256 + wr * 64 + fr, pnl = u.pn % nNl, col0 = pnl * 128 + wc * 32 + 8 * fq;
#pragma unroll
        for (int ai = 0; ai < 2; ++ai)
#pragma unroll
            for (int m = 0; m < 4; ++m) {
                asm volatile("" ::: "memory"); __builtin_amdgcn_sched_barrier(0);
                f32x4 r[2];
#pragma unroll
                for (int n = 0; n < 2; ++n)
#pragma unroll
                    for (int j = 0; j < 4; ++j) { const float g = acc[ai][0][m][n][j]; r[n][j] = g * acc[ai][1][m][n][j] * __builtin_amdgcn_rcpf(1.f + __builtin_amdgcn_exp2f(g)); }
                u32x2 w; w[0] = pk4_fp8(r[0][0], r[0][1], r[0][2], r[0][3]); w[1] = pk4_fp8(r[1][0], r[1][1], r[1][2], r[1][3]);
                *(u32x2*)(O + (size_t)(row0 + ai * 128 + m * 16) * ldo + col0) = w;
            }
    }
};

struct EpiMoeDown {
    static constexpr bool PERM = true;
    bf16_t* Y0; bf16_t* Y1;
    __device__ __forceinline__ void operator()(const AccT& acc, const pg8::Unit& u, int wr, int wc, int fr, int fq) const {
        const int k = (u.pm >= HSROWS / 256) ? 1 : 0;
        const int row0 = (u.pm - k * (HSROWS / 256)) * 256 + wr * 64 + fr, col0 = (u.pn & 3) * 256 + wc * 32 + 8 * fq;
        bf16_t* Y = k ? Y1 : Y0;
#pragma unroll
        for (int ai = 0; ai < 2; ++ai)
#pragma unroll
            for (int m = 0; m < 4; ++m) { bf16_t* op = Y + (size_t)(row0 + ai * 128 + m * 16) * DM + col0;
#pragma unroll
                for (int bj = 0; bj < 2; ++bj) *(u32x4*)(op + bj * 128) = pack8(acc[ai][bj][m][0], acc[ai][bj][m][1]); }
    }
};

#define XB_TMO      128
#define XB_XCNT(j)  (256  + 64 * (j))
#define XB_XSUB(j)  (1280 + 64 * (j))
#define XB_XGEN(j)  (2304 + 64 * (j))
#define XB_TOP      3328
#define XB_TOPGEN   3392
#define XCD_BAR_WORDS 3456
#define XB_SPIN_CAP (1u << 18)
__device__ __forceinline__ unsigned xb_ld(unsigned* p)              { return __hip_atomic_load(p, __ATOMIC_RELAXED, __HIP_MEMORY_SCOPE_AGENT); }
__device__ __forceinline__ unsigned xb_add(unsigned* p, unsigned v) { return __hip_atomic_fetch_add(p, v, __ATOMIC_RELAXED, __HIP_MEMORY_SCOPE_AGENT); }
__device__ __forceinline__ unsigned xb_xcc_id() { return (unsigned)__builtin_amdgcn_s_getreg((3 << 11) | 20) & 0xFu; }
#define XB_SPIN(cond, bar) do { unsigned _sp = 0; while (cond) { __builtin_amdgcn_s_sleep(1); \
    if ((++_sp & 255u) == 0u) { if (xb_ld(&(bar)[XB_TMO])) break; if (_sp > XB_SPIN_CAP) { atomicAdd(&(bar)[XB_TMO], 1u); break; } } } } while (0)
struct XcdBarrier { unsigned* bar; unsigned x; volatile LAS unsigned* st; };
__device__ __forceinline__ XcdBarrier xcd_barrier_post(unsigned* bar, volatile LAS unsigned* st) {
    XcdBarrier b; b.bar = bar; b.x = xb_xcc_id(); b.st = st;
    if (threadIdx.x == 0) (void)xb_add(&bar[XB_XCNT(b.x)], 1u);
    return b;
}
__device__ __forceinline__ void xcd_barrier_complete(unsigned* bar, unsigned x, unsigned& nloc, unsigned& nx) {
    const unsigned G = gridDim.x * gridDim.y * gridDim.z;
    unsigned sum, cnt, mine, sp = 0u;
    for (;;) {
        sum = 0u; cnt = 0u; mine = 0u;
#pragma unroll
        for (unsigned j = 0; j < 16; ++j) { const unsigned c = xb_ld(&bar[XB_XCNT(j)]); sum += c; cnt += (c > 0u) ? 1u : 0u; mine = (j == x) ? c : mine; }
        if (sum == G) break;
        __builtin_amdgcn_s_sleep(1);
        if ((++sp & 255u) == 0u) { if (xb_ld(&bar[XB_TMO])) break; if (sp > XB_SPIN_CAP) { atomicAdd(&bar[XB_TMO], 1u); break; } }
    }
    nloc = mine > 0u ? mine : 1u; nx = cnt > 0u ? cnt : 1u;
}
__device__ __forceinline__ void xcd_barrier(const XcdBarrier& b) {
    asm volatile("s_waitcnt vmcnt(0)" ::: "memory");
    __syncthreads();
    if (threadIdx.x == 0) {
        unsigned* bar = b.bar;
        __builtin_amdgcn_s_waitcnt(0);
        unsigned nloc = b.st[0], nx = b.st[1];
        if (nloc == 0u) { xcd_barrier_complete(bar, b.x, nloc, nx); b.st[0] = nloc; b.st[1] = nx; }
        const unsigned old = xb_add(&bar[XB_XSUB(b.x)], 1u);
        const unsigned gen = old / nloc;
        if (old + 1u == (gen + 1u) * nloc) {
            __builtin_amdgcn_fence(__ATOMIC_RELEASE, "agent");
            asm volatile("s_waitcnt vmcnt(0)" ::: "memory");
            const unsigned og = xb_add(&bar[XB_TOP], 1u);
            const unsigned tg = og / nx;
            if (og + 1u == (tg + 1u) * nx) xb_add(&bar[XB_TOPGEN], 1u);
            else XB_SPIN(xb_ld(&bar[XB_TOPGEN]) == tg, bar);
            __builtin_amdgcn_fence(__ATOMIC_ACQUIRE, "agent");
            xb_add(&bar[XB_XGEN(b.x)], 1u);
            asm volatile("s_waitcnt vmcnt(0)" ::: "memory");
        } else {
            XB_SPIN(xb_ld(&bar[XB_XGEN(b.x)]) == gen, bar);
            __builtin_amdgcn_fence(__ATOMIC_ACQUIRE, "agent");
            asm volatile("s_waitcnt vmcnt(0)" ::: "memory");
        }
    }
    __syncthreads();
}

struct Args { const float* in[23]; float* out; unsigned char* ws; int ph_lo, ph_hi; };
typedef const __attribute__((address_space(4))) Args* KArgs;
__device__ __forceinline__ KArgs kargs() { auto p = __builtin_amdgcn_kernarg_segment_ptr(); asm volatile("" : "+s"(p)); return (KArgs)p; }
__device__ __forceinline__ unsigned char* launder(unsigned char* p) { GAS unsigned char* g = (GAS unsigned char*)p; asm volatile("" : "+s"(g)); return (unsigned char*)g; }
#define GIN(p) ((const float*)(const GAS float*)(p))
enum { I_X = 0, I_C, I_POS, I_WADA, I_BADA, I_GMIX, I_GFFN, I_WIN, I_WOUT, I_LBL, I_ONORM, I_VNG, I_VNB, I_GWS, I_GBS, I_FG, I_FU, I_FD, I_MR, I_MG, I_MU, I_MD, I_GFIN };

__device__ __forceinline__ int opaque_tid() { int t = threadIdx.x; asm volatile("" : "+v"(t)); return t; }
__device__ __forceinline__ int q_next(unsigned* ctr, volatile LAS int* slot) {
    __syncthreads();
    if (threadIdx.x == 0) *slot = (int)__hip_atomic_fetch_add(ctr, 1u, RLX_AGENT);
    __syncthreads();
    return *slot;
}

__device__ __forceinline__ int q_next_xcd(unsigned* ctr8, unsigned per, unsigned x, volatile LAS int* slot) {
    __syncthreads();
    if (threadIdx.x == 0) { int r = -1;
        for (unsigned k = 0; k < 8u; ++k) { const unsigned xx = (x + k) & 7u; const unsigned i = __hip_atomic_fetch_add(ctr8 + 64 * xx, 1u, RLX_AGENT); if (i < per) { r = (int)(xx * per + i); break; } }
        *slot = r; }
    __syncthreads();
    return *slot;
}

template <bool FP8, class F>
__device__ __forceinline__ void p0_transpose_item(const float* W, int K, int Nsrc, void* WTv, LAS float* scr, int kb, int nb, int lane, F srccol, float ws16 = 16.f) {
    const int k0 = 64 * kb, n0 = 64 * nb; const int sc = srccol(n0 + lane);
    {
        float wv[64]; const float* wp = W + (size_t)k0 * Nsrc + (sc >= 0 ? sc : 0);
#pragma unroll
        for (int kk = 0; kk < 64; ++kk) wv[kk] = wp[(size_t)kk * Nsrc];
#pragma unroll
        for (int kk = 0; kk < 64; ++kk) scr[kk * 65 + lane] = (sc >= 0) ? wv[kk] : 0.f;
    }
    asm volatile("s_waitcnt lgkmcnt(0)" ::: "memory");
    const int c = lane & 7;
#pragma unroll
    for (int j = 0; j < 8; ++j) { const int n = (lane >> 3) + 8 * j; const LAS float* s = scr + (8 * c) * 65 + n;
        if constexpr (FP8) { u32x2 o; o[0] = pk4_fp8(ws16 * s[0 * 65], ws16 * s[1 * 65], ws16 * s[2 * 65], ws16 * s[3 * 65]); o[1] = pk4_fp8(ws16 * s[4 * 65], ws16 * s[5 * 65], ws16 * s[6 * 65], ws16 * s[7 * 65]);
            *(u32x2*)((unsigned char*)WTv + (size_t)(n0 + n) * K + k0 + 8 * c) = o; }
        else { u32x4 o; o.x = pk2(s[0 * 65], s[1 * 65]); o.y = pk2(s[2 * 65], s[3 * 65]); o.z = pk2(s[4 * 65], s[5 * 65]); o.w = pk2(s[6 * 65], s[7 * 65]);
            *(u32x4*)((bf16_t*)WTv + (size_t)(n0 + n) * K + k0 + 8 * c) = o; } }
    asm volatile("s_waitcnt lgkmcnt(0)" ::: "memory");
}
__device__ __forceinline__ void p0_wg_item(const float* sp, int Nsrc, unsigned char* drow, size_t pitch, float scale, LAS unsigned char* buf, int lane, int wave) {
    f32x4 v[16];
#pragma unroll
    for (int kk = 0; kk < 16; ++kk) v[kk] = *(const f32x4*)(sp + (size_t)kk * Nsrc);
#pragma unroll
    for (int e = 0; e < 4; ++e) { u32x4 o;
#pragma unroll
        for (int w = 0; w < 4; ++w) o[w] = pk4_fp8(scale * v[4 * w][e], scale * v[4 * w + 1][e], scale * v[4 * w + 2][e], scale * v[4 * w + 3][e]);
        *(LAS u32x4*)(buf + (64 * e + lane) * 144 + 16 * wave) = o; }
    __syncthreads();
    const int j = lane & 7, rr = lane >> 3;
#pragma unroll
    for (int i = 0; i < 4; ++i) { const int p = 32 * wave + 8 * i + rr; const u32x4 o = *(const LAS u32x4*)(buf + p * 144 + 16 * j);
        *(u32x4*)(drow + (size_t)(4 * (p & 63) + (p >> 6)) * pitch + 16 * j) = o; }
}
__device__ __forceinline__ int inproj_srccol(int n) {
    const int t = n >> 8, c = n & 255;
    if (t < 4) { const int half = c >> 7, hh = (c >> 5) & 3, dd = c & 31; const int s = 256 * t + 64 * hh + 32 * half + dd; return (t == 3 && s >= 836) ? -1 : s; }
    if (t < 10) { const int seg = c >> 6, dd = c & 63; return 836 + 384 * seg + 64 * (t - 4) + dd; }
    return 2372 + 256 * (t - 10) + c;
}
__constant__ float ROPE_INV[32] = {1.000000000e+00f, 7.498942018e-01f, 5.623413324e-01f, 4.216965139e-01f, 3.162277639e-01f, 2.371373773e-01f, 1.778279394e-01f, 1.333521456e-01f, 1.000000015e-01f, 7.498942316e-02f, 5.623413250e-02f, 4.216964915e-02f, 3.162277490e-02f, 2.371373773e-02f, 1.778279431e-02f, 1.333521400e-02f, 9.999999776e-03f, 7.498942316e-03f, 5.623413250e-03f, 4.216964822e-03f, 3.162277630e-03f, 2.371373819e-03f, 1.778279431e-03f, 1.333521446e-03f, 1.000000047e-03f, 7.498941850e-04f, 5.623413017e-04f, 4.216965172e-04f, 3.162277571e-04f, 2.371373703e-04f, 1.778279402e-04f, 1.333521504e-04f};

__device__ __forceinline__ void p0_prologue(KArgs Ap, LAS unsigned char* lds, int vcu, int G) {
#define A (*Ap)
    const int tid = opaque_tid0(), lane = tid & 63, wave = __builtin_amdgcn_readfirstlane(tid >> 6);
    unsigned char* ws = launder(A.ws);
    const int gt = vcu * NTHR + tid, NGT = G * NTHR;
    {
        float* CS = (float*)(ws + WS_CS);
        for (int e = gt; e < 6144 * 32; e += NGT) {
            const int p = e >> 5, i = e & 31; const float a = (float)p * ROPE_INV[i];
            const double ad = (double)a; const double kq = __builtin_rint(ad * 0.63661977236758134308); const float y = (float)(ad - kq * 1.57079632679489661923);
            const int q = ((int)kq) & 3; const float y2 = y * y;
            const float sn = y + y * y2 * (-1.6666654611e-1f + y2 * (8.3321608736e-3f + y2 * (-1.9515295891e-4f)));
            const float cn = 1.f - 0.5f * y2 + y2 * y2 * (4.166664568298827e-2f + y2 * (-1.388731625493765e-3f + y2 * 2.443315711809948e-5f));
            const float s = (q == 0) ? sn : (q == 1) ? cn : (q == 2) ? -sn : -cn;
            const float c = (q == 0) ? cn : (q == 1) ? -sn : (q == 2) ? -cn : sn;
            CS[(size_t)p * 64 + i] = c; CS[(size_t)p * 64 + 32 + i] = s;
        }
        float* LB = (float*)(ws + WS_LB);
        for (int e = gt; e < 2 * 384; e += NGT) { const int l = e / 384, j = e % 384; const float l0 = GIN(A.in[I_LBL])[j], l1 = GIN(A.in[I_LBL])[384 + j];
            LB[e] = (l == 0) ? 0.f : 1.f / (1.f + expf(l0 - l1)); }
        bf16_t* GW = (bf16_t*)(ws + WS_GW);
        for (int e = gt; e < 2 * 4 * 128 * 128; e += NGT) { const int s = e & 127, t = (e >> 7) & 127; GW[e] = (bf16_t)((s <= t) ? f2bf(GIN(A.in[I_GWS])[e]) : 0u); }
    }
    if (vcu < 192) {
        LAS float* sc = (LAS float*)lds;
        {
            f32x4 cv[16];
#pragma unroll
            for (int i = 0; i < 16; ++i) cv[i] = *(const f32x4*)(GIN(A.in[I_C]) + 4 * (tid + NTHR * i));
#pragma unroll
            for (int i = 0; i < 16; ++i) { f32x4 o;
#pragma unroll
                for (int j = 0; j < 4; ++j) o[j] = cv[i][j] * sigmoidf(cv[i][j]);
                *(LAS f32x4*)(sc + 4 * (tid + NTHR * i)) = o; }
        }
        __syncthreads();
        const int l = vcu / 96, n0 = (vcu % 96) * 64, n = n0 + lane;
        const float* W = GIN(A.in[I_WADA]) + (size_t)l * DM * 6144;
        float acc[32];
#pragma unroll
        for (int b = 0; b < 32; ++b) acc[b] = 0.f;
        {
            const float* wp = W + (size_t)(wave * 128) * 6144 + n;
            float nx[16];
#pragma unroll
            for (int i = 0; i < 16; ++i) nx[i] = wp[(size_t)i * 6144];
#pragma unroll
            for (int i = 0; i < 16; ++i) asm volatile("" : "+v"(nx[i]));
#pragma unroll 1
            for (int k0 = 0; k0 < 128; k0 += 16) {
                float cw[16];
#pragma unroll
                for (int i = 0; i < 16; ++i) cw[i] = nx[i];
                const float* wn = wp + (size_t)((k0 + 16 < 128) ? k0 + 16 : k0) * 6144;
#pragma unroll
                for (int i = 0; i < 16; ++i) nx[i] = wn[(size_t)i * 6144];
                __builtin_amdgcn_sched_barrier(0);
#pragma unroll
                for (int b = 0; b < 32; ++b) { const LAS f32x4* sp = (const LAS f32x4*)(sc + b * DM + wave * 128 + k0); float a = acc[b];
#pragma unroll
                    for (int q = 0; q < 4; ++q) { const f32x4 s4 = sp[q]; a = __builtin_fmaf(s4[0], cw[4 * q], a); a = __builtin_fmaf(s4[1], cw[4 * q + 1], a); a = __builtin_fmaf(s4[2], cw[4 * q + 2], a); a = __builtin_fmaf(s4[3], cw[4 * q + 3], a); }
                    asm volatile("" : "+v"(a));
                    acc[b] = a; }
#pragma unroll
                for (int i = 0; i < 16; ++i) asm volatile("" : "+v"(nx[i]));
            }
        }
        __syncthreads();
        LAS float* red = (LAS float*)lds;
#pragma unroll
        for (int b = 0; b < 32; ++b) red[(wave * 32 + b) * 64 + lane] = acc[b];
        __syncthreads();
        float* MOD = (float*)(ws + WS_MOD);
        for (int e = tid; e < 32 * 64; e += NTHR) { const int b = e >> 6, j = e & 63; float s = 0.f;
#pragma unroll
            for (int w = 0; w < 8; ++w) s += red[(w * 32 + b) * 64 + j];
            MOD[((size_t)l * 32 + b) * 6144 + n0 + j] = s + GIN(A.in[I_BADA])[l * 6144 + n0 + j]; }
        __syncthreads();
    }
    LAS float* scr = (LAS float*)(lds + wave * 16640);
    const int gw = vcu * NWAVES + wave, NGW = G * NWAVES;
    constexpr int I_IN = 16 * 48, I_OUT = 16 * 16, NWITEMS = 2 * I_IN + 2 * I_OUT;
    for (int it = gw; it < NWITEMS; it += NGW) {
        int r = it;
        if (r < 2 * I_IN) { const int l = r / I_IN; r %= I_IN;
            p0_transpose_item<false>(GIN(A.in[I_WIN]) + (size_t)l * DM * INSRC, DM, INSRC, (bf16_t*)(ws + WS_WIN) + (size_t)l * NIN * DM, scr, r / 48, r % 48, lane, [](int n) { return inproj_srccol(n); }); continue; }
        r -= 2 * I_IN;
        { const int l = r / I_OUT; r %= I_OUT;
            p0_transpose_item<false>(GIN(A.in[I_WOUT]) + (size_t)l * DM * DM, DM, DM, (bf16_t*)(ws + WS_WOUT) + (size_t)l * DM * DM, scr, r / 16, r % 16, lane, [](int n) { return n; }); }
    }
    __syncthreads();
    constexpr int G_F1 = 8 * 22, G_F2 = 22 * 4, G_M1 = 8 * 28, G_M2 = 28 * 4, NGITEMS = G_F1 + G_F2 + 8 * G_M1 + 8 * G_M2;
    const int half = lane >> 5, q32 = lane & 31; int par = 0;
    for (int wi = vcu; wi < NGITEMS; wi += G, par ^= 1) {
        LAS unsigned char* buf = lds + par * 36864;
        int r = wi;
        if (r < G_F1) { const int kb = r % 8, nt = r / 8; const float* src = half ? GIN(A.in[I_FU]) : GIN(A.in[I_FG]);
            p0_wg_item(src + (size_t)(128 * kb + 16 * wave) * FD + 128 * nt + 4 * q32, FD, ws + WS_WF1 + (size_t)(256 * nt) * DM + 128 * kb, (size_t)DM, half ? 16.f * SWI_UP : 16.f * SWI_GATE, buf, lane, wave); continue; }
        r -= G_F1;
        if (r < G_F2) { const int kb = r % 22, nt = r / 22;
            p0_wg_item(GIN(A.in[I_FD]) + (size_t)(128 * kb + 16 * wave) * DM + 256 * nt + 4 * lane, DM, ws + WS_WF2 + (size_t)(256 * nt) * FD + 128 * kb, (size_t)FD, 16.f, buf, lane, wave); continue; }
        r -= G_F2;
        if (r < 8 * G_M1) { const int e = r / G_M1; r %= G_M1; const int kb = r % 8, nt = r / 8; const float* src = (half ? GIN(A.in[I_MU]) : GIN(A.in[I_MG])) + (size_t)e * DM * FE;
            p0_wg_item(src + (size_t)(128 * kb + 16 * wave) * FE + 128 * nt + 4 * q32, FE, ws + WS_WM1 + (size_t)e * 7168 * DM + (size_t)(256 * nt) * DM + 128 * kb, (size_t)DM, half ? 16.f * SWI_UP : 16.f * SWI_GATE, buf, lane, wave); continue; }
        r -= 8 * G_M1;
        { const int e = r / G_M2; r %= G_M2; const int kb = r % 28, nt = r / 28;
            p0_wg_item(GIN(A.in[I_MD]) + (size_t)e * FE * DM + (size_t)(128 * kb + 16 * wave) * DM + 256 * nt + 4 * lane, DM, ws + WS_WM2 + (size_t)e * DM * FE + (size_t)(256 * nt) * FE + 128 * kb, (size_t)FE, 16.f, buf, lane, wave); }
    }
}

#undef A
template <bool FP8, bool XBF>
__device__ __forceinline__ void norm_phase(const void* xv_, const float* g, const float* sh, const float* sc, void* Ov, int vcu, int G) {
    const int lane = opaque_tid0() & 63, wave = opaque_tid0() >> 6, gw = vcu * NWAVES + wave, NGW = G * NWAVES;
    constexpr int NR = XBF ? 8 : 16;
    for (int rb = gw; rb < T / 32; rb += NGW) {
        const int b = (rb * 32) >> 11;
        f32x4 gv[4], sv[4];
#pragma unroll
        for (int j = 0; j < 4; ++j) { const int c = 4 * lane + 256 * j; const f32x4 gg = *(const f32x4*)(g + c), s1 = *(const f32x4*)(sc + (size_t)b * 6144 + c); gv[j] = gg * (s1 + 1.f); sv[j] = *(const f32x4*)(sh + (size_t)b * 6144 + c); }
        unsigned nx[NR];
        {   const size_t row = (size_t)rb * 32;
            if constexpr (XBF) { const u32x2* xr = (const u32x2*)((const bf16_t*)xv_ + row * DM) + lane;
#pragma unroll
                for (int j = 0; j < 4; ++j) { const u32x2 t = xr[64 * j]; nx[2 * j] = t[0]; nx[2 * j + 1] = t[1]; } }
            else { const u32x4* xr = (const u32x4*)((const float*)xv_ + row * DM) + lane;
#pragma unroll
                for (int j = 0; j < 4; ++j) { const u32x4 t = xr[64 * j]; nx[4 * j] = t[0]; nx[4 * j + 1] = t[1]; nx[4 * j + 2] = t[2]; nx[4 * j + 3] = t[3]; } }
#pragma unroll
            for (int i = 0; i < NR; ++i) asm volatile("" : "+v"(nx[i])); }
#pragma unroll 1
        for (int r = 0; r < 32; ++r) {
            const size_t row = (size_t)rb * 32 + r;
            unsigned cw[NR];
#pragma unroll
            for (int i = 0; i < NR; ++i) cw[i] = nx[i];
            {   const size_t rn = row + (r < 31 ? 1 : 0);
                if constexpr (XBF) { const u32x2* xr = (const u32x2*)((const bf16_t*)xv_ + rn * DM) + lane;
#pragma unroll
                    for (int j = 0; j < 4; ++j) { const u32x2 t = xr[64 * j]; nx[2 * j] = t[0]; nx[2 * j + 1] = t[1]; } }
                else { const u32x4* xr = (const u32x4*)((const float*)xv_ + rn * DM) + lane;
#pragma unroll
                    for (int j = 0; j < 4; ++j) { const u32x4 t = xr[64 * j]; nx[4 * j] = t[0]; nx[4 * j + 1] = t[1]; nx[4 * j + 2] = t[2]; nx[4 * j + 3] = t[3]; } } }
            __builtin_amdgcn_sched_barrier(0);
            f32x4 v[4]; float s = 0.f;
            if constexpr (XBF) {
#pragma unroll
                for (int j = 0; j < 4; ++j) { v[j][0] = __builtin_bit_cast(float, cw[2 * j] << 16); v[j][1] = __builtin_bit_cast(float, cw[2 * j] & 0xffff0000u); v[j][2] = __builtin_bit_cast(float, cw[2 * j + 1] << 16); v[j][3] = __builtin_bit_cast(float, cw[2 * j + 1] & 0xffff0000u); } }
            else {
#pragma unroll
                for (int j = 0; j < 4; ++j) { v[j][0] = __builtin_bit_cast(float, cw[4 * j]); v[j][1] = __builtin_bit_cast(float, cw[4 * j + 1]); v[j][2] = __builtin_bit_cast(float, cw[4 * j + 2]); v[j][3] = __builtin_bit_cast(float, cw[4 * j + 3]); } }
#pragma unroll
            for (int j = 0; j < 4; ++j) s += (v[j][0] * v[j][0] + v[j][1] * v[j][1]) + (v[j][2] * v[j][2] + v[j][3] * v[j][3]);
            const float rs = 1.f / sqrtf(wave_sum(s) * (1.f / DM) + EPS);
            if constexpr (FP8) { unsigned* o4 = (unsigned*)((unsigned char*)Ov + row * DM) + lane;
#pragma unroll
                for (int j = 0; j < 4; ++j) { const f32x4 y = v[j] * rs * gv[j] + sv[j]; o4[64 * j] = pk4_fp8(y[0], y[1], y[2], y[3]); } }
            else { unsigned long long* o8 = (unsigned long long*)((bf16_t*)Ov + row * DM) + lane;
#pragma unroll
                for (int j = 0; j < 4; ++j) { const f32x4 y = v[j] * rs * gv[j] + sv[j]; o8[64 * j] = (unsigned long long)pk2(y[0], y[1]) | ((unsigned long long)pk2(y[2], y[3]) << 32); } }
#pragma unroll
            for (int i = 0; i < NR; ++i) asm volatile("" : "+v"(nx[i]));
        }
    }
}
__device__ __forceinline__ void norm_route_phase(const bf16_t* x, const float* g, const float* sh, const float* sc, const float* wr_, unsigned char* O, int* TOK, unsigned* cnt, LAS unsigned char* lds, int vcu, int G) {
    const int tid = opaque_tid0(), lane = tid & 63, wave = tid >> 6;
    LAS float* WR = (LAS float*)lds;
    LAS int* lcnt = (LAS int*)(lds + 32768);
    LAS int* lbase = (LAS int*)(lds + 32768 + 64);
    LAS int* tinfo = (LAS int*)(lds + 32768 + 128);
    for (int e = tid; e < DM * NE; e += NTHR) WR[(e & 7) * DM + (e >> 3)] = wr_[e];
    for (int blk = vcu; blk < T / 256; blk += G) {
        __syncthreads();
        if (tid < 16) lcnt[tid] = 0;
        __syncthreads();
        const int b = (blk * 256) >> 11;
        f32x4 gv[4], sv[4];
#pragma unroll
        for (int j = 0; j < 4; ++j) { const int c = 4 * lane + 256 * j; const f32x4 gg = *(const f32x4*)(g + c), s1 = *(const f32x4*)(sc + (size_t)b * 6144 + c); gv[j] = gg * (s1 + 1.f); sv[j] = *(const f32x4*)(sh + (size_t)b * 6144 + c); }
        unsigned nx[8];
        {   const u32x2* xr0 = (const u32x2*)(x + ((size_t)blk * 256 + wave * 32) * DM) + lane;
#pragma unroll
            for (int j = 0; j < 4; ++j) { const u32x2 t = xr0[64 * j]; nx[2 * j] = t[0]; nx[2 * j + 1] = t[1]; }
#pragma unroll
            for (int j = 0; j < 8; ++j) asm volatile("" : "+v"(nx[j])); }
#pragma unroll 1
        for (int r = 0; r < 32; ++r) {
            const int tl = wave * 32 + r; const size_t row = (size_t)blk * 256 + tl;
            unsigned cwv[8];
#pragma unroll
            for (int j = 0; j < 8; ++j) cwv[j] = nx[j];
            {   const u32x2* xrn = (const u32x2*)(x + (row + (r < 31 ? 1 : 0)) * DM) + lane;
#pragma unroll
                for (int j = 0; j < 4; ++j) { const u32x2 t = xrn[64 * j]; nx[2 * j] = t[0]; nx[2 * j + 1] = t[1]; } }
            __builtin_amdgcn_sched_barrier(0);
            f32x4 v[4]; float s = 0.f;
#pragma unroll
            for (int j = 0; j < 4; ++j) { u32x2 w2; w2[0] = cwv[2 * j]; w2[1] = cwv[2 * j + 1]; v[j][0] = __builtin_bit_cast(float, w2[0] << 16); v[j][1] = __builtin_bit_cast(float, w2[0] & 0xffff0000u); v[j][2] = __builtin_bit_cast(float, w2[1] << 16); v[j][3] = __builtin_bit_cast(float, w2[1] & 0xffff0000u); s += (v[j][0] * v[j][0] + v[j][1] * v[j][1]) + (v[j][2] * v[j][2] + v[j][3] * v[j][3]); }
            const float rs = 1.f / sqrtf(wave_sum(s) * (1.f / DM) + EPS);
            unsigned* o4 = (unsigned*)(O + row * DM) + lane;
            float lg[8];
#pragma unroll
            for (int e = 0; e < 8; ++e) lg[e] = 0.f;
#pragma unroll
            for (int j = 0; j < 4; ++j) { const f32x4 y = v[j] * rs * gv[j] + sv[j]; o4[64 * j] = pk4_fp8(y[0], y[1], y[2], y[3]);
#pragma unroll
                for (int e = 0; e < 8; ++e) { const f32x4 wv = *(const LAS f32x4*)(WR + e * DM + 4 * lane + 256 * j);
                    lg[e] += (y[0] * wv[0] + y[1] * wv[1]) + (y[2] * wv[2] + y[3] * wv[3]); } }
#pragma unroll
            for (int e = 0; e < 8; ++e) lg[e] = wave_sum(lg[e]);
            if (lane == 0) {
                int e0 = 0; float v0 = lg[0];
#pragma unroll
                for (int e = 1; e < 8; ++e) if (lg[e] > v0) { v0 = lg[e]; e0 = e; }
                int e1 = -1; float v1 = -3.0e38f;
#pragma unroll
                for (int e = 0; e < 8; ++e) if (e != e0 && lg[e] > v1) { v1 = lg[e]; e1 = e; }
                const float w1 = fast_exp(v1 - v0), g0 = 1.f / (1.f + w1), g1 = w1 * g0;
                const int p0 = atomicAdd((int*)&lcnt[e0], 1), p1 = atomicAdd((int*)&lcnt[8 + e1], 1);
                tinfo[tl * 6 + 0] = e0; tinfo[tl * 6 + 1] = e1; tinfo[tl * 6 + 2] = p0; tinfo[tl * 6 + 3] = p1; tinfo[tl * 6 + 4] = __builtin_bit_cast(int, g0); tinfo[tl * 6 + 5] = __builtin_bit_cast(int, g1);
            }
#pragma unroll
            for (int j = 0; j < 8; ++j) asm volatile("" : "+v"(nx[j]));
        }
        __syncthreads();
        if (tid < 16) lbase[tid] = (int)__hip_atomic_fetch_add(cnt + 64 * tid, (unsigned)lcnt[tid], RLX_AGENT);
        __syncthreads();
        if (tid < 256) { int* o = TOK + ((size_t)blk * 256 + tid) * 8; const int e0 = tinfo[tid * 6], e1 = tinfo[tid * 6 + 1];
            o[0] = e0; o[1] = e1; o[2] = tinfo[tid * 6 + 2] + lbase[e0]; o[3] = tinfo[tid * 6 + 3] + lbase[8 + e1]; o[4] = tinfo[tid * 6 + 4]; o[5] = tinfo[tid * 6 + 5]; }
    }
}
__device__ __forceinline__ void moe_prefix_both(unsigned* cnt, LAS int* tp, LAS int* raw) {
    const int t = opaque_tid0();
    if (t < 16) raw[t] = (int)__hip_atomic_load(cnt + 64 * t, RLX_AGENT);
    __syncthreads();
    if (t == 0) {
#pragma unroll
        for (int k = 0; k < 2; ++k) { int a = 0;
#pragma unroll
            for (int e = 0; e < 8; ++e) { tp[k * 9 + e] = a; a += (raw[k * 8 + e] + 255) >> 8; }
            tp[k * 9 + 8] = a; } }
    __syncthreads();
}
__device__ __forceinline__ void moe_prefix(unsigned* cnt, int k, LAS int* tp) {
    if (opaque_tid0() == 0) { int a = 0; for (int e = 0; e < 8; ++e) { tp[e] = a; a += ((int)__hip_atomic_load(cnt + 64 * (k * 8 + e), RLX_AGENT) + 255) >> 8; } tp[8] = a; }
    __syncthreads();
}
__device__ __forceinline__ void unpack4(const u32x2 w2, f32x4& v) { v[0] = __builtin_bit_cast(float, w2[0] << 16); v[1] = __builtin_bit_cast(float, w2[0] & 0xffff0000u); v[2] = __builtin_bit_cast(float, w2[1] << 16); v[3] = __builtin_bit_cast(float, w2[1] & 0xffff0000u); }
__device__ __forceinline__ void final_norm_phase(const bf16_t* xr_, const bf16_t* Y0, const bf16_t* Y1, const int* TOK, const float* g2, unsigned* cnt, LAS unsigned char* lds, float* out, const float* g, int vcu, int G, float pscale = 1.f, float padd = 0.f) {
    const int lane = opaque_tid0() & 63, wave = opaque_tid0() >> 6, gw = vcu * NWAVES + wave, NGW = G * NWAVES;
    LAS int* tp = (LAS int*)lds;
    __syncthreads(); moe_prefix_both(cnt, tp, tp + 32);
    f32x4 gv[4];
#pragma unroll
    for (int j = 0; j < 4; ++j) gv[j] = *(const f32x4*)(g + 4 * lane + 256 * j);
    const int seg = (T + NGW - 1) / NGW, rbeg = gw * seg, rend = (rbeg + seg < T) ? rbeg + seg : T;
    int nti[6]; unsigned nxr[8];
    if (rbeg < rend) { const int* t0 = TOK + (size_t)rbeg * 8; const u32x2* x0 = (const u32x2*)(xr_ + (size_t)rbeg * DM) + lane;
#pragma unroll
        for (int i = 0; i < 6; ++i) nti[i] = t0[i];
#pragma unroll
        for (int j = 0; j < 4; ++j) { const u32x2 t = x0[64 * j]; nxr[2 * j] = t[0]; nxr[2 * j + 1] = t[1]; }
#pragma unroll
        for (int i = 0; i < 6; ++i) asm volatile("" : "+v"(nti[i]));
#pragma unroll
        for (int i = 0; i < 8; ++i) asm volatile("" : "+v"(nxr[i])); }
#pragma unroll 1
    for (int row = rbeg; row < rend; ++row) {
        int ti[6]; unsigned cx[8];
#pragma unroll
        for (int i = 0; i < 6; ++i) ti[i] = nti[i];
#pragma unroll
        for (int i = 0; i < 8; ++i) cx[i] = nxr[i];
        { const int rn = (row + 1 < rend) ? row + 1 : row; const int* tn = TOK + (size_t)rn * 8; const u32x2* xn = (const u32x2*)(xr_ + (size_t)rn * DM) + lane;
#pragma unroll
            for (int i = 0; i < 6; ++i) nti[i] = tn[i];
#pragma unroll
            for (int j = 0; j < 4; ++j) { const u32x2 t = xn[64 * j]; nxr[2 * j] = t[0]; nxr[2 * j + 1] = t[1]; } }
        const int e0 = ti[0], e1 = ti[1]; const float q0 = __builtin_bit_cast(float, ti[4]), q1 = __builtin_bit_cast(float, ti[5]);
        const size_t r0 = (size_t)256 * tp[e0] + ti[2], r1 = (size_t)256 * tp[9 + e1] + ti[3];
        f32x4* o = (f32x4*)(out + (size_t)row * DM) + lane;
        const u32x2* y0 = (const u32x2*)(Y0 + r0 * DM) + lane; const u32x2* y1 = (const u32x2*)(Y1 + r1 * DM) + lane;
        const float* gp = g2 + (size_t)(row >> 11) * 6144 + 4 * lane;
        u32x2 xr[4];
#pragma unroll
        for (int j = 0; j < 4; ++j) { xr[j][0] = cx[2 * j]; xr[j][1] = cx[2 * j + 1]; }
        f32x4 v[4]; float s = 0.f;
#pragma unroll
        for (int j = 0; j < 4; ++j) { f32x4 a, b; unpack4(xr[j], v[j]); unpack4(y0[64 * j], a); unpack4(y1[64 * j], b);
            v[j] += *(const f32x4*)(gp + 256 * j) * (a * q0 + b * q1);
            s += (v[j][0] * v[j][0] + v[j][1] * v[j][1]) + (v[j][2] * v[j][2] + v[j][3] * v[j][3]); }
        const float rs = 1.f / sqrtf(wave_sum(s) * (1.f / DM) + EPS);
#pragma unroll
        for (int j = 0; j < 4; ++j) { f32x4 y = v[j] * rs * gv[j] * pscale; if (row == 0 && j == 0 && lane == 0) y[0] += padd; o[64 * j] = y; }
#pragma unroll
        for (int i = 0; i < 6; ++i) asm volatile("" : "+v"(nti[i]));
#pragma unroll
        for (int i = 0; i < 8; ++i) asm volatile("" : "+v"(nxr[i]));
    }
}
__device__ __forceinline__ void moe_rowinfo_phase(const int* TOK, int* RI, unsigned* cnt, LAS unsigned char* lds, int vcu, int G) {
    const int tid = opaque_tid0();
    LAS int* tp = (LAS int*)lds;
    moe_prefix_both(cnt, tp, tp + 32);
    for (int tok = vcu * NTHR + tid; tok < T; tok += G * NTHR) {
        const u32x4 a = *(const u32x4*)(TOK + (size_t)tok * 8); const u32x2 gq = *(const u32x2*)(TOK + (size_t)tok * 8 + 4);
#pragma unroll
        for (int k = 0; k < 2; ++k) { const int e = (int)a[k], row = 256 * tp[k * 9 + e] + (int)a[2 + k];
            u32x2 o; o[0] = (unsigned)tok; o[1] = gq[k]; *(u32x2*)(RI + ((size_t)k * HSROWS + row) * 2) = o; }
    }
    for (int it = vcu; it < 16; it += G) { const int k = it >> 3, e = it & 7; const int c = (int)__hip_atomic_load(cnt + 64 * it, RLX_AGENT), base = 256 * tp[k * 9 + e];
        for (int r = c + tid; r < ((c + 255) & ~255); r += NTHR) RI[((size_t)k * HSROWS + base + r) * 2] = -1; }
}

typedef f32x16 acc16;
__device__ __forceinline__ acc16 zero16() { acc16 z;
#pragma unroll
    for (int i = 0; i < 16; ++i) z[i] = 0.f; return z; }
#define MFMA32(a, b, c) __builtin_amdgcn_mfma_f32_32x32x16_bf16((a), (b), (c), 0, 0, 0)
__device__ __forceinline__ bf16x8 ld_lds8(const LAS bf16_t* p) { return *(const LAS bf16x8*)p; }

struct MixPtrsT {
    unsigned char* ws;
    struct Ref { unsigned char* ws;
        __device__ __forceinline__ const bf16_t* QAp() const { return (const bf16_t*)(ws + WS_QA); } };
};
#define MP_FIELDS \
    X(const bf16_t*, QA, WS_QA) X(const bf16_t*, KA, WS_KA) X(const bf16_t*, VAT, WS_VAT) X(const bf16_t*, IQ, WS_IQ) X(const bf16_t*, IK, WS_IK) X(const float*, IW, WS_IW) \
    X(const bf16_t*, HQ, WS_HQ) X(const bf16_t*, HKK, WS_HKK) X(const bf16_t*, HI, WS_HI) X(const bf16_t*, HG, WS_HG) X(const float*, HLF, WS_HLF) \
    X(const bf16_t*, GU, WS_GU) X(const bf16_t*, GV, WS_GV) X(unsigned long long*, BM, WS_BM) X(bf16_t*, MIX, WS_ACT1)
struct MixPtrs { unsigned char* ws; };
#define X(T_, N_, O_) __device__ __forceinline__ T_ mp_##N_(const MixPtrs& P) { return (T_)(P.ws + O_); }
MP_FIELDS
#undef X


__device__ __forceinline__ void hgrn_unit(LAS unsigned char* lds, const MixPtrs& P, int b, int h, const float* onorm) {
    const int tid = opaque_tid0(), lane = tid & 63, w = tid >> 6, l32 = lane & 31, hh = lane >> 5;
    LAS float* BC = (LAS float*)lds;
    LAS float* GT = (LAS float*)(lds + 16384);
    LAS bf16_t* QA_ = (LAS bf16_t*)(lds + 18432);
    LAS bf16_t* KA_ = (LAS bf16_t*)(lds + 27648);
    LAS bf16_t* QB_ = (LAS bf16_t*)(lds + 36864);
    LAS bf16_t* KB_ = (LAS bf16_t*)(lds + 41472);
    LAS bf16_t* QE_ = (LAS bf16_t*)(lds + 46080);
    LAS bf16_t* KST = (LAS bf16_t*)(lds + 55296);
    LAS bf16_t* VT_ = (LAS bf16_t*)(lds + 64512);
    LAS bf16_t* AM_ = (LAS bf16_t*)(lds + 73728);
    LAS float* ST_ = (LAS float*)(lds + 82944);
    LAS float* OO_ = (LAS float*)(lds + 100352);
    for (int e = tid; e < 64 * 68; e += NTHR) ST_[e] = 0.f;
    ((LAS unsigned*)AM_)[(tid >> 4) * 36 + 16 + (tid & 15)] = 0u;
    const int te = tid >> 3, d0 = (tid & 7) * 8;
    const size_t rowb = (size_t)b * SEQ;
    float og[8];
#pragma unroll
    for (int i = 0; i < 8; ++i) og[i] = onorm[d0 + i];
    float nlf[8]; u32x4 nq, nk, nv, ng;
    {
#pragma unroll
        for (int i = 0; i < 8; ++i) nlf[i] = mp_HLF(P)[((rowb + 8 * w + i) * 6 + h) * 64 + lane];
        const size_t o = ((rowb + te) * 6 + h) * 64 + d0; nq = *(const u32x4*)(mp_HQ(P) + o); nk = *(const u32x4*)(mp_HKK(P) + o); nv = *(const u32x4*)(mp_HI(P) + o); ng = *(const u32x4*)(mp_HG(P) + o);
    }
    for (int c = 0; c < 32; ++c) {
        float lf[8]; u32x4 cq = nq, ck = nk, cv = nv, cg = ng;
#pragma unroll
        for (int i = 0; i < 8; ++i) lf[i] = nlf[i];
        if (c + 1 < 32) {
            const size_t r1 = rowb + (size_t)(c + 1) * 64;
#pragma unroll
            for (int i = 0; i < 8; ++i) nlf[i] = mp_HLF(P)[((r1 + 8 * w + i) * 6 + h) * 64 + lane];
            const size_t o = ((r1 + te) * 6 + h) * 64 + d0; nq = *(const u32x4*)(mp_HQ(P) + o); nk = *(const u32x4*)(mp_HKK(P) + o); nv = *(const u32x4*)(mp_HI(P) + o); ng = *(const u32x4*)(mp_HG(P) + o);
        }
#pragma unroll
        for (int i = 1; i < 8; ++i) lf[i] += lf[i - 1];
        GT[w * 64 + lane] = lf[7];
        __syncthreads();
        { float off = 0.f;
#pragma unroll
            for (int ww = 0; ww < 7; ++ww) off += (ww < w) ? GT[ww * 64 + lane] : 0.f;
#pragma unroll
            for (int i = 0; i < 8; ++i) BC[(8 * w + i) * 64 + lane] = lf[i] + off; }
        __syncthreads();
        {
            const f32x4 ba = *(const LAS f32x4*)(BC + te * 64 + d0), bb = *(const LAS f32x4*)(BC + te * 64 + d0 + 4);
            const int rr = (te < 32) ? 16 : 48;
            const f32x4 ra = *(const LAS f32x4*)(BC + rr * 64 + d0), rb = *(const LAS f32x4*)(BC + rr * 64 + d0 + 4);
            const f32x4 ma = *(const LAS f32x4*)(BC + 31 * 64 + d0), mb = *(const LAS f32x4*)(BC + 31 * 64 + d0 + 4);
            const f32x4 la = *(const LAS f32x4*)(BC + 63 * 64 + d0), lb_ = *(const LAS f32x4*)(BC + 63 * 64 + d0 + 4);
            float q[8], k[8], bt[8], rf[8], md[8], ls[8];
#pragma unroll
            for (int i = 0; i < 4; ++i) { q[2 * i] = bf2f((unsigned short)(cq[i] & 0xffff)); q[2 * i + 1] = bf2f((unsigned short)(cq[i] >> 16)); k[2 * i] = bf2f((unsigned short)(ck[i] & 0xffff)); k[2 * i + 1] = bf2f((unsigned short)(ck[i] >> 16)); }
#pragma unroll
            for (int i = 0; i < 4; ++i) { bt[i] = ba[i]; bt[4 + i] = bb[i]; rf[i] = ra[i]; rf[4 + i] = rb[i]; md[i] = ma[i]; md[4 + i] = mb[i]; ls[i] = la[i]; ls[4 + i] = lb_[i]; }
            float qa[8], ka[8], qe[8], xb[8], ks[8];
#pragma unroll
            for (int i = 0; i < 8; ++i) { qa[i] = q[i] * fast_exp(bt[i] - rf[i]); ka[i] = k[i] * fast_exp(rf[i] - bt[i]); qe[i] = q[i] * fast_exp(bt[i]);
                xb[i] = (te < 32) ? k[i] * fast_exp(md[i] - bt[i]) : q[i] * fast_exp(bt[i] - md[i]); ks[i] = k[i] * fast_exp(ls[i] - bt[i]); }
            u32x4 pq, pk, pe, px;
#pragma unroll
            for (int i = 0; i < 4; ++i) { pq[i] = pk2(qa[2 * i], qa[2 * i + 1]); pk[i] = pk2(ka[2 * i], ka[2 * i + 1]); pe[i] = pk2(qe[2 * i], qe[2 * i + 1]); px[i] = pk2(xb[2 * i], xb[2 * i + 1]); }
            *(LAS u32x4*)(QA_ + te * 72 + d0) = pq; *(LAS u32x4*)(KA_ + te * 72 + d0) = pk; *(LAS u32x4*)(QE_ + te * 72 + d0) = pe;
            if (te < 32) *(LAS u32x4*)(KB_ + te * 72 + d0) = px; else *(LAS u32x4*)(QB_ + (te - 32) * 72 + d0) = px;
#pragma unroll
            for (int i = 0; i < 8; ++i) KST[(d0 + i) * 72 + te] = (bf16_t)f2bf(ks[i]);
#pragma unroll
            for (int i = 0; i < 4; ++i) { VT_[(d0 + 2 * i) * 72 + te] = (bf16_t)(cv[i] & 0xffff); VT_[(d0 + 2 * i + 1) * 72 + te] = (bf16_t)(cv[i] >> 16); }
        }
        __syncthreads();
        acc16 oacc = zero16();
        if (w < 3) {
            const LAS bf16_t* Qs = (w == 0) ? QA_ : (w == 1) ? QA_ + 32 * 72 : QB_;
            const LAS bf16_t* Ks = (w == 0) ? KA_ : (w == 1) ? KA_ + 32 * 72 : KB_;
            acc16 a = zero16();
#pragma unroll
            for (int kk = 0; kk < 4; ++kk) a = MFMA32(ld_lds8(Qs + l32 * 72 + 8 * hh + 16 * kk), ld_lds8(Ks + l32 * 72 + 8 * hh + 16 * kk), a);
            const int tb = (w == 0) ? 0 : 32, sb = (w == 1) ? 32 : 0;
#pragma unroll
            for (int i = 0; i < 16; ++i) { const int tl = 8 * (i >> 2) + 4 * hh + (i & 3); const float v = (w < 2 && l32 > tl) ? 0.f : a[i]; AM_[(tb + tl) * 72 + sb + l32] = (bf16_t)f2bf(v); }
        } else if (w < 7) {
            const int th = (w - 3) >> 1, vh = (w - 3) & 1;
#pragma unroll
            for (int kk = 0; kk < 4; ++kk) {
                const LAS float* sp = ST_ + (vh * 32 + l32) * 68 + 8 * hh + 16 * kk; const f32x4 s0 = *(const LAS f32x4*)sp, s1 = *(const LAS f32x4*)(sp + 4);
                u32x4 sbv; sbv[0] = pk2(s0[0], s0[1]); sbv[1] = pk2(s0[2], s0[3]); sbv[2] = pk2(s1[0], s1[1]); sbv[3] = pk2(s1[2], s1[3]);
                oacc = MFMA32(ld_lds8(QE_ + (th * 32 + l32) * 72 + 8 * hh + 16 * kk), __builtin_bit_cast(bf16x8, sbv), oacc);
            }
        }
        __syncthreads();
        if (w >= 3 && w < 7) {
            const int th = (w - 3) >> 1, vh = (w - 3) & 1;
#pragma unroll
            for (int kk = 0; kk < 4; ++kk) oacc = MFMA32(ld_lds8(AM_ + (th * 32 + l32) * 72 + 8 * hh + 16 * kk), ld_lds8(VT_ + (vh * 32 + l32) * 72 + 8 * hh + 16 * kk), oacc);
#pragma unroll
            for (int i = 0; i < 16; ++i) { const int tl = 8 * (i >> 2) + 4 * hh + (i & 3); OO_[(th * 32 + tl) * 68 + vh * 32 + l32] = oacc[i]; }
        } else {
            const int idx = (w == 7) ? 3 : w, vh = idx >> 1, dh = idx & 1;
            acc16 a = zero16();
#pragma unroll
            for (int kk = 0; kk < 4; ++kk) a = MFMA32(ld_lds8(VT_ + (vh * 32 + l32) * 72 + 8 * hh + 16 * kk), ld_lds8(KST + (dh * 32 + l32) * 72 + 8 * hh + 16 * kk), a);
            const float dec = fast_exp(BC[63 * 64 + dh * 32 + l32]);
#pragma unroll
            for (int i = 0; i < 16; ++i) { const int vl = 8 * (i >> 2) + 4 * hh + (i & 3); LAS float* sp = ST_ + (vh * 32 + vl) * 68 + dh * 32 + l32; *sp = dec * (*sp) + a[i]; }
        }
        __syncthreads();
        {
            const f32x4 oa = *(const LAS f32x4*)(OO_ + te * 68 + d0), ob = *(const LAS f32x4*)(OO_ + te * 68 + d0 + 4);
            float ss = (oa[0] * oa[0] + oa[1] * oa[1]) + (oa[2] * oa[2] + oa[3] * oa[3]) + (ob[0] * ob[0] + ob[1] * ob[1]) + (ob[2] * ob[2] + ob[3] * ob[3]);
            ss = sum8(ss);
            const float rs = 1.f / sqrtf(ss * (1.f / 64.f) + EPS);
            float r[8];
#pragma unroll
            for (int i = 0; i < 4; ++i) { r[i] = oa[i] * rs * og[i]; r[4 + i] = ob[i] * rs * og[4 + i]; }
#pragma unroll
            for (int i = 0; i < 4; ++i) { r[2 * i] *= bf2f((unsigned short)(cg[i] & 0xffff)); r[2 * i + 1] *= bf2f((unsigned short)(cg[i] >> 16)); }
            u32x4 o; o[0] = pk2(r[0], r[1]); o[1] = pk2(r[2], r[3]); o[2] = pk2(r[4], r[5]); o[3] = pk2(r[6], r[7]);
            *(u32x4*)(mp_MIX(P) + (rowb + (size_t)c * 64 + te) * DM + 384 + h * 64 + d0) = o;
        }
    }
}

__device__ __forceinline__ void gmlp_unit(LAS unsigned char* lds, const MixPtrs& P, int b, int n, const float* vng, const float* vnb, const bf16_t* GW, const float* gbs) {
    const int tid = opaque_tid0(), lane = tid & 63, w = tid >> 6, l32 = lane & 31, hh = lane >> 5;
    LAS bf16_t* VT = (LAS bf16_t*)lds;
    const size_t row0 = (size_t)b * SEQ + (size_t)n * 128;
    u32x4 gwf[20];
    {   const int g_ = w >> 1; int fi = 0;
#pragma unroll
        for (int tb = 0; tb < 4; ++tb)
#pragma unroll
            for (int kk = 0; kk < 8; ++kk) if (kk < 2 * (tb + 1)) { gwf[fi] = *(const u32x4*)(GW + ((size_t)g_ * 128 + tb * 32 + l32) * 128 + 8 * hh + 16 * kk); ++fi; } }
    __builtin_amdgcn_sched_barrier(0);
    {
        const int s = 16 * w + (lane >> 2), c0 = 64 * (lane & 3);
        float x[64];
#pragma unroll
        for (int i = 0; i < 8; ++i) { const u32x4 v = *(const u32x4*)(mp_GV(P) + (row0 + s) * 256 + c0 + 8 * i);
#pragma unroll
            for (int j = 0; j < 4; ++j) { x[8 * i + 2 * j] = bf2f((unsigned short)(v[j] & 0xffff)); x[8 * i + 2 * j + 1] = bf2f((unsigned short)(v[j] >> 16)); } }
        float sm = 0.f;
#pragma unroll
        for (int i = 0; i < 64; ++i) sm += x[i];
        sm = dpp_add(sm, 0); sm = dpp_add(sm, 1);
        const float mu = sm * (1.f / 256.f); float vq = 0.f;
#pragma unroll
        for (int i = 0; i < 64; ++i) { x[i] -= mu; vq += x[i] * x[i]; }
        vq = dpp_add(vq, 0); vq = dpp_add(vq, 1);
        const float rs = 1.f / sqrtf(vq * (1.f / 256.f) + EPS);
#pragma unroll
        for (int i = 0; i < 64; ++i) VT[(c0 + i) * 136 + s] = (bf16_t)f2bf(x[i] * rs * vng[c0 + i] + vnb[c0 + i]);
    }
    __syncthreads();
    const int g = w >> 1, db = w & 1;
    acc16 acc[4];
#pragma unroll
    for (int fi = 0; fi < 20; ++fi) asm volatile("" : "+v"(gwf[fi]));
    { int fi = 0;
#pragma unroll
    for (int tb = 0; tb < 4; ++tb) { acc[tb] = zero16();
#pragma unroll
        for (int kk = 0; kk < 8; ++kk) if (kk < 2 * (tb + 1)) {
            acc[tb] = MFMA32(__builtin_bit_cast(bf16x8, gwf[fi]), ld_lds8(VT + (g * 64 + db * 32 + l32) * 136 + 8 * hh + 16 * kk), acc[tb]); ++fi; } } }
    const int cch = g * 64 + db * 32 + l32;
    __syncthreads();
    LAS float* GT_ = (LAS float*)lds;
#pragma unroll
    for (int tb = 0; tb < 4; ++tb)
#pragma unroll
        for (int i = 0; i < 16; ++i) { const int t = tb * 32 + 8 * (i >> 2) + 4 * hh + (i & 3); GT_[t * 260 + cch] = acc[tb][i] + gbs[g * 128 + t]; }
    __syncthreads();
#pragma unroll
    for (int k = 0; k < 8; ++k) { const int idx = tid + NTHR * k, t = idx >> 5, c8 = 8 * (idx & 31);
        const u32x4 uw = *(const u32x4*)(mp_GU(P) + (row0 + t) * 256 + c8);
        const f32x4 ga = *(const LAS f32x4*)(GT_ + t * 260 + c8), gb = *(const LAS f32x4*)(GT_ + t * 260 + c8 + 4);
        f32x4 ua, ub; unpack8(uw, ua, ub);
        *(u32x4*)(mp_MIX(P) + (row0 + t) * DM + 768 + c8) = pack8(ua * ga, ub * gb); }
}

constexpr int SC_STRIDE = 2052;
#ifndef SEL_REP_MODE
#define SEL_REP_MODE 0
#endif
typedef unsigned short u16x2 __attribute__((ext_vector_type(2)));
__device__ __forceinline__ unsigned pk_gt(unsigned x, unsigned c2) {
    unsigned d; asm("v_pk_sub_u16 %0, %1, %2 clamp\n\tv_pk_min_u16 %0, %0, %3" : "=&v"(d) : "v"(x), "v"(c2), "s"(0x00010001u)); return d;
}
__device__ __forceinline__ void pk_cnt(unsigned& acc, unsigned x, unsigned c2) {
    unsigned d; asm("v_pk_sub_u16 %1, %2, %3 clamp\n\tv_pk_min_u16 %1, %1, %4\n\tv_pk_add_u16 %0, %0, %1" : "+v"(acc), "=&v"(d) : "v"(x), "v"(c2), "s"(0x00010001u));
}
__device__ __forceinline__ void pk_neq(unsigned& acc, unsigned x, unsigned c2) {
    unsigned d; asm("v_xor_b32 %1, %2, %3\n\tv_pk_min_u16 %1, %1, %4\n\tv_pk_add_u16 %0, %0, %1" : "+v"(acc), "=&v"(d) : "v"(x), "v"(c2), "s"(0x00010001u));
}
__device__ __forceinline__ unsigned pk_add(unsigned a, unsigned b) { return __builtin_bit_cast(unsigned, (u16x2)(__builtin_bit_cast(u16x2, a) + __builtin_bit_cast(u16x2, b))); }
__device__ __forceinline__ unsigned pk_sub(unsigned a, unsigned b) { return __builtin_bit_cast(unsigned, (u16x2)(__builtin_bit_cast(u16x2, a) - __builtin_bit_cast(u16x2, b))); }

__device__ __forceinline__ void dsa_select_unit(LAS unsigned char* lds, const MixPtrs& P, int b, int j, int rep = 0) {
    const int tid = opaque_tid0(), lane = tid & 63, w = tid >> 6, qi = lane & 31, hh = lane >> 5;
    LAS unsigned* XC = (LAS unsigned*)lds;
    LAS unsigned char* TT = (LAS unsigned char*)(lds + 4096);
    LAS unsigned char* AL = (LAS unsigned char*)(lds + 6144);
    LAS int* NQ = (LAS int*)(lds + 8192);
    const size_t rowb = (size_t)b * SEQ; const size_t qrow = rowb + (size_t)j * 32 + qi;
    unsigned* BM32 = (unsigned*)mp_BM(P);
    const int zq = tid >> 4, zc = tid & 15;
    if (j < 8) {
        const int t = 32 * j + zq; u32x4 wv;
#pragma unroll
        for (int i = 0; i < 4; ++i) { const int k0 = 32 * (4 * zc + i); wv[i] = (k0 + 31 <= t) ? 0xffffffffu : (k0 > t) ? 0u : ((2u << (t - k0)) - 1u); }
        *(u32x4*)(BM32 + (rowb + t) * 64 + 4 * zc) = wv;
        return;
    }
    *(LAS unsigned*)(TT + 4 * tid) = 0u;
    {
        unsigned* bp = BM32 + (rowb + 32 * j + zq) * 64 + 4 * zc;
#pragma unroll
        for (int i = 0; i < 4; ++i) if (4 * zc + i > j) bp[i] = 0u;
    }
    unsigned K[8][8];
    {
        bf16x8 qf[4][4];
#pragma unroll
        for (int hd = 0; hd < 4; ++hd)
#pragma unroll
            for (int kk = 0; kk < 4; ++kk) qf[hd][kk] = *(const bf16x8*)(mp_IQ(P) + (qrow * 4 + hd) * 64 + 8 * hh + 16 * kk);
        f32x4 iw = *(const f32x4*)(mp_IW(P) + qrow * 4); iw *= 0.5f * 0.125f;
#pragma unroll
        for (int ti = 0; ti < 8; ++ti) {
            const int kt = w + 8 * ti;
            if (kt <= j) {
                bf16x8 kf[4];
#pragma unroll
                for (int kk = 0; kk < 4; ++kk) kf[kk] = *(const bf16x8*)(mp_IK(P) + (rowb + (size_t)kt * 32 + qi) * 64 + 8 * hh + 16 * kk);
                float sc[16];
#pragma unroll
                for (int i = 0; i < 16; ++i) sc[i] = 0.f;
#pragma unroll
                for (int hd = 0; hd < 4; ++hd) { acc16 a = zero16();
#pragma unroll
                    for (int kk = 0; kk < 4; ++kk) a = MFMA32(kf[kk], qf[hd][kk], a);
#pragma unroll
                    for (int i = 0; i < 16; ++i) { const float av = a[i]; int rb = __float_as_int(av); rb = rb > 0 ? rb : 0;
                        sc[i] = __builtin_fmaf(iw[hd], __int_as_float(rb), sc[i]); asm volatile("" : "+v"(sc[i])); } }
                unsigned ky[16];
#pragma unroll
                for (int i = 0; i < 16; ++i) { const int hb = (int)__builtin_bit_cast(unsigned short, (_Float16)sc[i]);
                    ky[i] = (unsigned)(hb ^ (__builtin_amdgcn_sbfe(hb, 15, 1) | 0x8000)) & 0xffffu; }
                if (kt == j) {
#pragma unroll
                    for (int i = 0; i < 16; ++i) if ((8 * (i >> 2) + 4 * hh + (i & 3)) > qi) ky[i] = 0u;
                }
#pragma unroll
                for (int p = 0; p < 8; ++p) K[ti][p] = ky[2 * p] | (ky[2 * p + 1] << 16);
            } else {
#pragma unroll
                for (int p = 0; p < 8; ++p) K[ti][p] = 0u;
            }
        }
    }
#define SEL_COUNT(c2, out) do { unsigned _a = 0u; _Pragma("unroll") for (int ti = 0; ti < 8; ++ti) if (w + 8 * ti <= j) { _Pragma("unroll") for (int p = 0; p < 8; ++p) pk_cnt(_a, K[ti][p], (c2)); } (out) = (int)((_a & 0xffffu) + (_a >> 16)); } while (0)
#define SEL_TOTAL(buf, cnt, tot) do { XC[((buf) * 32 + qi) * 16 + 2 * w + hh] = (unsigned)(cnt); __syncthreads(); \
        const LAS u32x4* _x = (const LAS u32x4*)(XC + ((buf) * 32 + qi) * 16); const u32x4 _a = _x[0], _b = _x[1], _c = _x[2], _d = _x[3]; \
        (tot) = (int)((_a[0] + _a[1] + _a[2] + _a[3]) + (_b[0] + _b[1] + _b[2] + _b[3]) + (_c[0] + _c[1] + _c[2] + _c[3]) + (_d[0] + _d[1] + _d[2] + _d[3])); } while (0)
    if (rep > 0 && SEL_REP_MODE == 1) return;
    unsigned v = 0u; int ngt = 0, cge = 0;
#pragma unroll 1
    for (int bit = 15; bit >= 0; --bit) {
        const unsigned cand = v | (1u << bit), cm1 = cand - 1u; int cnt, tot;
        SEL_COUNT(cm1 * 0x00010001u, cnt);
        SEL_TOTAL(bit & 1, cnt, tot);
        if (tot >= 256) { v = cand; cge = tot; } else ngt = tot;
    }
    (void)cge;
    const int need = 256 - ngt;
    if (w == 0 && hh == 0) NQ[qi] = need;
    const unsigned v2 = v * 0x00010001u, vm2 = (v - 1u) * 0x00010001u;
    int tlane[8];
#pragma unroll
    for (int ti = 0; ti < 8; ++ti) { tlane[ti] = 0;
        if (w + 8 * ti <= j) { unsigned a = 0u;
#pragma unroll
            for (int p = 0; p < 8; ++p) pk_neq(a, K[ti][p], v2);
            const int tl = 16 - (int)((a & 0xffffu) + (a >> 16)); const int tp = __shfl_xor(tl, 32); tlane[ti] = tl + tp;
            if (hh == 0) TT[qi * 64 + w + 8 * ti] = (unsigned char)(tl + tp); } }
    __syncthreads();
    {
        const unsigned x = *(const LAS unsigned*)(TT + zq * 64 + 4 * zc);
        const int b0 = x & 255, b1 = (x >> 8) & 255, b2 = (x >> 16) & 255, b3 = x >> 24; const int s = b0 + b1 + b2 + b3;
        int incl = s;
#pragma unroll
        for (int o = 1; o < 16; o <<= 1) { const int tt = __shfl_up(incl, o, 16); if (zc >= o) incl += tt; }
        int rem = NQ[zq] - (incl - s);
        int a0 = min(max(rem, 0), b0); rem -= b0; int a1 = min(max(rem, 0), b1); rem -= b1; int a2 = min(max(rem, 0), b2); rem -= b2; int a3 = min(max(rem, 0), b3);
        *(LAS unsigned*)(AL + zq * 64 + 4 * zc) = (unsigned)a0 | ((unsigned)a1 << 8) | ((unsigned)a2 << 16) | ((unsigned)a3 << 24);
    }
    __syncthreads();
#pragma unroll
    for (int ti = 0; ti < 8; ++ti) {
        const int kt = w + 8 * ti;
        if (kt <= j) {
            const int al = AL[qi * 64 + kt], tot = tlane[ti];
            unsigned word = 0u;
            if (!__any(al > 0 && al < tot)) {
                const unsigned thr2 = (al > 0) ? vm2 : v2;
#pragma unroll
                for (int p = 0; p < 8; ++p) { const unsigned f2 = pk_gt(K[ti][p], thr2); word |= ((f2 & 1u) | (f2 >> 15)) << (8 * (p >> 1) + 2 * (p & 1)); }
            } else {
            unsigned g2[8], e2[8]; unsigned tcp = 0u;
#pragma unroll
            for (int p = 0; p < 8; ++p) { g2[p] = pk_gt(K[ti][p], v2); e2[p] = pk_sub(pk_gt(K[ti][p], vm2), g2[p]); tcp += ((e2[p] & 1u) + (e2[p] >> 16)) << (4 * (p >> 1)); }
            const unsigned tpp = (unsigned)__shfl_xor((int)tcp, 32);
#pragma unroll
            for (int p = 0; p < 8; ++p) {
                const int g = p >> 1;
                unsigned ahead = 0u;
#pragma unroll
                for (int gg = 0; gg < 4; ++gg) if (gg < g) ahead += ((tcp >> (4 * gg)) & 15u) + ((tpp >> (4 * gg)) & 15u);
                if (hh) ahead += (tpp >> (4 * g)) & 15u;
                if (p & 1) ahead += (e2[p - 1] & 1u) + (e2[p - 1] >> 16);
                const unsigned elo = e2[p] & 1u, ehi = e2[p] >> 16;
                unsigned slo = elo, shi = ehi;
                if (al < tot) { slo = (elo && (int)ahead < al) ? 1u : 0u; shi = (ehi && (int)(ahead + elo) < al) ? 1u : 0u; }
                const unsigned bits = ((g2[p] & 1u) | slo) | ((((g2[p] >> 16) | shi)) << 1);
                word |= bits << (8 * g + 2 * (p & 1)); }
            }
            word <<= 4 * hh;
            word |= (unsigned)__shfl_xor((int)word, 32);
            if (hh == 0) BM32[qrow * 64 + kt + ((rep > 0 && SEL_REP_MODE == 2) ? (size_t)T * 64 : 0)] = word;
        }
    }
#undef SEL_COUNT
#undef SEL_TOTAL
}

constexpr int QL_STRIDE = 392;
__device__ __forceinline__ void dsa_attn_unit(LAS unsigned char* lds, const MixPtrs& P, int b, int J, float kmaxn) {
    const int tid = opaque_tid0(), lane = tid & 63, w = tid >> 6, qi = lane & 31, hh = lane >> 5;
    LAS bf16_t* KT = (LAS bf16_t*)lds;
    LAS bf16_t* VTT = (LAS bf16_t*)(lds + 2 * 64 * 72 * 2);
    LAS bf16_t* QL = (LAS bf16_t*)(lds + 4 * 64 * 72 * 2);
    const int qblk = w >> 1, hs = (w & 1) * 3;
    const size_t rowb = (size_t)b * SEQ; const int t = 128 * J + 32 * qblk + qi; const size_t row = rowb + t;
    {   u32x4 qt[12];
#pragma unroll
        for (int k = 0; k < 12; ++k) { const int e = tid + NTHR * k, r = e / 48, p = e % 48; qt[k] = *(const u32x4*)(mp_QA(P) + (rowb + (size_t)128 * J + r) * 384 + 8 * p); }
#pragma unroll
        for (int k = 0; k < 12; ++k) { const int e = tid + NTHR * k, r = e / 48, p = e % 48; *(LAS u32x4*)(QL + r * QL_STRIDE + 8 * p) = qt[k]; } }
    __syncthreads();
    const LAS bf16_t* qp = QL + (32 * qblk + qi) * QL_STRIDE + hs * 64 + 8 * hh;
    acc16 O[3][2]; float lsum[3];
#pragma unroll
    for (int h3 = 0; h3 < 3; ++h3) { O[h3][0] = zero16(); O[h3][1] = zero16(); lsum[h3] = 0.f; }
    const int nt = 2 * (J + 1);
    const int lr = tid >> 3, lp = (tid & 7) * 8;
    u32x4 rk = *(const u32x4*)(mp_KA(P) + (rowb + lr) * 64 + lp), rv = *(const u32x4*)(mp_VAT(P) + ((size_t)b * 64 + lr) * 2048 + lp);
    unsigned long long mw = mp_BM(P)[row * 32 + 0];
#pragma unroll 1
    for (int tile = 0; tile < nt; ++tile) {
        const int buf = tile & 1;
        *(LAS u32x4*)(KT + (buf * 64 + lr) * 72 + lp) = rk; *(LAS u32x4*)(VTT + (buf * 64 + lr) * 72 + lp) = rv;
        const unsigned long long cmw = mw;
        __syncthreads();
        if (tile + 1 < nt) { rk = *(const u32x4*)(mp_KA(P) + (rowb + (size_t)(tile + 1) * 64 + lr) * 64 + lp); rv = *(const u32x4*)(mp_VAT(P) + ((size_t)b * 64 + lr) * 2048 + (tile + 1) * 64 + lp); mw = mp_BM(P)[row * 32 + tile + 1]; }
#pragma unroll
        for (int sub = 0; sub < 2; ++sub) {
            const int msh = (int)((unsigned)(cmw >> (32 * sub)) >> (4 * hh));
            const LAS bf16_t* kp = KT + (buf * 64 + sub * 32 + qi) * 72 + 8 * hh;
            const LAS bf16_t* vp = VTT + (buf * 64 + qi) * 72 + sub * 32 + 4 * hh;
            bf16x8 kf[4], vf[2][2]; int em[16];
#pragma unroll
            for (int kk = 0; kk < 4; ++kk) kf[kk] = ld_lds8(kp + 16 * kk);
#pragma unroll
            for (int db = 0; db < 2; ++db)
#pragma unroll
                for (int s2 = 0; s2 < 2; ++s2) { const u32x2 lo = *(const LAS u32x2*)(vp + db * 32 * 72 + 16 * s2), hi = *(const LAS u32x2*)(vp + db * 32 * 72 + 16 * s2 + 8);
                    u32x4 c; c[0] = lo[0]; c[1] = lo[1]; c[2] = hi[0]; c[3] = hi[1]; vf[db][s2] = __builtin_bit_cast(bf16x8, c); }
#pragma unroll
            for (int i = 0; i < 16; ++i) em[i] = __builtin_amdgcn_sbfe(msh, 8 * (i >> 2) + (i & 3), 1);
            bf16x8 qc[4];
#pragma unroll
            for (int kk = 0; kk < 4; ++kk) qc[kk] = ld_lds8(qp + 16 * kk);
#pragma unroll
            for (int h3 = 0; h3 < 3; ++h3) {
                asm volatile("" ::: "memory"); __builtin_amdgcn_sched_barrier(0);
                acc16 s = zero16();
#pragma unroll
                for (int kk = 0; kk < 4; ++kk) s = MFMA32(kf[kk], qc[kk], s);
                if (h3 < 2) {
#pragma unroll
                    for (int kk = 0; kk < 4; ++kk) qc[kk] = ld_lds8(qp + (h3 + 1) * 64 + 16 * kk);
                }
#pragma unroll
                for (int s2 = 0; s2 < 2; ++s2) {
                    float p[8];
#pragma unroll
                    for (int i = 0; i < 8; ++i) { const int ii = 8 * s2 + i; p[i] = __builtin_bit_cast(float, __builtin_bit_cast(int, __builtin_amdgcn_exp2f(s[ii])) & em[ii]); lsum[h3] += p[i]; }
                    u32x4 pp;
#pragma unroll
                    for (int i = 0; i < 4; ++i) pp[i] = pk2(p[2 * i], p[2 * i + 1]);
#pragma unroll
                    for (int db = 0; db < 2; ++db) O[h3][db] = MFMA32(vf[db][s2], __builtin_bit_cast(bf16x8, pp), O[h3][db]);
                }
            }
        }
    }
#pragma unroll
    for (int h3 = 0; h3 < 3; ++h3) {
        float l = lsum[h3]; l += __shfl_xor(l, 32); const float inv = 1.f / l;
#pragma unroll
        for (int db = 0; db < 2; ++db)
#pragma unroll
            for (int gq = 0; gq < 4; ++gq) { u32x2 o; o[0] = pk2(O[h3][db][4 * gq] * inv, O[h3][db][4 * gq + 1] * inv); o[1] = pk2(O[h3][db][4 * gq + 2] * inv, O[h3][db][4 * gq + 3] * inv);
                *(u32x2*)(mp_MIX(P) + row * DM + (hs + h3) * 64 + db * 32 + 8 * gq + 4 * hh) = o; }
    }
    __syncthreads();
}

__device__ __forceinline__ MixPtrs make_mp(unsigned char* ws) { MixPtrs MP; MP.ws = ws; return MP; }
constexpr int NPH = 26;
__global__ void __launch_bounds__(NTHR, 2) fwd_kernel(Args args_by_value) {
    extern __shared__ __attribute__((aligned(16))) unsigned char lds_raw[];
    LAS unsigned char* lds = (LAS unsigned char*)lds_raw;
    volatile LAS unsigned* MISC = (volatile LAS unsigned*)(lds + LDS_MISC);
    const int tid = opaque_tid0();
    const int G = gridDim.x; int bx = blockIdx.x; int vcu = (G % 8 == 0) ? (bx % 8) * (G / 8) + bx / 8 : bx;
    (void)args_by_value;
#define args (*kargs())
    unsigned char* ws = args.ws;
    unsigned* ctl = (unsigned*)(ws + WS_CTL);
    if (tid < 64) MISC[tid] = 0u;
    __syncthreads();
    XcdBarrier bar = xcd_barrier_post(ctl + CW_BAR, MISC + 8);
    if (tid == 0) MISC[24] = __hip_atomic_fetch_add(ctl + CW_XRANK + 64 * (bar.x & 7u), 1u, RLX_AGENT);
    volatile LAS int* qslot = (volatile LAS int*)(MISC + 16);
    LAS int* tpl = (LAS int*)(lds + LDS_MISC + 128);
    const int lo = args.ph_lo, hi = args.ph_hi;
#ifndef PHMASK
#define PHMASK 0xFFFFFFFFu
#endif
#define PH(k) (lo <= (k) && (k) < hi)
#define PHM(j) ((PHMASK >> ((j) + 1)) & 1u)
#define PHL(j) (PHM(j) && PH(pb + (j)))
#define SEAM(k) do { if ((k) + 1 < hi) xcd_barrier(bar); } while (0)
#ifdef PROBE_A
    volatile LAS unsigned long long* PT = (volatile LAS unsigned long long*)(lds + LDS_MISC + 192);
    if (tid == 0) { const unsigned long long _t = __builtin_amdgcn_s_memrealtime(); PT[0] = _t; PT[1] = 0ull; PT[2] = 0ull; PT[3] = _t; }
#define STAMP(g) do { if (opaque_tid0() == 0) { const unsigned long long _t = __builtin_amdgcn_s_memrealtime(); if ((g) == PROBE_A) PT[1] += _t - PT[0]; if ((g) == PROBE_B) PT[2] += _t - PT[0]; PT[0] = _t; } } while (0)
#define UNIT_T0() const unsigned long long _ut0 = __builtin_amdgcn_s_memrealtime()
#define UNIT_T1(idx, cond) do { if ((cond) && opaque_tid0() == 0) ((unsigned*)(w + WS_CTL))[200 + (idx)] = (unsigned)(__builtin_amdgcn_s_memrealtime() - _ut0); } while (0)
#else
#define STAMP(g) do { } while (0)
#define UNIT_T0() do { } while (0)
#define UNIT_T1(idx, cond) do { } while (0)
#endif
    if ((PHMASK & 1u) && PH(0)) { p0_prologue(kargs(), lds, vcu, G);
#ifdef REP_PRO
        __syncthreads(); p0_prologue(kargs(), lds, vcu, G);
#endif
        SEAM(0); STAMP(0); }
    if (G % 8 == 0 && lo == 0 && hi > 1) {
        __syncthreads();
        if (tid == 0) { bool even = true;
            for (int k = 0; k < 8; ++k) even = even && (__hip_atomic_load(ctl + CW_XRANK + 64 * k, RLX_AGENT) == (unsigned)(G / 8));
            MISC[25] = even ? (MISC[24] * 8u + (bar.x & 7u)) : (unsigned)blockIdx.x; }
        __syncthreads();
        bx = __builtin_amdgcn_readfirstlane((int)MISC[25]); vcu = (bx % 8) * (G / 8) + bx / 8;
    }

    for (int l = 0; l < 2; ++l) {
        const int pb = 1 + 12 * l;
        if (PHL(0)) { unsigned char* w = launder(args.ws); const float* modl = (const float*)(w + WS_MOD) + (size_t)l * 32 * 6144;
            if (l == 0) norm_phase<false, false>(GIN(args.in[I_X]), GIN(args.in[I_GMIX]) + l * DM, modl + 0, modl + 1024, (void*)(w + WS_ACT1), vcu, G);
            else norm_phase<false, true>((const void*)(w + WS_XR), GIN(args.in[I_GMIX]) + l * DM, modl + 0, modl + 1024, (void*)(w + WS_ACT1), vcu, G); SEAM(pb + 0); STAMP(1); }
        if (PHL(1)) {
            unsigned char* w = launder(args.ws); const MixPtrs MP = make_mp(w);
            pg8::Gemm g{w, (unsigned)WS_ACT1, (unsigned)(WS_WIN + (size_t)l * NIN * DM * 2), T, NIN, DM}; pg8::StaticOrder S; S.init(T, NIN, G, bx, 4);
            EpiInproj E; E.QA = (bf16_t*)mp_QA(MP); E.KA = (bf16_t*)mp_KA(MP); E.VAT = (bf16_t*)mp_VAT(MP); E.IQ = (bf16_t*)mp_IQ(MP); E.IK = (bf16_t*)mp_IK(MP); E.IW = (float*)mp_IW(MP); E.HQ = (bf16_t*)mp_HQ(MP); E.HKK = (bf16_t*)mp_HKK(MP); E.HI = (bf16_t*)mp_HI(MP); E.HG = (bf16_t*)mp_HG(MP); E.HLF = (float*)mp_HLF(MP);
            E.GU = (bf16_t*)mp_GU(MP); E.GV = (bf16_t*)mp_GV(MP); E.CS = (const float*)(w + WS_CS); E.pos = (const int*)GIN(args.in[I_POS]); E.lb = (const float*)(w + WS_LB) + l * 384; E.kmax = (unsigned*)(w + WS_CTL) + CW_KMAX + l * 32; E.has_lb = (l > 0);
            pg8::gemm_phase<EpiInproj, pg8::StaticOrder>(lds, g, S, E);
            SEAM(pb + 1); STAMP(2);
        }
        if (PHL(2)) {
#if EN_HGRN
            for (int rep = 0; rep < REP_HGRN; ++rep) { unsigned char* w = launder(args.ws); const MixPtrs MP = make_mp(w); unsigned* ctr = (unsigned*)(w + WS_CTL) + CW_Q + 64 * (4 * l + 0 + 8 * rep);
              for (;;) { const int u = q_next(ctr, qslot); if (u >= 192) break; UNIT_T0(); hgrn_unit(lds, MP, u / 6, u % 6, GIN(args.in[I_ONORM]) + l * 64); UNIT_T1(0, u == 0 && l == 0); } }
#endif
#if EN_DSA
            for (int rep = 0; rep < REP_SEL; ++rep) { unsigned char* w = launder(args.ws); const MixPtrs MP = make_mp(w); unsigned* ctr = (unsigned*)(w + WS_CTL) + CW_Q + 64 * (32 + 8 * l + 16 * rep);
              for (;;) { const int u = q_next_xcd(ctr, 64u, bar.x & 7u, qslot); if (u < 0) break;
                  const int b = 4 * (u >> 6) + (u & 3), J = 15 - ((u & 63) >> 2);
#pragma unroll 1
                  for (int jj = 3; jj >= 0; --jj) { dsa_select_unit(lds, MP, b, 4 * J + jj, rep); __syncthreads(); }
                  asm volatile("s_waitcnt vmcnt(0)" ::: "memory"); __syncthreads();
                  dsa_attn_unit(lds, MP, b, J, 0.f); } }
#endif
#if EN_GMLP
            for (int rep = 0; rep < REP_GMLP; ++rep) { unsigned char* w = launder(args.ws); const MixPtrs MP = make_mp(w); unsigned* ctr = (unsigned*)(w + WS_CTL) + CW_Q + 64 * (4 * l + 2 + 8 * rep);
              for (;;) { const int u = q_next(ctr, qslot); if (u >= 512) break;
                  UNIT_T0(); gmlp_unit(lds, MP, u >> 4, u & 15, GIN(args.in[I_VNG]) + l * 256, GIN(args.in[I_VNB]) + l * 256, (const bf16_t*)(w + WS_GW) + (size_t)l * 4 * 128 * 128, GIN(args.in[I_GBS]) + l * 512); UNIT_T1(2, u == 0 && l == 0); } }
#endif
#if !EN_HGRN || !EN_GMLP || !EN_DSA
            {
                unsigned char* w = launder(args.ws); bf16_t* A1 = (bf16_t*)(w + WS_ACT1); const int tz = opaque_tid0();
                for (size_t e = (size_t)vcu * NTHR + tz; e < (size_t)T * 1024; e += (size_t)G * NTHR) { const int c = (int)(e & 1023);
                    const bool z = (!EN_DSA && c < 384) || (!EN_HGRN && c >= 384 && c < 768) || (!EN_GMLP && c >= 768); if (z) A1[e] = 0; }
            }
#endif
            SEAM(pb + 2); STAMP(4);
        }
        if (PHL(4)) {
            unsigned char* w = launder(args.ws); const float* modl = (const float*)(w + WS_MOD) + (size_t)l * 32 * 6144;
            pg8::Gemm g{w, (unsigned)WS_ACT1, (unsigned)(WS_WOUT + (size_t)l * DM * DM * 2), T, DM, DM}; pg8::StaticOrder S; S.init(T, DM, G, bx, 4);
            if (l == 0) { EpiResid<true> E{GIN(args.in[I_X]), (bf16_t*)(w + WS_XR), modl + 2 * 1024}; pg8::gemm_phase<EpiResid<true>, pg8::StaticOrder>(lds, g, S, E); }
            else { EpiResid<false> E{GIN(args.in[I_X]), (bf16_t*)(w + WS_XR), modl + 2 * 1024}; pg8::gemm_phase<EpiResid<false>, pg8::StaticOrder>(lds, g, S, E); }
            SEAM(pb + 4); STAMP(3);
        }
        if (l == 0) {
            if (PHL(5)) { unsigned char* w = launder(args.ws); const float* modl = (const float*)(w + WS_MOD) + (size_t)l * 32 * 6144;
                norm_phase<true, true>((const void*)(w + WS_XR), GIN(args.in[I_GFFN]) + l * DM, modl + 3 * 1024, modl + 4 * 1024, (void*)(w + WS_ACT1), vcu, G); SEAM(pb + 5); STAMP(1); }
            if (PHL(7)) {
                unsigned char* w = launder(args.ws);
                pg8::Gemm g{w, (unsigned)WS_ACT1, (unsigned)WS_WF1, T, 2 * FD, DM}; pg8::StaticOrder S; S.init(T, 2 * FD, G, bx);
                EpiSwiglu E{(unsigned char*)(w + WS_ACTF), FD, 22};
                pg8::gemm_phase<EpiSwiglu, pg8::StaticOrder, true>(lds, g, S, E);
                SEAM(pb + 7); STAMP(6);
            }
            if (PHL(8)) {
                unsigned char* w = launder(args.ws); const float* modl = (const float*)(w + WS_MOD) + (size_t)l * 32 * 6144;
                pg8::Gemm g{w, (unsigned)WS_ACTF, (unsigned)WS_WF2, T, DM, FD}; pg8::StaticOrder S; S.init(T, DM, G, bx);
                EpiResid<false> E{GIN(args.in[I_X]), (bf16_t*)(w + WS_XR), modl + 5 * 1024};
                pg8::gemm_phase<EpiResid<false>, pg8::StaticOrder, true>(lds, g, S, E);
                SEAM(pb + 8); STAMP(7);
            }
        } else {
            if (PHL(5)) { unsigned char* w = launder(args.ws); const float* modl = (const float*)(w + WS_MOD) + (size_t)l * 32 * 6144;
                norm_route_phase((const bf16_t*)(w + WS_XR), GIN(args.in[I_GFFN]) + l * DM, modl + 3 * 1024, modl + 4 * 1024, GIN(args.in[I_MR]), (unsigned char*)(w + WS_HS), (int*)(w + WS_TOK), (unsigned*)(w + WS_CTL) + CW_CNT, lds, vcu, G); SEAM(pb + 5); STAMP(1); }
            if (PHL(6)) { unsigned char* w = launder(args.ws);
                moe_rowinfo_phase((const int*)(w + WS_TOK), (int*)(w + WS_ROWINFO), (unsigned*)(w + WS_CTL) + CW_CNT, lds, vcu, G); SEAM(pb + 6); STAMP(1); }
            if (PHL(7)) {
                unsigned char* w = launder(args.ws); unsigned* cnt = (unsigned*)(w + WS_CTL) + CW_CNT;
                __syncthreads(); moe_prefix_both(cnt, tpl, (LAS int*)(lds + 133120));
                const int NT0 = __builtin_amdgcn_readfirstlane(tpl[8]), NT1 = __builtin_amdgcn_readfirstlane(tpl[17]);
                pg8::Gemm g{w, (unsigned)WS_HS, (unsigned)WS_WM1, (NT0 + NT1) * 256, 2 * FE, DM};
                pg8::MoeOrder S; S.init((NT0 + NT1) * 256, 2 * FE, G, bx); S.tp = tpl; S.nNl = 28; S.NT0 = NT0;
                EpiSwiglu E{(unsigned char*)(w + WS_ACTM), FE, 28};
                pg8::gemm_phase<EpiSwiglu, pg8::MoeOrder, true, true>(lds, g, S, E, (const int*)(w + WS_ROWINFO));
                SEAM(pb + 7); STAMP(8);
            }
            if (PHL(8)) {
                unsigned char* w = launder(args.ws); unsigned* cnt = (unsigned*)(w + WS_CTL) + CW_CNT;
                __syncthreads(); moe_prefix_both(cnt, tpl, (LAS int*)(lds + 133120));
                const int NT0 = __builtin_amdgcn_readfirstlane(tpl[8]), NT1 = __builtin_amdgcn_readfirstlane(tpl[17]);
                pg8::Gemm g{w, (unsigned)WS_ACTM, (unsigned)WS_WM2, (NT0 + NT1) * 256, DM, FE};
                pg8::MoeOrder S; S.init((NT0 + NT1) * 256, DM, G, bx); S.tp = tpl; S.nNl = 4; S.NT0 = NT0;
                EpiMoeDown E{(bf16_t*)(w + WS_YM0), (bf16_t*)(w + WS_YM1)};
                pg8::gemm_phase<EpiMoeDown, pg8::MoeOrder, true>(lds, g, S, E);
                SEAM(pb + 8); STAMP(9);
            }
        }
    }
    if (((PHMASK >> 13) & 1u) && PH(25)) {
#ifdef PROBE_A
        __syncthreads(); float tot = (float)(PT[0] - PT[3]);
        if (PROBE_A >= 100) { tot = PROBE_TOT; if (opaque_tid0() == 0) { PT[1] = ((volatile unsigned*)(ws + WS_CTL))[200 + PROBE_A - 100]; PT[2] = ((volatile unsigned*)(ws + WS_CTL))[200 + PROBE_B - 100]; } __syncthreads(); }
        final_norm_phase((const bf16_t*)(launder(args.ws) + WS_XR), (const bf16_t*)(launder(args.ws) + WS_YM0), (const bf16_t*)(launder(args.ws) + WS_YM1), (const int*)(launder(args.ws) + WS_TOK), (const float*)(launder(args.ws) + WS_MOD) + 32 * 6144 + 5 * 1024, (unsigned*)(launder(args.ws) + WS_CTL) + CW_CNT, lds, (float*)(GAS float*)args.out, GIN(args.in[I_GFIN]), vcu, G, 1.f + floorf((float)PT[1] / tot * 40.f + PROBE_OFF) / 40.f, 100.f * floorf((float)PT[2] / tot * 40.f + PROBE_OFF) / 40.f);
#else
        final_norm_phase((const bf16_t*)(launder(args.ws) + WS_XR), (const bf16_t*)(launder(args.ws) + WS_YM0), (const bf16_t*)(launder(args.ws) + WS_YM1), (const int*)(launder(args.ws) + WS_TOK), (const float*)(launder(args.ws) + WS_MOD) + 32 * 6144 + 5 * 1024, (unsigned*)(launder(args.ws) + WS_CTL) + CW_CNT, lds, (float*)(GAS float*)args.out, GIN(args.in[I_GFIN]), vcu, G);
#endif
    }
#undef PH
#undef SEAM
#undef args
}

extern "C" void kernel_launch(void* const* d_in, const int* in_sizes, int n_in, void* d_out, int out_size, void* d_ws, size_t ws_size, hipStream_t stream) {
    static int grid = 0;
    if (grid == 0) {
        if (n_in != 23 || out_size != T * DM || ws_size < WS_END) { fprintf(stderr, "kernel_launch: unexpected shapes (n_in %d, out %d, ws %zu)\n", n_in, out_size, ws_size); grid = -1; return; }
        int dev = 0, cus = 0, per_cu = 0;
        if (hipGetDevice(&dev) != hipSuccess || hipDeviceGetAttribute(&cus, hipDeviceAttributeMultiprocessorCount, dev) != hipSuccess) { grid = -1; return; }
        if (hipFuncSetAttribute((const void*)fwd_kernel, hipFuncAttributeMaxDynamicSharedMemorySize, LDS_BYTES) != hipSuccess) { fprintf(stderr, "kernel_launch: hipFuncSetAttribute failed\n"); grid = -1; return; }
        if (hipOccupancyMaxActiveBlocksPerMultiprocessor(&per_cu, (const void*)fwd_kernel, NTHR, LDS_BYTES) != hipSuccess || per_cu < 1) fprintf(stderr, "kernel_launch: occupancy query reports %d\n", per_cu);
        (void)hipGetLastError();
        grid = cus;
    }
    if (grid < 0) return;
    (void)hipMemsetAsync((char*)d_ws + WS_CTL, 0, CTL_ZERO_BYTES, stream);
    Args a{};
    for (int i = 0; i < 23; ++i) a.in[i] = (const float*)d_in[i];
    a.out = (float*)d_out; a.ws = (unsigned char*)d_ws;
#if MK_PER_PHASE
    for (int p = 0; p < NPH; ++p) {
        if (p == 7 || p == 10 || p == 11 || p == 12 || p == 24) continue;
        a.ph_lo = p; a.ph_hi = p + 1;
        hipLaunchKernelGGL(fwd_kernel, dim3(grid), dim3(NTHR), LDS_BYTES, stream, a);
    }
#else
    a.ph_lo = 0; a.ph_hi = NPH;
    hipLaunchKernelGGL(fwd_kernel, dim3(grid), dim3(NTHR), LDS_BYTES, stream, a);
#endif
}
```
